# Optimizing an MI355X kernel written in HIP

```python
import jax, jax.numpy as jnp
from jax import lax
import numpy as np

D_MODEL = 1024
BATCH = 4
SEQ = 4096
DEPTH = 1

ATT_HEADS = 8
ATT_HD = 64
ATT_W = ATT_HEADS * ATT_HD
IDX_HEADS = 4
IDX_HD = 64
TOPK_MAX = 256
QBLOCK = 128
GLA_HEADS = 4
GLA_DK = 64
GLA_DV = 128
GLA_W = GLA_HEADS * GLA_DV
GLA_GATE_RANK = 16
GLA_TAU = 16.0
GLA_CHUNK = 64
ROPE_THETA = 500000.0
ROT_DIM = ATT_HD // 4
NORM_EPS = 1e-6
NEG = -1e30

PROJ_SIZES = (
    ATT_W, ATT_W, ATT_W,
    IDX_HEADS * IDX_HD,
    IDX_HD,
    IDX_HEADS,
    ATT_W,
    GLA_HEADS * GLA_DK,
    GLA_HEADS * GLA_DK,
    GLA_W,
    GLA_GATE_RANK,
    GLA_W,
)
PROJ_TOTAL = sum(PROJ_SIZES)

kernel_name = "hymba_dsa_gla_sandwich_block"


def _rmsnorm(x, w):
    xf = x.astype(jnp.float32)
    y = xf * lax.rsqrt(jnp.mean(xf * xf, axis=-1, keepdims=True) + NORM_EPS)
    return (y * w.astype(jnp.float32)).astype(x.dtype)


def _rope_tables(positions):
    inv = ROPE_THETA ** (-jnp.arange(0, ROT_DIM, 2, dtype=jnp.float32) / ROT_DIM)
    ang = positions.astype(jnp.float32)[..., None] * inv
    return jnp.cos(ang)[:, :, None, :], jnp.sin(ang)[:, :, None, :]


def _partial_rope(x, cos, sin):
    half = ROT_DIM // 2
    xf = x.astype(jnp.float32)
    x1 = xf[..., :half]
    x2 = xf[..., half:ROT_DIM]
    out = jnp.concatenate([x1 * cos - x2 * sin, x2 * cos + x1 * sin, xf[..., ROT_DIM:]], axis=-1)
    return out.astype(x.dtype)


def _dsa_attention(q, k, v, q_idx, k_idx, w_idx):
    B, S, H, dh = q.shape
    nb = S // QBLOCK
    ksel = min(TOPK_MAX, S // 4)
    key_pos = jnp.arange(S)
    k_idx_f = k_idx.astype(jnp.float32)
    gather = jax.vmap(lambda tab, ix: tab[ix])

    def to_blocks(a):
        return jnp.moveaxis(a.reshape((B, nb, QBLOCK) + a.shape[2:]), 1, 0)

    def block(args):
        qb, qib, wb, bi = args
        qpos = bi * QBLOCK + jnp.arange(QBLOCK)
        causal = key_pos[None, :] <= qpos[:, None]
        rel = jax.nn.relu(jnp.einsum('bqhd,bsd->bqhs', qib.astype(jnp.float32), k_idx_f))
        score = jnp.einsum('bqh,bqhs->bqs', wb.astype(jnp.float32), rel)
        score = jnp.where(causal[None], score, NEG)
        _, idx = lax.top_k(score, ksel)
        valid = idx <= qpos[None, :, None]
        kg = gather(k, idx)
        vg = gather(v, idx)
        logits = jnp.einsum('bqhd,bqkhd->bqhk', qb, kg).astype(jnp.float32) * (dh ** -0.5)
        logits = jnp.where(valid[:, :, None, :], logits, NEG)
        p = jax.nn.softmax(logits, axis=-1).astype(v.dtype)
        return jnp.einsum('bqhk,bqkhd->bqhd', p, vg)

    out = lax.map(block, (to_blocks(q), to_blocks(q_idx), to_blocks(w_idx), jnp.arange(nb)))
    return jnp.moveaxis(out, 0, 1).reshape(B, S, H, dh)


def _gla(q, k, v, g):
    B, S, H, dk = q.shape
    C = GLA_CHUNK
    nc = S // C

    def chunks(a):
        return jnp.transpose(a.reshape(B, nc, C, H, a.shape[-1]), (1, 0, 3, 2, 4))

    qc = chunks(q.astype(jnp.float32) * (dk ** -0.5))
    kc = chunks(k.astype(jnp.float32))
    vc = chunks(v.astype(jnp.float32))
    gc = chunks(g)
    tri = jnp.tril(jnp.ones((C, C), dtype=bool))

    def step(state, inp):
        qi, ki, vi, gi = inp
        b = jnp.cumsum(gi, axis=2)
        o_inter = jnp.einsum('bhtd,bhde->bhte', qi * jnp.exp(b), state)
        diff = b[:, :, :, None, :] - b[:, :, None, :, :]
        decay = jnp.exp(jnp.where(tri[None, None, :, :, None], diff, NEG))
        a = jnp.einsum('bhtd,bhsd,bhtsd->bhts', qi, ki, decay)
        o = o_inter + jnp.einsum('bhts,bhse->bhte', a, vi)
        b_last = b[:, :, -1:, :]
        new_state = (jnp.exp(b_last[:, :, 0, :])[..., None] * state
                     + jnp.einsum('bhsd,bhse->bhde', ki * jnp.exp(b_last - b), vi))
        return new_state, o

    state0 = jnp.zeros((B, H, dk, v.shape[-1]), jnp.float32)
    _, o = lax.scan(step, state0, (qc, kc, vc, gc))
    return jnp.transpose(o, (1, 0, 3, 2, 4)).reshape(B, S, H, v.shape[-1])


def setup_inputs(seed: int = 0) -> dict:
    key = jax.random.key(seed)
    ks = jax.random.split(key, 9)
    x = jax.random.normal(ks[0], (BATCH, SEQ, D_MODEL), jnp.float32)
    positions = jnp.broadcast_to(jnp.arange(SEQ, dtype=jnp.int32)[None, :], (BATCH, SEQ))
    w_in = jax.random.normal(ks[1], (D_MODEL, PROJ_TOTAL), jnp.float32) * D_MODEL ** -0.5
    w_gla_gate_up = jax.random.normal(ks[2], (GLA_GATE_RANK, GLA_HEADS * GLA_DK), jnp.float32) * GLA_GATE_RANK ** -0.5
    b_gla_gate = 0.01 * jax.random.normal(ks[3], (GLA_HEADS * GLA_DK,), jnp.float32)
    gla_norm_w = 1.0 + 0.02 * jax.random.normal(ks[4], (GLA_DV,), jnp.float32)
    w_out = jax.random.normal(ks[5], (ATT_W + GLA_W, D_MODEL), jnp.float32) * (ATT_W + GLA_W) ** -0.5
    pre_norm_w = 1.0 + 0.02 * jax.random.normal(ks[6], (D_MODEL,), jnp.float32)
    post_norm_w = 1.0 + 0.02 * jax.random.normal(ks[7], (D_MODEL,), jnp.float32)
    return {"x": x, "positions": positions, "w_in": w_in, "w_gla_gate_up": w_gla_gate_up,
            "b_gla_gate": b_gla_gate, "gla_norm_w": gla_norm_w, "w_out": w_out,
            "pre_norm_w": pre_norm_w, "post_norm_w": post_norm_w}


def reference(x, positions, w_in, w_gla_gate_up, b_gla_gate, gla_norm_w, w_out, pre_norm_w, post_norm_w):
    B, S, _ = x.shape
    cos, sin = _rope_tables(positions)
    for _layer in range(DEPTH):
        h = _rmsnorm(x, pre_norm_w)
        proj = h @ w_in
        splits = []
        acc = 0
        for sz in PROJ_SIZES[:-1]:
            acc += sz
            splits.append(acc)
        (a_q, a_k, a_v, i_q, i_k, i_w, a_gate,
         g_q, g_k, g_v, g_lr, g_gate) = jnp.split(proj, splits, axis=-1)

        a_q = _partial_rope(a_q.reshape(B, S, ATT_HEADS, ATT_HD), cos, sin)
        a_k = _partial_rope(a_k.reshape(B, S, ATT_HEADS, ATT_HD), cos, sin)
        a_v = a_v.reshape(B, S, ATT_HEADS, ATT_HD)
        i_q = _partial_rope(i_q.reshape(B, S, IDX_HEADS, IDX_HD), cos, sin)
        i_k = _partial_rope(i_k.reshape(B, S, 1, IDX_HD), cos, sin)[:, :, 0, :]
        i_w = i_w * (IDX_HEADS ** -0.5 * IDX_HD ** -0.5)
        att = _dsa_attention(a_q, a_k, a_v, i_q, i_k, i_w).reshape(B, S, ATT_W)
        att = att * jax.nn.silu(a_gate)

        log_alpha = jax.nn.log_sigmoid((g_lr @ w_gla_gate_up + b_gla_gate).astype(jnp.float32)) / GLA_TAU
        o = _gla(g_q.reshape(B, S, GLA_HEADS, GLA_DK), g_k.reshape(B, S, GLA_HEADS, GLA_DK),
                 g_v.reshape(B, S, GLA_HEADS, GLA_DV), log_alpha.reshape(B, S, GLA_HEADS, GLA_DK))
        o = _rmsnorm(o, gla_norm_w).astype(x.dtype).reshape(B, S, GLA_W)
        gla = o * jax.nn.silu(g_gate)

        mixed = jnp.concatenate([att, gla], axis=-1) @ w_out
        x = x + _rmsnorm(mixed, post_norm_w)
    return x
```

```cpp
#include <hip/hip_runtime.h>
#include <hip/hip_cooperative_groups.h>
#include <stdint.h>
#include <cstdio>
namespace cg = cooperative_groups;

constexpr int BATCH = 4, SEQ = 4096, M = BATCH * SEQ, DM = 1024, NPROJ = 3924;
constexpr int OFF_AQ = 0, OFF_AK = 512, OFF_AV = 1024, OFF_IQ = 1536, OFF_IK = 1792, OFF_IW = 1856, OFF_AG = 1860,
              OFF_GQ = 2372, OFF_GK = 2628, OFF_GV = 2884, OFF_GLR = 3396, OFF_GG = 3412;
constexpr int TOPK = 256;
constexpr float NORM_EPS = 1e-6f;
constexpr float C2 = 0.125f * 1.4426950408889634f;
constexpr int NF = 4096;

constexpr size_t MiB = 1u << 20;
constexpr size_t WS_CTL = 0, WS_RSTD = 1 * MiB, WS_ROPE = 2 * MiB, WS_W2T = 3 * MiB, WS_Q = 6 * MiB, WS_K = 22 * MiB, WS_V = 38 * MiB, WS_MIX = 54 * MiB,
                 WS_GQ = 86 * MiB, WS_GK = 94 * MiB, WS_GV = 102 * MiB, WS_IQH = 118 * MiB, WS_IQL = 126 * MiB, WS_IKH = 134 * MiB, WS_IKL = 136 * MiB, WS_IW = 138 * MiB, WS_GLR = 139 * MiB,
                 WS_MASK = 140 * MiB, WS_XH = 148 * MiB, WS_XL = 180 * MiB, WS_W1T = 212 * MiB, WS_W1L = 220 * MiB, WS_TMP = 148 * MiB, WS_SC = 148 * MiB, WS_UT = 148 * MiB, WS_DV = 166 * MiB;

typedef unsigned short bf16_t;
#define LAS __attribute__((address_space(3)))
__device__ __forceinline__ unsigned f2bf_u(float f) { unsigned u = __builtin_bit_cast(unsigned, f); return (u + 0x7fffu + ((u >> 16) & 1u)) >> 16; }
__device__ __forceinline__ bf16_t f2bf(float f) { return (bf16_t)f2bf_u(f); }
__device__ __forceinline__ float bf2f(bf16_t b) { return __builtin_bit_cast(float, (unsigned)b << 16); }
__device__ __forceinline__ unsigned pk2(float lo, float hi) { return f2bf_u(lo) | (f2bf_u(hi) << 16); }
__device__ __forceinline__ float wave_sum(float v) {
#pragma unroll
    for (int o = 1; o < 64; o <<= 1) v += __shfl_xor(v, o);
    return v;
}
__device__ __forceinline__ float silu(float x) { return x / (1.f + __expf(-x)); }
__device__ __forceinline__ int cmap(int n) {
    if (n < 512) return OFF_AQ + n;
    if (n < 1024) return OFF_AK + (n - 512);
    if (n < 1536) return OFF_AV + (n - 1024);
    if (n < 2048) return OFF_AG + (n - 1536);
    if (n < 2304) return OFF_GQ + (n - 2048);
    if (n < 2560) return OFF_GK + (n - 2304);
    if (n < 3072) return OFF_GV + (n - 2560);
    if (n < 3584) return OFF_GG + (n - 3072);
    if (n < 3840) return OFF_IQ + (n - 3584);
    const int l = n - 3840;
    if (l < 64) return OFF_IK + l;
    if (l < 68) return OFF_IW + (l - 64);
    if (l >= 72 && l < 88) return OFF_GLR + (l - 72);
    return -1;
}
struct MkPtrs { const float* GLR; const float* wup; const float* bias; const float* gnw; const bf16_t* GQ; const bf16_t* GK; const bf16_t* GV; bf16_t* UT; float* DV; bf16_t* MIX; };
namespace pg8 {
typedef short bf16x8 __attribute__((ext_vector_type(8)));
typedef float f32x4 __attribute__((ext_vector_type(4)));
typedef unsigned u32x4 __attribute__((ext_vector_type(4)));
constexpr int BM = 256, BK = 64, HALF = 128, HTB = HALF * BK * 2, STAGE_BYTES = 8 * HTB, KP = 1024  ;
__host__ __device__ __forceinline__ int lds_byte(int r, int c) { const int st = (r >> 4) * 2 + (c >> 5), rr = r & 15, cc = c & 31, ob = rr * 64 + cc * 2; return st * 1024 + (ob ^ (((ob >> 9) & 1) << 5)); }
__host__ __device__ __forceinline__ void stage_rc(int b, int& R, int& C) { const int st = b / 1024, sb = b % 1024, swz = sb ^ (((sb >> 9) & 1) << 5); R = (st >> 1) * 16 + swz / 64; C = (st & 1) * 32 + (swz % 64) / 2; }
__host__ __device__ __forceinline__ int perm32(int rho) { const int n = rho >> 4, i = rho & 15; return 8 * (i >> 2) + 4 * n + (i & 3); }
struct Unit { int pm, pn, kind; };

template <class Epi, class Sched, class Prob, bool ALIGN_EPI>
__device__ __forceinline__ void gemm_phase(LAS unsigned char* lds, const Prob& P, const Sched& S, const Epi& E) {
    const int tid = threadIdx.x, wid = __builtin_amdgcn_readfirstlane(tid >> 6), lane = tid & 63, wr = wid >> 2, wc = wid & 3, fr = lane & 15, fq = lane >> 4;
    unsigned voffA[2], voffB[2];
#pragma unroll
    for (int i = 0; i < 2; ++i) { int R, C; stage_rc(tid * 16 + i * 8192, R, C); const int Rb = Epi::PERM ? ((R & ~31) + perm32(R & 31)) : R;
        voffA[i] = (unsigned)(R * KP + C) * 2u; voffB[i] = (unsigned)(Rb * KP + C) * 2u; }
    const size_t hstep = (size_t)HALF * KP * 2;
    const unsigned ldsw = (unsigned)wid * 1024u;
    const int aoff = lds_byte(wr * 64 + fr, fq * 8), boff = lds_byte(wc * 32 + fr, fq * 8);
#define PG8_SA(b, h) (((b) * 2 + (h)) * HTB)
#define PG8_SB(b, h) ((4 + (b) * 2 + (h)) * HTB)
#define PG8_STAGE(bufoff, gbase, voff) do { _Pragma("unroll") for (int _i = 0; _i < 2; ++_i) \
        __builtin_amdgcn_global_load_lds((const unsigned*)((const char*)(gbase) + (voff)[_i]), (LAS unsigned*)(lds + (bufoff) + ldsw + _i * 8192), 16, 0, 0); } while (0)
#define PG8_LDA(dst, b, h) do { _Pragma("unroll") for (int m = 0; m < 4; ++m) _Pragma("unroll") for (int k = 0; k < 2; ++k) dst[m][k] = *(const LAS bf16x8*)(lds + PG8_SA(b, h) + aoff + m * 2048 + k * 1024); } while (0)
#define PG8_LDB(dst, b, h) do { _Pragma("unroll") for (int n = 0; n < 2; ++n) _Pragma("unroll") for (int k = 0; k < 2; ++k) dst[n][k] = *(const LAS bf16x8*)(lds + PG8_SB(b, h) + boff + n * 2048 + k * 1024); } while (0)
#define PG8_MMA(ai, bj, At, Bt) do { __builtin_amdgcn_s_setprio(1); _Pragma("unroll") for (int m = 0; m < 4; ++m) _Pragma("unroll") for (int n = 0; n < 2; ++n) _Pragma("unroll") for (int k = 0; k < 2; ++k) \
        acc[ai][bj][m][n] = __builtin_amdgcn_mfma_f32_16x16x32_bf16(Bt[n][k], At[m][k], acc[ai][bj][m][n], 0, 0, 0); __builtin_amdgcn_s_setprio(0); } while (0)
#define PG8_WAIT_V(n) asm volatile("s_waitcnt vmcnt(" #n ")" ::: "memory")
#define PG8_WAIT_L(n) asm volatile("s_waitcnt lgkmcnt(" #n ")" ::: "memory")
#define PG8_BAR __builtin_amdgcn_s_barrier()
#define PG8_SCHED __builtin_amdgcn_sched_barrier(0)
    Unit cur, nxt; int ui = 0;
    if (!S.next(0, cur)) return;
    f32x4 acc[2][2][4][2];
#pragma unroll
    for (int a = 0; a < 2; ++a)
#pragma unroll
        for (int b = 0; b < 2; ++b)
#pragma unroll
            for (int m = 0; m < 4; ++m)
#pragma unroll
                for (int n = 0; n < 2; ++n) acc[a][b][m][n] = (f32x4){0.f, 0.f, 0.f, 0.f};
    bf16x8 At[4][2], B0[2][2], B1[2][2];
    {
        const char* a0 = P.a(cur, 0); const char* b0 = P.b(cur, 0); const char* a1 = P.a(cur, 1); const char* b1 = P.b(cur, 1);
        PG8_STAGE(PG8_SB(0, 0), b0, voffB); PG8_STAGE(PG8_SB(0, 1), b0 + hstep, voffB); PG8_STAGE(PG8_SA(0, 0), a0, voffA); PG8_STAGE(PG8_SA(0, 1), a0 + hstep, voffA);
        if (wr == 1) PG8_BAR;
        PG8_WAIT_V(2); PG8_BAR;
        PG8_STAGE(PG8_SB(1, 0), b1, voffB); PG8_STAGE(PG8_SA(1, 0), a1, voffA); PG8_STAGE(PG8_SB(1, 1), b1 + hstep, voffB);
        PG8_WAIT_V(6); PG8_BAR;
    }
    for (;;) {
        const bool has_next = S.next(ui + 1, nxt);
        const Unit nu = has_next ? nxt : cur;
        const int nt = P.nt(cur);
        for (int t = 0; t < nt; t += 2) {
            const bool last = (t == nt - 2);
            const char* a1 = P.a(cur, t + 1);
            const char* a2 = last ? P.a(nu, 0) : P.a(cur, t + 2); const char* b2 = last ? P.b(nu, 0) : P.b(cur, t + 2);
            const char* a3 = last ? P.a(nu, 1) : P.a(cur, t + 3); const char* b3 = last ? P.b(nu, 1) : P.b(cur, t + 3);
            PG8_LDB(B0, 0, 0); PG8_LDB(B1, 0, 1); PG8_SCHED; PG8_LDA(At, 0, 0); PG8_STAGE(PG8_SA(1, 1), a1 + hstep, voffA);
            PG8_WAIT_V(8); PG8_WAIT_L(0); PG8_BAR; PG8_MMA(0, 0, At, B0); PG8_MMA(0, 1, At, B1); PG8_BAR; PG8_SCHED;
            PG8_LDA(At, 0, 1); PG8_STAGE(PG8_SB(0, 0), b2, voffB); PG8_STAGE(PG8_SB(0, 1), b2 + hstep, voffB); PG8_STAGE(PG8_SA(0, 0), a2, voffA);
            PG8_WAIT_V(8); PG8_WAIT_L(0); PG8_BAR; PG8_MMA(1, 0, At, B0); PG8_MMA(1, 1, At, B1); PG8_BAR; PG8_SCHED;
            PG8_LDB(B0, 1, 0); PG8_LDB(B1, 1, 1); PG8_SCHED; PG8_LDA(At, 1, 0); PG8_STAGE(PG8_SA(0, 1), a2 + hstep, voffA);
            PG8_WAIT_V(8); PG8_WAIT_L(0); PG8_BAR; PG8_MMA(0, 0, At, B0); PG8_MMA(0, 1, At, B1); PG8_BAR; PG8_SCHED;
            PG8_LDA(At, 1, 1); PG8_STAGE(PG8_SB(1, 0), b3, voffB); PG8_STAGE(PG8_SB(1, 1), b3 + hstep, voffB); PG8_STAGE(PG8_SA(1, 0), a3, voffA);
            PG8_WAIT_V(8); PG8_WAIT_L(0); PG8_BAR; PG8_MMA(1, 0, At, B0); PG8_MMA(1, 1, At, B1); PG8_BAR; PG8_SCHED;
        }
        if constexpr (ALIGN_EPI) { if (wr == 0) PG8_BAR; }
        if constexpr (!Epi::AFTER_DRAIN) { E(acc, cur, wr, wc, fr, fq); }
        if (!has_next) break;
#pragma unroll
        for (int a = 0; a < 2; ++a)
#pragma unroll
            for (int b = 0; b < 2; ++b)
#pragma unroll
                for (int m = 0; m < 4; ++m)
#pragma unroll
                    for (int n = 0; n < 2; ++n) acc[a][b][m][n] = (f32x4){0.f, 0.f, 0.f, 0.f};
        cur = nxt; ++ui;
        if constexpr (ALIGN_EPI) { if (wr == 1) PG8_BAR; }
    }
    PG8_WAIT_V(0);
    if constexpr (!ALIGN_EPI) { if (wr == 0) PG8_BAR; }
    PG8_BAR;
    if constexpr (Epi::AFTER_DRAIN) { E.fused(acc, cur, wr, wc, fr, fq, lds, wid, lane); }
#undef PG8_SA
#undef PG8_SB
#undef PG8_STAGE
#undef PG8_LDA
#undef PG8_LDB
#undef PG8_MMA
#undef PG8_WAIT_V
#undef PG8_WAIT_L
#undef PG8_BAR
#undef PG8_SCHED
}
}
typedef float f32x4 __attribute__((ext_vector_type(4)));
typedef unsigned u32x4 __attribute__((ext_vector_type(4)));
typedef unsigned u32x2 __attribute__((ext_vector_type(2)));

struct ProbProj {
    const bf16_t *XH, *XL, *W1T, *W1L;
    __device__ __forceinline__ int nt(const pg8::Unit& u) const { return u.kind ? 48 : 16; }
    __device__ __forceinline__ const char* a(const pg8::Unit& u, int t) const {
        const bf16_t* base = (u.kind && t >= 16 && t < 32) ? XL : XH;
        return (const char*)(base + (size_t)u.pm * 256 * pg8::KP) + (size_t)(t & 15) * 128; }
    __device__ __forceinline__ const char* b(const pg8::Unit& u, int t) const {
        const bf16_t* base = (u.kind && t >= 32) ? (W1L + (size_t)(u.pn - 14) * 256 * pg8::KP) : (W1T + (size_t)u.pn * 256 * pg8::KP);
        return (const char*)base + (size_t)(t & 15) * 128; }
};
struct SchedProj {
    int G, c;
    __device__ __forceinline__ bool next(int i, pg8::Unit& u) const {
        if (G == 256) {
            const int role = c & 3; u.pm = c >> 2;
            if (role < 2) { if (i >= 3) return false; if (i == 0) { u.pn = 14 + role; u.kind = 1; } else { u.pn = role * 2 + (i - 1); u.kind = 0; } }
            else { if (i >= 5) return false; u.pn = 4 + (role - 2) * 5 + i; u.kind = 0; }
            return true;
        }
        const long L = (long)i * G + c; if (L >= 64 * 16) return false;
        const int pn = 15 - (int)(L / 64); u.pm = (int)(L % 64); u.pn = pn; u.kind = pn >= 14 ? 1 : 0; return true;
    }
};
__device__ __forceinline__ void split_store8(const f32x4& v0, const f32x4& v1, bf16_t* ph, bf16_t* pl) {
    u32x4 h; h.x = pk2(v0[0], v0[1]); h.y = pk2(v0[2], v0[3]); h.z = pk2(v1[0], v1[1]); h.w = pk2(v1[2], v1[3]);
    f32x4 l0, l1;
    l0[0] = v0[0] - __builtin_bit_cast(float, h.x << 16); l0[1] = v0[1] - __builtin_bit_cast(float, h.x & 0xffff0000u);
    l0[2] = v0[2] - __builtin_bit_cast(float, h.y << 16); l0[3] = v0[3] - __builtin_bit_cast(float, h.y & 0xffff0000u);
    l1[0] = v1[0] - __builtin_bit_cast(float, h.z << 16); l1[1] = v1[1] - __builtin_bit_cast(float, h.z & 0xffff0000u);
    l1[2] = v1[2] - __builtin_bit_cast(float, h.w << 16); l1[3] = v1[3] - __builtin_bit_cast(float, h.w & 0xffff0000u);
    u32x4 l; l.x = pk2(l0[0], l0[1]); l.y = pk2(l0[2], l0[3]); l.z = pk2(l1[0], l1[1]); l.w = pk2(l1[2], l1[3]);
    *(u32x4*)ph = h; *(u32x4*)pl = l;
}
struct EpiProj {
    static constexpr bool PERM = true, AFTER_DRAIN = false;
    unsigned char* ws;
    __device__ __forceinline__ void operator()(const f32x4 (&acc)[2][2][4][2], const pg8::Unit& u, int wr, int wc, int fr, int fq) const {
        const int pn = u.pn;
        const float* rstd = (const float*)(ws + WS_RSTD); const float* rope = (const float*)(ws + WS_ROPE);
        const bool rope_tile = (pn < 4) || (pn >= 14);
        const bool rope_wave = rope_tile && ((wc & 1) == 0);
        int mode, ld, coloff; unsigned char* base; float sc = 1.f;
        if (pn < 2)       { mode = 0; base = ws + WS_Q;   ld = 512;  coloff = pn * 256; sc = C2; }
        else if (pn < 4)  { mode = 0; base = ws + WS_K;   ld = 512;  coloff = (pn - 2) * 256; }
        else if (pn < 6)  { mode = 0; base = ws + WS_V;   ld = 512;  coloff = (pn - 4) * 256; }
        else if (pn < 8)  { mode = 1; base = ws + WS_MIX; ld = 1024; coloff = (pn - 6) * 256; }
        else if (pn == 8) { mode = 0; base = ws + WS_GQ;  ld = 256;  coloff = 0; }
        else if (pn == 9) { mode = 0; base = ws + WS_GK;  ld = 256;  coloff = 0; }
        else if (pn < 12) { mode = 0; base = ws + WS_GV;  ld = 512;  coloff = (pn - 10) * 256; }
        else if (pn < 14) { mode = 1; base = ws + WS_MIX; ld = 1024; coloff = 512 + (pn - 12) * 256; }
        else if (pn == 14){ mode = 2; base = ws + WS_IQH; ld = 256;  coloff = 0; }
        else              { mode = 3; base = ws + WS_IKH; ld = 64;   coloff = 0; }
        const int row0 = u.pm * 256 + wr * 64 + fr;
#pragma unroll
        for (int ai = 0; ai < 2; ++ai)
#pragma unroll
            for (int m = 0; m < 4; ++m) {
                const int row = row0 + ai * 128 + m * 16;
                const float r = rstd[row];
                f32x4 c_lo = {1.f, 1.f, 1.f, 1.f}, c_hi = c_lo, s_lo = {0.f, 0.f, 0.f, 0.f}, s_hi = s_lo;
                if (rope_wave) { const f32x4* rp = (const f32x4*)(rope + (size_t)row * 16); c_lo = rp[0]; c_hi = rp[1]; s_lo = rp[2]; s_hi = rp[3]; }
#pragma unroll
                for (int bj = 0; bj < 2; ++bj) {
                    f32x4 v0 = acc[ai][bj][m][0] * r, v1 = acc[ai][bj][m][1] * r;
                    if (rope_wave && (pn != 15 || (bj == 0 && wc == 0))) {
                        f32x4 p0, p1;
#pragma unroll
                        for (int j = 0; j < 4; ++j) { p0[j] = __shfl_xor(v0[j], 16); p1[j] = __shfl_xor(v1[j], 16); }
                        if (fq == 0) { v0 = v0 * c_lo - p0 * s_lo; v1 = v1 * c_hi - p1 * s_hi; }
                        else if (fq == 1) { v0 = v0 * c_lo + p0 * s_lo; v1 = v1 * c_hi + p1 * s_hi; }
                    }
                    const int c0 = bj * 128 + wc * 32 + 8 * fq;
                    if (mode == 0 || mode == 1) {
                        if (mode == 1) {
#pragma unroll
                            for (int j = 0; j < 4; ++j) { v0[j] = silu(v0[j]); v1[j] = silu(v1[j]); }
                        } else { v0 = v0 * sc; v1 = v1 * sc; }
                        u32x4 w; w.x = pk2(v0[0], v0[1]); w.y = pk2(v0[2], v0[3]); w.z = pk2(v1[0], v1[1]); w.w = pk2(v1[2], v1[3]);
                        *(u32x4*)((bf16_t*)base + (size_t)row * ld + coloff + c0) = w;
                    } else if (mode == 2) {
                        split_store8(v0, v1, (bf16_t*)(ws + WS_IQH) + (size_t)row * 256 + c0, (bf16_t*)(ws + WS_IQL) + (size_t)row * 256 + c0);
                    } else {
                        if (c0 < 64) split_store8(v0, v1, (bf16_t*)(ws + WS_IKH) + (size_t)row * 64 + c0, (bf16_t*)(ws + WS_IKL) + (size_t)row * 64 + c0);
                        else if (c0 == 64) { *(f32x4*)((float*)(ws + WS_IW) + (size_t)row * 4) = v0 * (0.5f * 0.125f); }
                        else if (c0 == 72) { float* p = (float*)(ws + WS_GLR) + (size_t)row * 16; *(f32x4*)p = v0; *(f32x4*)(p + 4) = v1; }
                        else if (c0 == 80) { float* p = (float*)(ws + WS_GLR) + (size_t)row * 16 + 8; *(f32x4*)p = v0; *(f32x4*)(p + 4) = v1; }
                    }
                }
            }
    }
};

template <bool MAPPED>
__device__ __forceinline__ void p0_transpose_item(const float* W, int Nsrc, const float* ksc, bf16_t* WT, bf16_t* WL, LAS float* scr, int item, int nblk, int lane) {
    const int kb = item / nblk, nb = item % nblk, k0 = 64 * kb, n0 = 32 * nb;
    const int srcc = MAPPED ? cmap(n0 + (lane & 31)) : (n0 + (lane & 31));
#pragma unroll 8
    for (int i = 0; i < 32; ++i) { const int kk = 2 * i + (lane >> 5);
        float v = W[(size_t)(k0 + kk) * Nsrc + (srcc < 0 ? 0 : srcc)]; if (MAPPED) v *= ksc[k0 + kk];
        scr[kk * 33 + (lane & 31)] = (srcc < 0) ? 0.f : v; }
    asm volatile("s_waitcnt lgkmcnt(0)" ::: "memory");
    const int c = lane & 7;
#pragma unroll
    for (int j = 0; j < 4; ++j) { const int n = (lane >> 3) + 8 * j; const LAS float* s = scr + (8 * c) * 33 + n;
        float v[8];
#pragma unroll
        for (int q = 0; q < 8; ++q) v[q] = s[q * 33];
        u32x4 o; o.x = pk2(v[0], v[1]); o.y = pk2(v[2], v[3]); o.z = pk2(v[4], v[5]); o.w = pk2(v[6], v[7]);
        *(u32x4*)(WT + (size_t)(n0 + n) * 1024 + k0 + 8 * c) = o;
        if (MAPPED && n0 >= 3584) {
            float l[8];
#pragma unroll
            for (int q = 0; q < 8; ++q) l[q] = v[q] - bf2f(f2bf(v[q]));
            u32x4 ol; ol.x = pk2(l[0], l[1]); ol.y = pk2(l[2], l[3]); ol.z = pk2(l[4], l[5]); ol.w = pk2(l[6], l[7]);
            *(u32x4*)(WL + (size_t)(n0 - 3584 + n) * 1024 + k0 + 8 * c) = ol;
        }
    }
    asm volatile("s_waitcnt lgkmcnt(0)" ::: "memory");
}
__device__ __forceinline__ void p0_row(const float* x, const int* pos, unsigned char* ws, int row, int lane) {
    const f32x4* xr = (const f32x4*)(x + (size_t)row * DM) + lane;
    f32x4 v[4]; float s = 0.f;
#pragma unroll
    for (int j = 0; j < 4; ++j) { v[j] = xr[64 * j]; s += (v[j][0] * v[j][0] + v[j][1] * v[j][1]) + (v[j][2] * v[j][2] + v[j][3] * v[j][3]); }
    s = wave_sum(s);
    u32x2* oh = (u32x2*)((bf16_t*)(ws + WS_XH) + (size_t)row * DM) + lane;
    u32x2* ol = (u32x2*)((bf16_t*)(ws + WS_XL) + (size_t)row * DM) + lane;
#pragma unroll
    for (int j = 0; j < 4; ++j) {
        u32x2 h; h.x = pk2(v[j][0], v[j][1]); h.y = pk2(v[j][2], v[j][3]);
        f32x4 l; l[0] = v[j][0] - __builtin_bit_cast(float, h.x << 16); l[1] = v[j][1] - __builtin_bit_cast(float, h.x & 0xffff0000u);
        l[2] = v[j][2] - __builtin_bit_cast(float, h.y << 16); l[3] = v[j][3] - __builtin_bit_cast(float, h.y & 0xffff0000u);
        u32x2 lo; lo.x = pk2(l[0], l[1]); lo.y = pk2(l[2], l[3]);
        oh[64 * j] = h; ol[64 * j] = lo;
    }
    if (lane == 0) ((float*)(ws + WS_RSTD))[row] = 1.0f / sqrtf(s * (1.0f / DM) + NORM_EPS);
    if (lane < 8) {
        const float inv = (float)pow(500000.0, -(double)lane / 8.0);
        const float ang = (float)pos[row] * inv;
        float* rope = (float*)(ws + WS_ROPE);
        rope[row * 16 + lane] = (float)cos((double)ang);
        rope[row * 16 + 8 + lane] = (float)sin((double)ang);
    }
}
struct ProbOut {
    const bf16_t *A, *Bt;
    __device__ __forceinline__ int nt(const pg8::Unit&) const { return 16; }
    __device__ __forceinline__ const char* a(const pg8::Unit& u, int t) const { return (const char*)(A + (size_t)u.pm * 256 * pg8::KP) + (size_t)(t & 15) * 128; }
    __device__ __forceinline__ const char* b(const pg8::Unit& u, int t) const { return (const char*)(Bt + (size_t)u.pn * 256 * pg8::KP) + (size_t)(t & 15) * 128; }
};
struct SchedOut {
    int G, c;
    __device__ __forceinline__ bool next(int i, pg8::Unit& u) const { const long L = (long)i * G + c; if (L >= 256) return false; u.pm = (int)(L >> 2); u.pn = (int)(L & 3); u.kind = 0; return true; }
};
struct EpiY {
    static constexpr bool PERM = false, AFTER_DRAIN = false;
    float* Y;
    __device__ __forceinline__ void operator()(const f32x4 (&acc)[2][2][4][2], const pg8::Unit& u, int wr, int wc, int fr, int fq) const {
        const int row0 = u.pm * 256 + wr * 64 + fr, col0 = u.pn * 256 + wc * 32 + 4 * fq;
#pragma unroll
        for (int ai = 0; ai < 2; ++ai)
#pragma unroll
            for (int m = 0; m < 4; ++m) { float* rowp = Y + (size_t)(row0 + ai * 128 + m * 16) * DM + col0;
#pragma unroll
                for (int bj = 0; bj < 2; ++bj)
#pragma unroll
                    for (int n = 0; n < 2; ++n) *(f32x4*)(rowp + bj * 128 + n * 16) = acc[ai][bj][m][n]; }
    }
};
__device__ __forceinline__ void p6_row(const float* x, const float* Y, const float* pw, float* out, int row, int lane) {
    const f32x4* yr = (const f32x4*)(Y + (size_t)row * DM) + lane;
    f32x4 v[4]; float s = 0.f;
#pragma unroll
    for (int j = 0; j < 4; ++j) { v[j] = yr[64 * j]; s += (v[j][0] * v[j][0] + v[j][1] * v[j][1]) + (v[j][2] * v[j][2] + v[j][3] * v[j][3]); }
    s = wave_sum(s);
    const float r = 1.0f / sqrtf(s * (1.0f / DM) + NORM_EPS);
#pragma unroll
    for (int j = 0; j < 4; ++j) {
        const f32x4 xv = ((const f32x4*)(x + (size_t)row * DM) + lane)[64 * j], w = ((const f32x4*)pw + lane)[64 * j];
        ((f32x4*)(out + (size_t)row * DM) + lane)[64 * j] = xv + v[j] * r * w;
    }
}
#include <hip/hip_bf16.h>
#include <cmath>
namespace attn_body {
using bf16=__hip_bfloat16;
using bf16x8=__attribute__((ext_vector_type(8)))short;
using s16x4=__attribute__((ext_vector_type(4)))short;
using f32x16=__attribute__((ext_vector_type(16)))float;
using u32x4=__attribute__((ext_vector_type(4)))unsigned;
constexpr int BATCH=4,NHEAD=8,SEQ=4096,D=64,DM=NHEAD*D,OPITCH=1024;
constexpr int NW=8,QBLK=32,QB=QBLK*NW,KVBLK=64,NQB=SEQ/QB;
constexpr int ATTN_PITCH=DM, ATTN_UNIT_ROWS=QB;
__device__ __forceinline__ int crow(int r,int hi){return (r&3)+8*(r>>2)+4*hi;}
#define SBAR() __builtin_amdgcn_sched_barrier(0)
__device__ __forceinline__ void cmask(f32x16&p0,f32x16&p1,int jb,int qrel,int hi){
  const float NEG=-INFINITY; int kb=64*jb+4*hi;
  #pragma unroll
  for(int r=0;r<16;++r){int kv=kb+(r&3)+8*(r>>2); if(kv>qrel)p0[r]=NEG; if(kv+32>qrel)p1[r]=NEG;}
}

constexpr int NSLOT=3, SLOTB=8192;
constexpr int LDS_K=0, LDS_V=NSLOT*SLOTB, LDS_WS=2*NSLOT*SLOTB, LDS_OST=LDS_WS+NW*64*4, LDS_MSK=LDS_OST+NW*4096, LDS_BYTES=LDS_MSK+NW*512;
constexpr float C2=0.125f*1.4426950408889634f;
__device__ __forceinline__ void glds16(const void*gsrc,unsigned lds_dst){unsigned keep;
  asm volatile("s_mov_b32 %0, m0\n\ts_mov_b32 m0, %2\n\ts_nop 0\n\tglobal_load_lds_dwordx4 %1, off\n\ts_mov_b32 m0, %0":"=&s"(keep):"v"(gsrc),"s"(lds_dst):"memory");}
__device__ __forceinline__ void glds4(const void*gsrc,unsigned lds_dst){unsigned keep;
  asm volatile("s_mov_b32 %0, m0\n\ts_mov_b32 m0, %2\n\ts_nop 0\n\tglobal_load_lds_dword %1, off\n\ts_mov_b32 m0, %0":"=&s"(keep):"v"(gsrc),"s"(lds_dst):"memory");}
__device__ __forceinline__ float max3f(float a,float b,float c){float r;asm("v_max3_f32 %0, %1, %2, %3":"=v"(r):"v"(a),"v"(b),"v"(c));return r;}
__device__ __forceinline__ float max2f(float a,float b){float r;asm("v_max_f32_e32 %0, %1, %2":"=v"(r):"v"(a),"v"(b));return r;}
__device__ __forceinline__ float fadd_s(float a,float b){float r;asm("v_add_f32_e32 %0, %1, %2":"=v"(r):"v"(a),"v"(b));return r;}
__device__ __forceinline__ float fsub_s(float a,float b){float r;asm("v_sub_f32_e32 %0, %1, %2":"=v"(r):"v"(a),"v"(b));return r;}
typedef float f32x2_t __attribute__((ext_vector_type(2))); typedef __bf16 bf16x2_t __attribute__((ext_vector_type(2)));
__device__ __forceinline__ unsigned cvtpk_s(float lo,float hi){f32x2_t v={lo,hi};bf16x2_t b=__builtin_convertvector(v,bf16x2_t);return __builtin_bit_cast(unsigned,b);}
#define WAIT_BAR(N) asm volatile("s_waitcnt vmcnt(" #N ") lgkmcnt(0)\n\ts_barrier":::"memory")

__device__ __forceinline__ void qkt(f32x16&p0,f32x16&p1,const char*Kslot,const bf16x8*qr,const f32x16&negm,int r32,int hi){
  const char*kb=Kslot+hi*1024+r32*16;
  #pragma unroll
  for(int d0=0;d0<4;++d0){
    const bf16x8 b0=*reinterpret_cast<const bf16x8*>(kb+d0*2048);
    const bf16x8 b1=*reinterpret_cast<const bf16x8*>(kb+d0*2048+512);
    if(d0==0){p0=__builtin_amdgcn_mfma_f32_32x32x16_bf16(b0,qr[0],negm,0,0,0);p1=__builtin_amdgcn_mfma_f32_32x32x16_bf16(b1,qr[0],negm,0,0,0);}
    else{p0=__builtin_amdgcn_mfma_f32_32x32x16_bf16(b0,qr[d0],p0,0,0,0);p1=__builtin_amdgcn_mfma_f32_32x32x16_bf16(b1,qr[d0],p1,0,0,0);}}
}
typedef __attribute__((address_space(3))) const char* lds_cptr;
typedef short v4i16_t __attribute__((ext_vector_type(4)));
__device__ __forceinline__ void kload8(bf16x8*kf,lds_cptr kp){
  kf[0]=*(const __attribute__((address_space(3))) bf16x8*)(kp);      kf[1]=*(const __attribute__((address_space(3))) bf16x8*)(kp+512);
  kf[2]=*(const __attribute__((address_space(3))) bf16x8*)(kp+2048); kf[3]=*(const __attribute__((address_space(3))) bf16x8*)(kp+2560);
  kf[4]=*(const __attribute__((address_space(3))) bf16x8*)(kp+4096); kf[5]=*(const __attribute__((address_space(3))) bf16x8*)(kp+4608);
  kf[6]=*(const __attribute__((address_space(3))) bf16x8*)(kp+6144); kf[7]=*(const __attribute__((address_space(3))) bf16x8*)(kp+6656);
}
__device__ __forceinline__ void kload2(bf16x8*kf,lds_cptr kp,int j){ kf[2*j]=*(const __attribute__((address_space(3))) bf16x8*)(kp+j*2048); kf[2*j+1]=*(const __attribute__((address_space(3))) bf16x8*)(kp+j*2048+512); }
__device__ __forceinline__ s16x4 vtr(lds_cptr p){ return __builtin_bit_cast(s16x4,__builtin_amdgcn_ds_read_tr16_b64_v4i16((__attribute__((address_space(3))) v4i16_t*)p)); }
__device__ __forceinline__ float rowmax(const f32x16&p0,const f32x16&p1){
  float a=max3f(p0[0],p0[1],p1[0]),b=max3f(p0[2],p0[3],p1[1]);a=max3f(a,p1[2],p1[3]);
  #pragma unroll
  for(int r=4;r<16;r+=4){a=max3f(a,p0[r],p0[r+1]);b=max3f(b,p0[r+2],p0[r+3]);a=max3f(a,p1[r],p1[r+1]);b=max3f(b,p1[r+2],p1[r+3]);}
  const float m=max2f(a,b);
  auto rr=__builtin_amdgcn_permlane32_swap(__float_as_uint(m),__float_as_uint(m),false,false);
  return max2f(__uint_as_float(rr[0]),__uint_as_float(rr[1]));
}
__device__ __forceinline__ void pv(f32x16*o,int vb,bf16x8 pa0,bf16x8 pa1,bf16x8 pa2,bf16x8 pa3){
  #pragma unroll
  for(int d0=0;d0<2;++d0){s16x4 lo[4],hi[4];
    #pragma unroll
    for(int ks=0;ks<4;++ks){
      asm volatile("ds_read_b64_tr_b16 %0,%1 offset:%c2":"=&v"(lo[ks]):"v"(vb),"i"(d0*4096+ks*1024):"memory");
      asm volatile("ds_read_b64_tr_b16 %0,%1 offset:%c2":"=&v"(hi[ks]):"v"(vb),"i"(d0*4096+ks*1024+512):"memory");}
    asm volatile("s_waitcnt lgkmcnt(0)":::"memory");SBAR();
    #define PK(k) (bf16x8){lo[k][0],lo[k][1],lo[k][2],lo[k][3],hi[k][0],hi[k][1],hi[k][2],hi[k][3]}
    o[d0]=__builtin_amdgcn_mfma_f32_32x32x16_bf16(pa0,PK(0),o[d0],0,0,0);
    o[d0]=__builtin_amdgcn_mfma_f32_32x32x16_bf16(pa1,PK(1),o[d0],0,0,0);
    o[d0]=__builtin_amdgcn_mfma_f32_32x32x16_bf16(pa2,PK(2),o[d0],0,0,0);
    o[d0]=__builtin_amdgcn_mfma_f32_32x32x16_bf16(pa3,PK(3),o[d0],0,0,0);
    #undef PK
  }
}

#ifndef ATTN_STORE16
#define ATTN_STORE16(p,v) (*(u32x4*)(p)=(v))
#endif
template<int THRL> __device__ __forceinline__ void attn_unit(int b,int h,int qb,const bf16*Q,const bf16*__restrict__ K,const bf16*__restrict__ V,const unsigned*__restrict__ MASK32,bf16*O,char*shm){
  const int tid=threadIdx.x,lane=tid&63,r32=lane&31,hi=lane>>5; const int wid=__builtin_amdgcn_readfirstlane(tid>>6);
  const long rowbase=(long)b*SEQ; const int q0=qb*QB;
  const bf16*Qw=Q+(rowbase+q0+wid*QBLK)*DM+h*D;
  const bf16*Kh=K+rowbase*DM+h*D,*Vh=V+rowbase*DM+h*D;
  const unsigned lds0=(unsigned)(uintptr_t)shm;
  float*wsf=(float*)(shm+LDS_WS)+wid*64;
  const bf16*ksrc=Kh+(long)lane*DM+wid*8;
  const bf16*vsrc=Vh+(long)(16*(wid&3)+(lane>>2))*DM+(wid>>2)*32+(lane&3)*8;
  const unsigned kdst=lds0+LDS_K+wid*1024, vdst=lds0+LDS_V+wid*1024;
  #define DMA_K(t,slot) glds16(ksrc+(long)(t)*KVBLK*DM,(unsigned)__builtin_amdgcn_readfirstlane(kdst+(slot)))
  #define DMA_V(t,slot) glds16(vsrc+(long)(t)*KVBLK*DM,(unsigned)__builtin_amdgcn_readfirstlane(vdst+(slot)))
  const unsigned*msrc=MASK32+(size_t)(rowbase+q0+wid*QBLK+(lane>>1))*128+(lane&1);
  const unsigned mdst=lds0+LDS_MSK+wid*512;
  #define DMA_M(t) glds4(msrc+2*(t),(unsigned)__builtin_amdgcn_readfirstlane(mdst+(((t)&1)<<8)))
  typedef __attribute__((address_space(3))) const unsigned long long* lds_u64p;
  #define MSK(v,W,b) __uint_as_float(__float_as_uint(v)&(unsigned)__builtin_amdgcn_sbfe((int)(W),(b),1))
  #define BP(B) (((B)&3)+8*((B)>>2))
  const int vb0=(int)(lds0+LDS_V)+((lane>>4)&1)*32+(lane&3)*8+(4*hi+((lane&15)>>2))*64;
  const char*Kbase=shm+LDS_K; bf16x8 kf[8];
  const lds_cptr shm3=(lds_cptr)shm; const lds_cptr kp0=shm3+LDS_K+hi*1024+r32*16; const lds_cptr vp0=shm3+LDS_V+((lane>>4)&1)*32+(lane&3)*8+(4*hi+((lane&15)>>2))*64;
  const lds_cptr mp0=shm3+LDS_MSK+wid*512+r32*8;
  const int NT=(q0+QB)/KVBLK;
  DMA_M(0);DMA_M(1);DMA_K(0,0);DMA_V(0,0);DMA_K(1,SLOTB);
  bf16x8 qr[4];
  #pragma unroll
  for(int d0=0;d0<4;++d0)qr[d0]=*reinterpret_cast<const bf16x8*>(&Qw[(long)r32*DM+d0*16+hi*8]);
  float mhat=0.f,l_reg=0.f;f32x16 o[2];o[0]=f32x16{};o[1]=f32x16{};f32x16 negm=f32x16{};asm volatile("":"+v"(negm));
  const int qrel=wid*QBLK+r32;
  #define CMASK(P0,P1,t) do{}while(0)
  bool resc=false;
  #define START(P0,P1) do{ const float rm=rowmax(P0,P1); resc=false; \
    { const float dl=rm; mhat=fadd_s(mhat,dl); \
      _Pragma("unroll") for(int r=0;r<16;++r){P0[r]=fsub_s(P0[r],dl);P1[r]=fsub_s(P1[r],dl);} \
      _Pragma("unroll") for(int r=0;r<16;++r)negm[r]=-mhat; asm volatile("":"+v"(negm)); } \
    _Pragma("unroll") for(int r=0;r<16;++r)P0[r]=__builtin_amdgcn_exp2f(P0[r]); }while(0)
  #define RESC() do{ if(resc){ asm volatile("s_waitcnt lgkmcnt(0)":::"memory"); \
      _Pragma("unroll") for(int d_=0;d_<2;++d_) _Pragma("unroll") for(int r=0;r<16;++r)o[d_][r]*=wsf[crow(r,hi)]; } }while(0)
  f32x16 pA0,pA1,pB0,pB1;
  int sl_prev=0,sl_cur=0,sl_next=SLOTB;
  #define ROT() do{sl_prev=sl_cur;sl_cur=sl_next;sl_next=(sl_next==(NSLOT-1)*SLOTB)?0:sl_next+SLOTB;}while(0)
  DMA_K(2,2*SLOTB);
  WAIT_BAR(3);
  qkt(pA0,pA1,Kbase,qr,negm,r32,hi);asm volatile("s_nop 15\n\ts_nop 7":"+v"(pA0),"+v"(pA1));
  START(pA0,pA1);
  _Pragma("unroll") for(int r=0;r<16;++r)pA1[r]=__builtin_amdgcn_exp2f(pA1[r]);
  { const unsigned long long mw_=*(lds_u64p)(mp0); const unsigned mwl_=(unsigned)mw_>>(4*hi), mwh_=(unsigned)(mw_>>32)>>(4*hi);
    _Pragma("unroll") for(int r=0;r<16;++r){pA0[r]=MSK(pA0[r],mwl_,BP(r));pA1[r]=MSK(pA1[r],mwh_,BP(r));} }
  WAIT_BAR(0);
  DMA_K(3,0);DMA_V(1,SLOTB);
  ROT();
  kload8(kf,kp0+sl_cur);
  WAIT_BAR(2);
  s16x4 vlo[8],vhi[8]; u32x4 pw0,pw1,pw2,pw3;
  #define PKW(P,B) cvtpk_s(P[B],P[B+1])
  #define PAF(k) __builtin_bit_cast(bf16x8,pw##k)
  #define VFR(i) (bf16x8){vlo[i][0],vlo[i][1],vlo[i][2],vlo[i][3],vhi[i][0],vhi[i][1],vhi[i][2],vhi[i][3]}
  #define PIN(x) asm volatile("":"+v"(x))
  #define MX3(a,b,c) __builtin_fmaxf(__builtin_fmaxf((a),(b)),(c))
  #define GAPA(MF,A0,A1,A2,A3,W0,W1,PW) do{ MF; sacc+=A0; sacc+=A1; sacc+=A2; sacc+=A3; PIN(sacc); W0; W1; PIN(PW); SBAR(); }while(0)
  #define EX(v) __builtin_amdgcn_exp2f(v)
  #define GAPB(MF,X,W,B) do{ MF; X[B]=MSK(EX(X[B]),W,BP(B)); X[B+1]=MSK(EX(X[B+1]),W,BP(B+1)); X[B+2]=MSK(EX(X[B+2]),W,BP(B+2)); X[B+3]=MSK(EX(X[B+3]),W,BP(B+3)); PIN(X); SBAR(); }while(0)
  #define VRD(i) do{ vlo[i]=vtr(vp_+(((i)>>2)*4096+((i)&3)*1024)); vhi[i]=vtr(vp_+(((i)>>2)*4096+((i)&3)*1024+512)); }while(0)
  #define KRD(G,j) do{ if(G){ kload2(kf,kp0+sl_next,j); SBAR(); } }while(0)
  #define STEP(C0,C1,P0,P1,t,GK,GV,GL) do{ SBAR(); \
    if(GV){DMA_M((t)+1);} \
    const unsigned long long mw_=*(lds_u64p)(mp0+(((t)&1)<<8)); const unsigned mwl_=(unsigned)mw_>>(4*hi), mwh_=(unsigned)(mw_>>32)>>(4*hi); \
    const lds_cptr vp_=vp0+sl_prev; \
    VRD(0); SBAR(); float sacc=(P0[0]+P0[1]); \
    GAPA(C0=__builtin_amdgcn_mfma_f32_32x32x16_bf16(kf[0],qr[0],negm,0,0,0), P0[2],P0[3],P0[4],P0[5],     pw0[0]=PKW(P0,0), pw0[1]=PKW(P0,2), pw0); \
    VRD(4); SBAR(); GAPA(C1=__builtin_amdgcn_mfma_f32_32x32x16_bf16(kf[1],qr[0],negm,0,0,0), P0[6],P0[7],P0[8],P0[9],     pw0[2]=PKW(P0,4), pw0[3]=PKW(P0,6), pw0); \
    VRD(1); SBAR(); GAPA(C0=__builtin_amdgcn_mfma_f32_32x32x16_bf16(kf[2],qr[1],C0,0,0,0),   P0[10],P0[11],P0[12],P0[13], pw1[0]=PKW(P0,8), pw1[1]=PKW(P0,10), pw1); \
    VRD(5); SBAR(); GAPA(C1=__builtin_amdgcn_mfma_f32_32x32x16_bf16(kf[3],qr[1],C1,0,0,0),   P0[14],P0[15],P1[0],P1[1],   pw1[2]=PKW(P0,12),pw1[3]=PKW(P0,14), pw1); \
    VRD(2); SBAR(); GAPA(C0=__builtin_amdgcn_mfma_f32_32x32x16_bf16(kf[4],qr[2],C0,0,0,0),   P1[2],P1[3],P1[4],P1[5],     pw2[0]=PKW(P1,0), pw2[1]=PKW(P1,2), pw2); \
    VRD(6); SBAR(); GAPA(C1=__builtin_amdgcn_mfma_f32_32x32x16_bf16(kf[5],qr[2],C1,0,0,0),   P1[6],P1[7],P1[8],P1[9],     pw2[2]=PKW(P1,4), pw2[3]=PKW(P1,6), pw2); \
    VRD(3); SBAR(); GAPA(C0=__builtin_amdgcn_mfma_f32_32x32x16_bf16(kf[6],qr[3],C0,0,0,0),   P1[10],P1[11],P1[12],P1[13], pw3[0]=PKW(P1,8), pw3[1]=PKW(P1,10), pw3); \
    VRD(7); SBAR(); GAPA(C1=__builtin_amdgcn_mfma_f32_32x32x16_bf16(kf[7],qr[3],C1,0,0,0),   P1[14],P1[15],0.f,0.f,       pw3[2]=PKW(P1,12),pw3[3]=PKW(P1,14), pw3); \
    l_reg+=sacc; \
    if(GK){DMA_K((t)+3,sl_cur);} if(GV){DMA_V((t)+1,sl_next);} \
    CMASK(C0,C1,t); \
    { float a=MX3(C0[0],C0[1],C1[0]),b=MX3(C0[2],C0[3],C1[1]); a=MX3(a,C1[2],C1[3]); \
      _Pragma("unroll") for(int r=4;r<16;r+=4){a=MX3(a,C0[r],C0[r+1]);b=MX3(b,C0[r+2],C0[r+3]);a=MX3(a,C1[r],C1[r+1]);b=MX3(b,C1[r+2],C1[r+3]);} \
      float rm=__builtin_fmaxf(a,b); { auto rr=__builtin_amdgcn_permlane32_swap(__float_as_uint(rm),__float_as_uint(rm),false,false); rm=__builtin_fmaxf(__uint_as_float(rr[0]),__uint_as_float(rr[1])); } \
      resc=false; \
      if(__builtin_expect(__any(rm>(float)THRL),0)){ const float dl=__builtin_fmaxf(rm,0.f); mhat+=dl; \
        _Pragma("unroll") for(int r=0;r<16;++r){C0[r]-=dl;C1[r]-=dl;} \
        _Pragma("unroll") for(int r=0;r<16;++r)negm[r]=-mhat; asm volatile("":"+v"(negm)); \
        const float f=__builtin_amdgcn_exp2f(-dl); l_reg*=f; if(hi==0)wsf[r32]=f; resc=true; } } \
    SBAR(); \
    GAPB(o[0]=__builtin_amdgcn_mfma_f32_32x32x16_bf16(PAF(0),VFR(0),o[0],0,0,0), C0,mwl_,0); \
    GAPB(o[1]=__builtin_amdgcn_mfma_f32_32x32x16_bf16(PAF(0),VFR(4),o[1],0,0,0), C0,mwl_,4); \
    KRD(GL,0); GAPB(o[0]=__builtin_amdgcn_mfma_f32_32x32x16_bf16(PAF(1),VFR(1),o[0],0,0,0), C0,mwl_,8); \
    KRD(GL,1); GAPB(o[1]=__builtin_amdgcn_mfma_f32_32x32x16_bf16(PAF(1),VFR(5),o[1],0,0,0), C0,mwl_,12); \
    KRD(GL,2); GAPB(o[0]=__builtin_amdgcn_mfma_f32_32x32x16_bf16(PAF(2),VFR(2),o[0],0,0,0), C1,mwh_,0); \
    KRD(GL,3); GAPB(o[1]=__builtin_amdgcn_mfma_f32_32x32x16_bf16(PAF(2),VFR(6),o[1],0,0,0), C1,mwh_,4); \
    GAPB(o[0]=__builtin_amdgcn_mfma_f32_32x32x16_bf16(PAF(3),VFR(3),o[0],0,0,0), C1,mwh_,8); \
    GAPB(o[1]=__builtin_amdgcn_mfma_f32_32x32x16_bf16(PAF(3),VFR(7),o[1],0,0,0), C1,mwh_,12); \
    }while(0)
  int t=1;
  #undef CMASK
  #define CMASK(P0,P1,t) do{}while(0)
  for(;t+5<NT;t+=2){
    STEP(pB0,pB1,pA0,pA1,t,true,true,true);     WAIT_BAR(2); RESC(); ROT();
    STEP(pA0,pA1,pB0,pB1,t+1,true,true,true);   WAIT_BAR(2); RESC(); ROT();
  }
  #undef CMASK
  #define CMASK(P0,P1,t) do{}while(0)
  #define ENDW(tt) do{ if((tt)+3<NT){WAIT_BAR(2);} else if((tt)+2<NT){WAIT_BAR(1);} else {WAIT_BAR(0);} }while(0)
  for(;t+1<NT;t+=2){
    STEP(pB0,pB1,pA0,pA1,t,(t+3<NT),(t+1<NT),(t+1<NT));       ENDW(t);   RESC(); ROT();
    STEP(pA0,pA1,pB0,pB1,t+1,(t+4<NT),(t+2<NT),(t+2<NT));     ENDW(t+1); RESC(); ROT();
  }
  STEP(pB0,pB1,pA0,pA1,NT-1,false,false,false); RESC();
  { float sacc=pB0[0]+pB0[1]; _Pragma("unroll") for(int r=2;r<16;++r)sacc+=pB0[r]; _Pragma("unroll") for(int r=0;r<16;++r)sacc+=pB1[r]; l_reg+=sacc;
    pw0=(u32x4){PKW(pB0,0),PKW(pB0,2),PKW(pB0,4),PKW(pB0,6)};pw1=(u32x4){PKW(pB0,8),PKW(pB0,10),PKW(pB0,12),PKW(pB0,14)};pw2=(u32x4){PKW(pB1,0),PKW(pB1,2),PKW(pB1,4),PKW(pB1,6)};pw3=(u32x4){PKW(pB1,8),PKW(pB1,10),PKW(pB1,12),PKW(pB1,14)};
    SBAR(); pv(o,vb0+sl_cur,PAF(0),PAF(1),PAF(2),PAF(3)); }
  #undef PKW
  #undef PAF
  #undef VFR
  #undef PIN
  #undef MX3
  #undef GAPA
  #undef GAPB
  #undef EX
  #undef VRD
  #undef KRD
  #undef STEP
  #undef ENDW
  {auto rr=__builtin_amdgcn_permlane32_swap(__float_as_uint(l_reg),__float_as_uint(l_reg),false,false);l_reg=__uint_as_float(rr[0])+__uint_as_float(rr[1]);}
  if(hi==0)wsf[32+r32]=l_reg;asm volatile("s_waitcnt lgkmcnt(0)":::"memory");
  float rli[16];
  #pragma unroll
  for(int r=0;r<16;++r)rli[r]=__builtin_amdgcn_rcpf(wsf[32+crow(r,hi)]);
  bf16*Ow=O+(rowbase+q0+wid*QBLK)*OPITCH+h*D;
  { bf16*stg=(bf16*)(shm+LDS_OST)+wid*2048;
    #pragma unroll
    for(int r=0;r<16;++r){const int orow=crow(r,hi);
      #pragma unroll
      for(int d0=0;d0<2;++d0)stg[orow*64+d0*32+r32]=__float2bfloat16(o[d0][r]*rli[r]);}
    asm volatile("s_waitcnt lgkmcnt(0)":::"memory");
    #pragma unroll
    for(int i=0;i<4;++i){const int row=i*8+(lane>>3),ch=lane&7; const u32x4 v=*(const u32x4*)(stg+row*64+ch*8); bf16*dst=Ow+(long)row*OPITCH+ch*8; const u32x4 g=*(const u32x4*)dst; u32x4 w;
      _Pragma("unroll") for(int e=0;e<4;++e){ const float a0=__uint_as_float(v[e]<<16),a1=__uint_as_float(v[e]&0xffff0000u),g0=__uint_as_float(g[e]<<16),g1=__uint_as_float(g[e]&0xffff0000u); w[e]=cvtpk_s(a0*g0,a1*g1); }
      *(u32x4*)dst=w;} }
  asm volatile("s_waitcnt lgkmcnt(0)\n\ts_barrier":::"memory");
  #undef DMA_K
  #undef DMA_V
  #undef DMA_M
  #undef MSK
  #undef BP
  #undef CMASK
  #undef START
  #undef RESC
  #undef ROT
}
constexpr int ATTN_LDS_BYTES=LDS_BYTES;
struct AttnTensors { const bf16* Q; const bf16* K; const bf16* V; const unsigned* MASK32; bf16* O; };
struct AttnUnit { int bh; int qb; };
struct StaticOrder {
  int vcu,G;
  __device__ __forceinline__ StaticOrder(int grid,int v):vcu(v),G(grid){}
  __device__ __forceinline__ bool next(int i,AttnUnit&u)const{
    if(G==256){ if(i>=2)return false; const int s=vcu&7; u.bh=vcu>>3; u.qb=(i==0)?15-s:s; return true; }
    const long L=(long)i*G+vcu; if(L>=BATCH*NHEAD*NQB)return false; u.qb=NQB-1-(int)(L/(BATCH*NHEAD)); u.bh=(int)(L%(BATCH*NHEAD)); return true; }
  __device__ __forceinline__ void a_ready(const AttnUnit&)const{}
  __device__ __forceinline__ void done(const AttnUnit&)const{}
};
template<class Sched,int THRL=8> __device__ __forceinline__ void attn_phase(char*lds,const AttnTensors&T,const Sched&S){
  AttnUnit u;
  for(int i=0;S.next(i,u);++i){ S.a_ready(u); attn_unit<THRL>(u.bh/NHEAD,u.bh%NHEAD,u.qb,T.Q,T.K,T.V,T.MASK32,T.O,lds); S.done(u); }
}
#undef SBAR
#undef WAIT_BAR
}
namespace sel {
typedef short bf16x8 __attribute__((ext_vector_type(8)));
typedef float f32x16 __attribute__((ext_vector_type(16)));
constexpr int QF_OFF = 0;
constexpr int ROW_OFF = 0;
constexpr int HIST_OFF = 131072;
constexpr int WBUF_OFF = 131072 + 8192;
constexpr int NUNITS = BATCH * (SEQ / 32);
__device__ __forceinline__ unsigned mono(float f) { const unsigned u = __builtin_bit_cast(unsigned, f); return (u & 0x80000000u) ? ~u : (u | 0x80000000u); }
__device__ __forceinline__ void unit_of(int u, int& b, int& j) { j = (SEQ / 32 - 1) - (u >> 2); b = u & 3; }
__device__ __forceinline__ size_t scratch_bytes(int v) { return (size_t)4096 * (size_t)((SEQ / 32) - (v >> 2)); }

__device__ __forceinline__ void unit(int b, int j, unsigned char* ws, float* sc, LAS unsigned char* lds) {
    const int tid = threadIdx.x, lane = tid & 63, wid = __builtin_amdgcn_readfirstlane(tid >> 6), r32 = lane & 31, hi = lane >> 5;
    const int q0 = j * 32, row0 = b * SEQ + q0, nkt = j + 1;
    const bf16_t* IQH = (const bf16_t*)(ws + WS_IQH); const bf16_t* IQL = (const bf16_t*)(ws + WS_IQL);
    const bf16_t* IKH = (const bf16_t*)(ws + WS_IKH); const bf16_t* IKL = (const bf16_t*)(ws + WS_IKL);
#pragma unroll
    for (int i = 0; i < 2; ++i) {
        const int f = tid + 512 * i, h = f >> 8, s = (f >> 6) & 3, l = f & 63, r = l & 31, half = l >> 5;
        const size_t src = (size_t)(row0 + r) * 256 + h * 64 + 16 * s + 8 * half;
        const u32x4 vh = *(const u32x4*)(IQH + src), vl = *(const u32x4*)(IQL + src);
        *(LAS u32x4*)(lds + QF_OFF + ((h * 4 + s) * 2 + 0) * 1024 + l * 16) = vh;
        *(LAS u32x4*)(lds + QF_OFF + ((h * 4 + s) * 2 + 1) * 1024 + l * 16) = vl;
    }
    const f32x4 w = *(const f32x4*)((const float*)(ws + WS_IW) + (size_t)(row0 + r32) * 4);
    __syncthreads();
    for (int kt = wid; kt < nkt; kt += 8) {
        const size_t krow = (size_t)(b * SEQ + kt * 32 + r32) * 64 + 8 * hi;
        bf16x8 kh[4], kl[4];
#pragma unroll
        for (int s = 0; s < 4; ++s) { kh[s] = *(const bf16x8*)(IKH + krow + 16 * s); kl[s] = *(const bf16x8*)(IKL + krow + 16 * s); }
        f32x16 score;
#pragma unroll
        for (int i = 0; i < 16; ++i) score[i] = 0.f;
        int qoff = lane * 16; asm volatile("" : "+v"(qoff));
#pragma unroll
        for (int h = 0; h < 4; ++h) {
            f32x16 acc;
#pragma unroll
            for (int i = 0; i < 16; ++i) acc[i] = 0.f;
#pragma unroll
            for (int s = 0; s < 4; ++s) {
                const bf16x8 qh = *(const LAS bf16x8*)(lds + QF_OFF + ((h * 4 + s) * 2 + 0) * 1024 + qoff);
                const bf16x8 ql = *(const LAS bf16x8*)(lds + QF_OFF + ((h * 4 + s) * 2 + 1) * 1024 + qoff);
                acc = __builtin_amdgcn_mfma_f32_32x32x16_bf16(kh[s], qh, acc, 0, 0, 0);
                acc = __builtin_amdgcn_mfma_f32_32x32x16_bf16(kh[s], ql, acc, 0, 0, 0);
                acc = __builtin_amdgcn_mfma_f32_32x32x16_bf16(kl[s], qh, acc, 0, 0, 0);
            }
            const float wh = w[h];
#pragma unroll
            for (int i = 0; i < 16; ++i) score[i] += wh * fmaxf(acc[i], 0.f);
        }
        float* dst = sc + ((size_t)(kt * 32 + r32) * 32 + 4 * hi);
#pragma unroll
        for (int g = 0; g < 4; ++g) *(f32x4*)(dst + 8 * g) = (f32x4){score[4 * g], score[4 * g + 1], score[4 * g + 2], score[4 * g + 3]};
    }
    asm volatile("s_waitcnt vmcnt(0)" ::: "memory");
    __syncthreads();
    LAS unsigned* hist = (LAS unsigned*)(lds + HIST_OFF + wid * 1024);
    LAS unsigned* rowb = (LAS unsigned*)(lds + ROW_OFF + wid * 16384);
    LAS unsigned long long* wbuf = (LAS unsigned long long*)(lds + WBUF_OFF + wid * 512);
    for (int qi = 0; qi < 4; ++qi) {
        const int qq = wid * 4 + qi, t = q0 + qq, n = t + 1, nj = (n + 63) >> 6, nj8 = (nj + 7) & ~7;
        const float* urow = sc + (size_t)qq * 32 + hi * 1024 + r32;
        for (int j0 = 0; j0 < nj8; j0 += 8) {
            float v[8];
#pragma unroll
            for (int i = 0; i < 8; ++i) v[i] = __builtin_nontemporal_load(urow + (size_t)(j0 + i) * 2048);
            asm volatile("" : "+v"(v[0]), "+v"(v[1]), "+v"(v[2]), "+v"(v[3]), "+v"(v[4]), "+v"(v[5]), "+v"(v[6]), "+v"(v[7]));
#pragma unroll
            for (int i = 0; i < 8; ++i) rowb[(j0 + i) * 64 + lane] = (lane < n - 64 * (j0 + i)) ? mono(v[i]) : 0u;
        }
        unsigned thr = 0u; int need = 1 << 30;
        if (n > TOPK) {
            unsigned prefix = 0u; unsigned kneed = TOPK;
#pragma unroll 1
            for (int p = 0; p < 4; ++p) {
                const int shift = 24 - 8 * p;
                *(LAS u32x4*)(hist + 4 * lane) = (u32x4){0u, 0u, 0u, 0u};
#pragma unroll 4
                for (int jj = 0; jj < nj; ++jj) {
                    const unsigned k = rowb[jj * 64 + lane];
                    const bool part = (k != 0u) && (p == 0 || (k >> (shift + 8)) == prefix);
                    if (part) __hip_atomic_fetch_add(hist + ((k >> shift) & 255u), 1u, __ATOMIC_RELAXED, __HIP_MEMORY_SCOPE_WORKGROUP);
                }
                asm volatile("s_waitcnt lgkmcnt(0)" ::: "memory");
                const u32x4 hv = *(const LAS u32x4*)(hist + 4 * lane);
                const unsigned tot = (hv.x + hv.y) + (hv.z + hv.w);
                unsigned suf = tot;
#pragma unroll
                for (int o = 1; o < 64; o <<= 1) { const unsigned v = __shfl_down(suf, o); if (lane + o < 64) suf += v; }
                const unsigned c3 = suf - tot, c2 = c3 + hv.w, c1 = c2 + hv.z, c0 = c1 + hv.y;
                int fb = -1; unsigned cab = 0u;
                if (c3 < kneed && kneed <= c3 + hv.w) { fb = 3; cab = c3; }
                else if (c2 < kneed && kneed <= c2 + hv.z) { fb = 2; cab = c2; }
                else if (c1 < kneed && kneed <= c1 + hv.y) { fb = 1; cab = c1; }
                else if (c0 < kneed && kneed <= c0 + hv.x) { fb = 0; cab = c0; }
                const unsigned long long fm = __ballot(fb >= 0);
                const int src = (int)__builtin_ctzll(fm | (1ull << 63));
                const unsigned bin = 4u * (unsigned)src + (unsigned)__builtin_amdgcn_readlane(fb, src);
                kneed -= (unsigned)__builtin_amdgcn_readlane((int)cab, src);
                prefix = (prefix << 8) | bin;
                asm volatile("s_waitcnt lgkmcnt(0)" ::: "memory");
            }
            thr = prefix; need = (int)kneed;
        }
        wbuf[lane] = 0ull;
        int eqcnt = 0;
        const unsigned long long lt = (1ull << lane) - 1ull;
        const bool all = (n <= TOPK);
#pragma unroll 2
        for (int jj = 0; jj < nj; ++jj) {
            const unsigned k = rowb[jj * 64 + lane];
            const bool valid = (k != 0u);
            const bool gt = valid && (all || k > thr), eq = valid && !all && k == thr;
            const unsigned long long meq = __ballot(eq);
            const int rank = eqcnt + (int)__popcll(meq & lt);
            const bool selb = gt || (eq && rank < need);
            const unsigned long long bits = __ballot(selb);
            eqcnt += (int)__popcll(meq);
            if (lane == 0) wbuf[jj] = bits;
        }
        asm volatile("s_waitcnt lgkmcnt(0)" ::: "memory");
        ((unsigned long long*)(ws + WS_MASK))[(size_t)(row0 + qq) * 64 + lane] = wbuf[lane];
        asm volatile("s_waitcnt lgkmcnt(0)" ::: "memory");
    }
    __syncthreads();
}

__device__ __forceinline__ void phase(unsigned char* ws, unsigned char* scbase, LAS unsigned char* lds, int G, int v) {
    const int GE = G < 256 ? G : 256;
    if (v >= GE) return;
    size_t off = 0;
    for (int i = 0; i < v; ++i) off += scratch_bytes(i);
    float* sc = (float*)(scbase + off);
    for (int r = 0;; ++r) {
        const int u = (r & 1) ? ((r + 1) * GE - 1 - v) : (r * GE + v);
        if (u >= NUNITS) break;
        int b, j; unit_of(u, b, j);
        unit(b, j, ws, sc, lds);
    }
}
}
namespace gla {
typedef short bf16x8 __attribute__((ext_vector_type(8)));
typedef float f32x16 __attribute__((ext_vector_type(16)));
constexpr int NUNITS = BATCH * 4 * (SEQ / 64);
constexpr int LP = 72;
constexpr int L_GLR = 0, L_WUP = 4096, L_GT = 8192, L_RED = 10240, L_A = 12288, L_B = L_A + 64 * LP * 2, L_V = L_B + 64 * LP * 2, L_A2 = L_V + 128 * LP * 2, L_END = L_A2 + 64 * LP * 2;
__device__ __forceinline__ int crow(int r, int hi) { return (r & 3) + 8 * (r >> 2) + 4 * hi; }

__device__ __forceinline__ void cum_gates(const float* GLR, const float* wup, const float* bias, int tok0, int h, LAS unsigned char* lds, float (&bv)[8], float& blast) {
    const int tid = threadIdx.x, d = tid & 63, tg = tid >> 6;
    LAS float* sg = (LAS float*)(lds + L_GLR); LAS float* sw = (LAS float*)(lds + L_WUP); LAS float* gt = (LAS float*)(lds + L_GT);
#pragma unroll
    for (int i = 0; i < 2; ++i) { const int e = tid + 512 * i; sg[e] = GLR[(size_t)tok0 * 16 + e]; sw[e] = wup[(e >> 6) * 256 + h * 64 + (e & 63)]; }
    __syncthreads();
    float wu[16];
#pragma unroll
    for (int r = 0; r < 16; ++r) wu[r] = sw[r * 64 + d];
    const float bi = bias[h * 64 + d];
    float run = 0.f;
#pragma unroll
    for (int i = 0; i < 8; ++i) {
        const int t = tg * 8 + i;
        float z = bi;
#pragma unroll
        for (int r = 0; r < 16; ++r) z = fmaf(sg[t * 16 + r], wu[r], z);
        const float ls = fminf(z, 0.f) - log1pf(expf(-fabsf(z)));
        run += ls * (1.0f / 16.0f);
        bv[i] = run;
    }
    gt[tg * 64 + d] = run;
    __syncthreads();
    float pre = 0.f, tot = 0.f;
#pragma unroll
    for (int g = 0; g < 8; ++g) { const float v = gt[g * 64 + d]; tot += v; if (g < tg) pre += v; }
#pragma unroll
    for (int i = 0; i < 8; ++i) bv[i] += pre;
    blast = tot;
}
__device__ __forceinline__ void stage_vT(const bf16_t* GV, int tok0, int h, LAS unsigned char* lds) {
    const int tid = threadIdx.x, e = tid & 127, tq = tid >> 7;
    unsigned pk[8];
#pragma unroll
    for (int i = 0; i < 8; ++i) {
        const unsigned lo = GV[(size_t)(tok0 + tq * 16 + 2 * i) * 512 + h * 128 + e], hi = GV[(size_t)(tok0 + tq * 16 + 2 * i + 1) * 512 + h * 128 + e];
        pk[i] = lo | (hi << 16);
    }
    LAS u32x4* dst = (LAS u32x4*)(lds + L_V + (e * LP + tq * 16) * 2);
    dst[0] = (u32x4){pk[0], pk[1], pk[2], pk[3]}; dst[1] = (u32x4){pk[4], pk[5], pk[6], pk[7]};
}

__device__ __forceinline__ void g1_unit(int u, const MkPtrs& P, LAS unsigned char* lds) {
    const int tid = threadIdx.x, lane = tid & 63, wid = __builtin_amdgcn_readfirstlane(tid >> 6), r32 = lane & 31, hi = lane >> 5;
    const int bh = u >> 6, c = u & 63, b = bh >> 2, h = bh & 3, tok0 = b * SEQ + c * 64, d = tid & 63, tg = tid >> 6;
    float bv[8], blast;
    cum_gates(P.GLR, P.wup, P.bias, tok0, h, lds, bv, blast);
    {
        float kl[8];
#pragma unroll
        for (int i = 0; i < 8; ++i) kl[i] = bf2f(P.GK[(size_t)(tok0 + tg * 8 + i) * 256 + h * 64 + d]) * expf(blast - bv[i]);
        *(LAS u32x4*)(lds + L_A + (d * LP + tg * 8) * 2) = (u32x4){pk2(kl[0], kl[1]), pk2(kl[2], kl[3]), pk2(kl[4], kl[5]), pk2(kl[6], kl[7])};
    }
    stage_vT(P.GV, tok0, h, lds);
    if (tid < 64) P.DV[(size_t)u * 64 + tid] = expf(blast);
    __syncthreads();
    {
        const int wd = wid & 1, we = wid >> 1;
        f32x16 acc;
#pragma unroll
        for (int i = 0; i < 16; ++i) acc[i] = 0.f;
#pragma unroll
        for (int s = 0; s < 4; ++s) {
            const bf16x8 af = *(const LAS bf16x8*)(lds + L_A + ((wd * 32 + r32) * LP + 16 * s + 8 * hi) * 2);
            const bf16x8 bf = *(const LAS bf16x8*)(lds + L_V + ((we * 32 + r32) * LP + 16 * s + 8 * hi) * 2);
            acc = __builtin_amdgcn_mfma_f32_32x32x16_bf16(af, bf, acc, 0, 0, 0);
        }
        bf16_t* dst = P.UT + ((size_t)u * 128 + we * 32 + r32) * 64 + wd * 32 + 4 * hi;
#pragma unroll
        for (int g = 0; g < 4; ++g) *(u32x2*)(dst + 8 * g) = (u32x2){pk2(acc[4 * g], acc[4 * g + 1]), pk2(acc[4 * g + 2], acc[4 * g + 3])};
    }
    __syncthreads();
}
__device__ __forceinline__ void g2_item(int item, const MkPtrs& P) {
    const int tid = threadIdx.x, bh = item >> 4, idx = (item & 15) * 512 + tid, d = idx & 63;
    bf16_t* p = P.UT + (size_t)bh * 64 * 8192 + idx; const float* dvp = P.DV + (size_t)bh * 64 * 64 + d;
    float S = 0.f;
#pragma unroll 1
    for (int c0 = 0; c0 < 64; c0 += 16) {
        float uu[16], dd[16];
#pragma unroll
        for (int i = 0; i < 16; ++i) { uu[i] = bf2f(p[(size_t)(c0 + i) * 8192]); dd[i] = dvp[(c0 + i) * 64]; }
        asm volatile("" ::: "memory");
#pragma unroll
        for (int i = 0; i < 16; ++i) { p[(size_t)(c0 + i) * 8192] = f2bf(S); S = fmaf(dd[i], S, uu[i]); }
    }
}
__device__ __forceinline__ void g3_unit(int u, const MkPtrs& P, LAS unsigned char* lds) {
    const int tid = threadIdx.x, lane = tid & 63, wid = __builtin_amdgcn_readfirstlane(tid >> 6), r32 = lane & 31, hi = lane >> 5;
    const int bh = u >> 6, c = u & 63, b = bh >> 2, h = bh & 3, tok0 = b * SEQ + c * 64, d = tid & 63, tg = tid >> 6;
    float bv[8], blast;
    cum_gates(P.GLR, P.wup, P.bias, tok0, h, lds, bv, blast);
    {
        LAS bf16_t* qa = (LAS bf16_t*)(lds + L_A); LAS bf16_t* kb = (LAS bf16_t*)(lds + L_B);
#pragma unroll
        for (int i = 0; i < 8; ++i) {
            const int t = tg * 8 + i; const size_t g = (size_t)(tok0 + t) * 256 + h * 64 + d;
            qa[t * LP + d] = f2bf(bf2f(P.GQ[g]) * 0.125f * expf(bv[i]));
            kb[t * LP + d] = f2bf(bf2f(P.GK[g]) * expf(-bv[i]));
        }
    }
    stage_vT(P.GV, tok0, h, lds);
    __syncthreads();
    if (wid < 4) {
        const int ss = wid & 1, tt = wid >> 1;
        f32x16 acc;
#pragma unroll
        for (int i = 0; i < 16; ++i) acc[i] = 0.f;
        if (ss <= tt) {
#pragma unroll
            for (int s = 0; s < 4; ++s) {
                const bf16x8 af = *(const LAS bf16x8*)(lds + L_B + ((ss * 32 + r32) * LP + 16 * s + 8 * hi) * 2);
                const bf16x8 bf = *(const LAS bf16x8*)(lds + L_A + ((tt * 32 + r32) * LP + 16 * s + 8 * hi) * 2);
                acc = __builtin_amdgcn_mfma_f32_32x32x16_bf16(af, bf, acc, 0, 0, 0);
            }
        }
        const int t = tt * 32 + r32;
#pragma unroll
        for (int g = 0; g < 4; ++g) {
            float x[4];
#pragma unroll
            for (int e = 0; e < 4; ++e) { const int s = ss * 32 + 8 * g + 4 * hi + e; x[e] = (s <= t) ? acc[4 * g + e] : 0.f; }
            *(LAS u32x2*)(lds + L_A2 + (t * LP + ss * 32 + 8 * g + 4 * hi) * 2) = (u32x2){pk2(x[0], x[1]), pk2(x[2], x[3])};
        }
    }
    __syncthreads();
    const int ee = wid >> 1, tt = wid & 1;
    f32x16 o;
#pragma unroll
    for (int i = 0; i < 16; ++i) o[i] = 0.f;
    {
        const bf16_t* st = P.UT + ((size_t)u * 128 + ee * 32 + r32) * 64 + 8 * hi;
#pragma unroll
        for (int s = 0; s < 4; ++s) {
            const bf16x8 af = *(const bf16x8*)(st + 16 * s);
            const bf16x8 bf = *(const LAS bf16x8*)(lds + L_A + ((tt * 32 + r32) * LP + 16 * s + 8 * hi) * 2);
            o = __builtin_amdgcn_mfma_f32_32x32x16_bf16(af, bf, o, 0, 0, 0);
        }
#pragma unroll
        for (int s = 0; s < 4; ++s) {
            const bf16x8 af = *(const LAS bf16x8*)(lds + L_V + ((ee * 32 + r32) * LP + 16 * s + 8 * hi) * 2);
            const bf16x8 bf = *(const LAS bf16x8*)(lds + L_A2 + ((tt * 32 + r32) * LP + 16 * s + 8 * hi) * 2);
            o = __builtin_amdgcn_mfma_f32_32x32x16_bf16(af, bf, o, 0, 0, 0);
        }
    }
    float ssq = 0.f;
#pragma unroll
    for (int i = 0; i < 16; ++i) ssq = fmaf(o[i], o[i], ssq);
    ssq += __shfl_xor(ssq, 32);
    LAS float* red = (LAS float*)(lds + L_RED);
    const int t = tt * 32 + r32;
    if (hi == 0) red[ee * 64 + t] = ssq;
    __syncthreads();
    const float tot = (red[t] + red[64 + t]) + (red[128 + t] + red[192 + t]);
    const float rs = 1.0f / sqrtf(tot * (1.0f / 128.0f) + NORM_EPS);
    bf16_t* mrow = P.MIX + (size_t)(tok0 + t) * 1024 + 512 + h * 128 + ee * 32 + 4 * hi;
    const float* gw = P.gnw + ee * 32 + 4 * hi;
#pragma unroll
    for (int g = 0; g < 4; ++g) {
        const u32x2 gg = *(const u32x2*)(mrow + 8 * g);
        const f32x4 w4 = *(const f32x4*)(gw + 8 * g);
        const float y0 = o[4 * g] * rs * w4[0] * __builtin_bit_cast(float, gg.x << 16), y1 = o[4 * g + 1] * rs * w4[1] * __builtin_bit_cast(float, gg.x & 0xffff0000u);
        const float y2 = o[4 * g + 2] * rs * w4[2] * __builtin_bit_cast(float, gg.y << 16), y3 = o[4 * g + 3] * rs * w4[3] * __builtin_bit_cast(float, gg.y & 0xffff0000u);
        *(u32x2*)(mrow + 8 * g) = (u32x2){pk2(y0, y1), pk2(y2, y3)};
    }
    __syncthreads();
}
}
constexpr int MK_LDS = 147456;
constexpr int N_PHASES = 9;
struct MkArgs { const float* x; const int* pos; const float* w_in; const float* wup; const float* bgate; const float* gnw; const float* w_out; const float* prew; const float* postw;
                float* out; unsigned char* ws; int ph_lo, ph_hi; };
__global__ void __launch_bounds__(512, 2) mk_fwd(MkArgs a) {
    extern __shared__ __attribute__((aligned(16))) unsigned char lds_raw[];
    LAS unsigned char* lds = (LAS unsigned char*)lds_raw;
    cg::grid_group grid = cg::this_grid();
    const int tid = threadIdx.x, lane = tid & 63, wave = __builtin_amdgcn_readfirstlane(tid >> 6);
    const int G = gridDim.x, bx = blockIdx.x;
    const int vcu = (G % 8 == 0) ? (bx % 8) * (G / 8) + bx / 8 : bx;
    unsigned char* ws = a.ws;
    const MkPtrs PT{(const float*)(ws + WS_GLR), a.wup, a.bgate, a.gnw, (const bf16_t*)(ws + WS_GQ), (const bf16_t*)(ws + WS_GK), (const bf16_t*)(ws + WS_GV),
                    (bf16_t*)(ws + WS_UT), (float*)(ws + WS_DV), (bf16_t*)(ws + WS_MIX)};
#define IN(k) (a.ph_lo <= (k) && (k) < a.ph_hi)
#define SEAM(k) do { if (IN(k) && IN((k) + 1)) grid.sync(); } while (0)
    if (IN(0)) {
        LAS float* scr = (LAS float*)(lds + wave * 16384);
        const int gw = vcu * 8 + wave, NGW = G * 8;
        constexpr int I_W1 = 16 * (NF / 32), I_W2 = 16 * (DM / 32);
        for (int it = gw; it < I_W1 + I_W2; it += NGW) {
            if (it < I_W1) p0_transpose_item<true>(a.w_in, NPROJ, a.prew, (bf16_t*)(ws + WS_W1T), (bf16_t*)(ws + WS_W1L), scr, it, NF / 32, lane);
            else p0_transpose_item<false>(a.w_out, DM, nullptr, (bf16_t*)(ws + WS_W2T), nullptr, scr, it - I_W1, DM / 32, lane);
        }
        for (int row = gw; row < M; row += NGW) p0_row(a.x, a.pos, ws, row, lane);
    }
    SEAM(0);
    if (IN(1)) {
        ProbProj P{(const bf16_t*)(ws + WS_XH), (const bf16_t*)(ws + WS_XL), (const bf16_t*)(ws + WS_W1T), (const bf16_t*)(ws + WS_W1L)};
        SchedProj S{G, vcu};
        EpiProj E{ws};
        pg8::gemm_phase<EpiProj, SchedProj, ProbProj, true>(lds, P, S, E);
    }
    SEAM(1);
    if (IN(2)) { for (int u = vcu; u < gla::NUNITS; u += G) gla::g1_unit(u, PT, lds); }
    SEAM(2);
    if (IN(3)) { for (int it = vcu; it < 256; it += G) gla::g2_item(it, PT); }
    SEAM(3);
    if (IN(4)) { for (int u = vcu; u < gla::NUNITS; u += G) gla::g3_unit(u, PT, lds); }
    SEAM(4);
    if (IN(5)) sel::phase(ws, ws + WS_SC, lds, G, vcu);
    SEAM(5);
    if (IN(6)) {
        const attn_body::AttnTensors AT{(const attn_body::bf16*)(ws + WS_Q), (const attn_body::bf16*)(ws + WS_K), (const attn_body::bf16*)(ws + WS_V), (const unsigned*)(ws + WS_MASK), (attn_body::bf16*)(ws + WS_MIX)};
        const attn_body::StaticOrder S(G, vcu);
        attn_body::attn_phase<attn_body::StaticOrder>((char*)lds_raw, AT, S);
    }
    SEAM(6);
    if (IN(7)) {
        ProbOut P{(const bf16_t*)(ws + WS_MIX), (const bf16_t*)(ws + WS_W2T)};
        SchedOut S{G, vcu};
        EpiY E{(float*)(ws + WS_TMP)};
        pg8::gemm_phase<EpiY, SchedOut, ProbOut, false>(lds, P, S, E);
    }
    SEAM(7);
    if (IN(8)) {
        const int gw = vcu * 8 + wave, NGW = G * 8;
        for (int row = gw; row < M; row += NGW) p6_row(a.x, (const float*)(ws + WS_TMP), a.postw, a.out, row, lane);
    }
#undef IN
#undef SEAM
}

#ifndef MK_CUTS
#define MK_CUTS {0, 9}
#endif
extern "C" void kernel_launch(void* const* d_in, const int* in_sizes, int n_in, void* d_out, int out_size, void* d_ws, size_t ws_size, hipStream_t stream) {
    const float* x = (const float*)d_in[0]; const int* pos = (const int*)d_in[1]; const float* w_in = (const float*)d_in[2];
    const float* wup = (const float*)d_in[3]; const float* bgate = (const float*)d_in[4]; const float* gnw = (const float*)d_in[5];
    const float* w_out = (const float*)d_in[6]; const float* prew = (const float*)d_in[7]; const float* postw = (const float*)d_in[8];
    unsigned char* ws = (unsigned char*)d_ws; float* out = (float*)d_out;
    static int grid_blocks = 0;
    if (!grid_blocks) {
        int dev = 0, cus = 0, per_cu = 0;
        (void)hipGetDevice(&dev);
        (void)hipDeviceGetAttribute(&cus, hipDeviceAttributeMultiprocessorCount, dev);
        (void)hipFuncSetAttribute((const void*)mk_fwd, hipFuncAttributeMaxDynamicSharedMemorySize, MK_LDS);
        (void)hipOccupancyMaxActiveBlocksPerMultiprocessor(&per_cu, (const void*)mk_fwd, 512, MK_LDS);
        if (per_cu < 1) per_cu = 1;
        grid_blocks = cus * per_cu;
    }
    auto launch = [&](int lo, int hi) {
        MkArgs a{}; a.x = x; a.pos = pos; a.w_in = w_in; a.wup = wup; a.bgate = bgate; a.gnw = gnw; a.w_out = w_out; a.prew = prew; a.postw = postw;
        a.out = out; a.ws = ws; a.ph_lo = lo; a.ph_hi = hi;
        void* args[] = {&a};
        hipError_t e = hipLaunchCooperativeKernel((const void*)mk_fwd, dim3(grid_blocks), dim3(512), args, MK_LDS, stream);
        if (e != hipSuccess) fprintf(stderr, "cooperative launch [%d,%d) failed: %s (grid %d)\n", lo, hi, hipGetErrorString(e), grid_blocks);
    };
    const int cuts[] = MK_CUTS;
    for (int i = 0; i + 1 < (int)(sizeof(cuts) / sizeof(cuts[0])); ++i) launch(cuts[i], cuts[i + 1]);
}
```

```cpp
#include <hip/hip_runtime.h>
#include <hip/hip_cooperative_groups.h>
#include <stdint.h>
#include <cstdio>
namespace cg = cooperative_groups;

constexpr int BATCH = 4, SEQ = 4096, M = BATCH * SEQ, DM = 1024, NPROJ = 3924;
constexpr int OFF_AQ = 0, OFF_AK = 512, OFF_AV = 1024, OFF_IQ = 1536, OFF_IK = 1792, OFF_IW = 1856, OFF_AG = 1860,
              OFF_GQ = 2372, OFF_GK = 2628, OFF_GV = 2884, OFF_GLR = 3396, OFF_GG = 3412;
constexpr int TOPK = 256;
constexpr float NORM_EPS = 1e-6f;
constexpr float C2 = 0.125f * 1.4426950408889634f;
constexpr int NF = 4096;

constexpr size_t MiB = 1u << 20;
constexpr size_t WS_CTL = 0, WS_RSTD = 1 * MiB, WS_ROPE = 2 * MiB, WS_W2T = 3 * MiB, WS_Q = 6 * MiB, WS_K = 22 * MiB, WS_V = 38 * MiB, WS_MIX = 54 * MiB,
                 WS_GQ = 86 * MiB, WS_GK = 94 * MiB, WS_GV = 102 * MiB, WS_IQH = 118 * MiB, WS_IQL = 126 * MiB, WS_IKH = 134 * MiB, WS_IKL = 136 * MiB, WS_IW = 138 * MiB, WS_GLR = 139 * MiB,
                 WS_MASK = 140 * MiB, WS_XH = 148 * MiB, WS_XL = 180 * MiB, WS_W1T = 212 * MiB, WS_W1L = 220 * MiB, WS_TMP = 148 * MiB, WS_SC = 148 * MiB, WS_UT = 148 * MiB, WS_DV = 166 * MiB, WS_DUMMY = 180 * MiB;

constexpr int CW_BAR = 4096;
constexpr size_t CTL_ZERO_BYTES = 65536;
typedef unsigned short bf16_t;
#define LAS __attribute__((address_space(3)))
__device__ __forceinline__ unsigned f2bf_u(float f) { unsigned u = __builtin_bit_cast(unsigned, f); return (u + 0x7fffu + ((u >> 16) & 1u)) >> 16; }
__device__ __forceinline__ bf16_t f2bf(float f) { return (bf16_t)f2bf_u(f); }
__device__ __forceinline__ float bf2f(bf16_t b) { return __builtin_bit_cast(float, (unsigned)b << 16); }
__device__ __forceinline__ unsigned pk2(float lo, float hi) { return f2bf_u(lo) | (f2bf_u(hi) << 16); }
__device__ __forceinline__ float wave_sum(float v) {
#pragma unroll
    for (int o = 1; o < 64; o <<= 1) v += __shfl_xor(v, o);
    return v;
}
__device__ __forceinline__ float silu(float x) { return x / (1.f + __expf(-x)); }
__device__ __forceinline__ int cmap(int n) {
    if (n < 512) return OFF_AQ + n;
    if (n < 1024) return OFF_AK + (n - 512);
    if (n < 1536) return OFF_AV + (n - 1024);
    if (n < 2048) return OFF_AG + (n - 1536);
    if (n < 2304) return OFF_GQ + (n - 2048);
    if (n < 2560) return OFF_GK + (n - 2304);
    if (n < 3072) return OFF_GV + (n - 2560);
    if (n < 3584) return OFF_GG + (n - 3072);
    if (n < 3840) return OFF_IQ + (n - 3584);
    const int l = n - 3840;
    if (l < 64) return OFF_IK + l;
    if (l < 68) return OFF_IW + (l - 64);
    if (l >= 72 && l < 88) return OFF_GLR + (l - 72);
    return -1;
}

struct MkPtrs { const float* GLR; const float* wup; const float* bias; const float* gnw; const bf16_t* GQ; const bf16_t* GK; const bf16_t* GV; bf16_t* UT; float* DV; bf16_t* MIX; };
#define XB_TMO      128
#define XB_XCNT(j)  (256  + 64 * (j))
#define XB_XSUB(j)  (1280 + 64 * (j))
#define XB_XGEN(j)  (2304 + 64 * (j))
#define XB_TOP      3328
#define XB_TOPGEN   3392
#define XCD_BAR_WORDS 3456
#define XB_SPIN_CAP (1u << 18)

__device__ __forceinline__ unsigned xb_ld(unsigned* p)              { return __hip_atomic_load(p, __ATOMIC_RELAXED, __HIP_MEMORY_SCOPE_AGENT); }
__device__ __forceinline__ unsigned xb_add(unsigned* p, unsigned v) { return __hip_atomic_fetch_add(p, v, __ATOMIC_RELAXED, __HIP_MEMORY_SCOPE_AGENT); }
__device__ __forceinline__ unsigned xb_xcc_id() { return (unsigned)__builtin_amdgcn_s_getreg((3 << 11) | 20) & 0xFu; }
#define XB_SPIN(cond, bar) do { unsigned _sp = 0; while (cond) { __builtin_amdgcn_s_sleep(1); \
    if ((++_sp & 255u) == 0u) { if (xb_ld(&(bar)[XB_TMO])) break; if (_sp > XB_SPIN_CAP) { atomicAdd(&(bar)[XB_TMO], 1u); break; } } } } while (0)

struct XcdBarrier {
    unsigned* bar; unsigned x;
    volatile LAS unsigned* st;
};

__device__ __forceinline__ XcdBarrier xcd_barrier_post(unsigned* bar, volatile LAS unsigned* st) {
    XcdBarrier b; b.bar = bar; b.x = xb_xcc_id(); b.st = st;
    if (threadIdx.x == 0) (void)xb_add(&bar[XB_XCNT(b.x)], 1u);
    return b;
}
__device__ __forceinline__ void xcd_barrier_complete(unsigned* bar, unsigned x, unsigned& nloc, unsigned& nx) {
    const unsigned G = gridDim.x * gridDim.y * gridDim.z;
    unsigned sum, cnt, mine, sp = 0u;
    for (;;) {
        sum = 0u; cnt = 0u; mine = 0u;
#pragma unroll
        for (unsigned j = 0; j < 16; ++j) { const unsigned c = xb_ld(&bar[XB_XCNT(j)]); sum += c; cnt += (c > 0u) ? 1u : 0u; mine = (j == x) ? c : mine; }
        if (sum == G) break;
        __builtin_amdgcn_s_sleep(1);
        if ((++sp & 255u) == 0u) { if (xb_ld(&bar[XB_TMO])) break; if (sp > XB_SPIN_CAP) { atomicAdd(&bar[XB_TMO], 1u); break; } }
    }
    nloc = mine > 0u ? mine : 1u; nx = cnt > 0u ? cnt : 1u;
}

__device__ __forceinline__ void xcd_barrier(const XcdBarrier& b) {
    asm volatile("s_waitcnt vmcnt(0)" ::: "memory");
    __syncthreads();
    if (threadIdx.x == 0) {
        unsigned* bar = b.bar;
        __builtin_amdgcn_s_waitcnt(0);
        unsigned nloc = b.st[0], nx = b.st[1];
        if (nloc == 0u) { xcd_barrier_complete(bar, b.x, nloc, nx); b.st[0] = nloc; b.st[1] = nx; }
        const unsigned old = xb_add(&bar[XB_XSUB(b.x)], 1u);
        const unsigned gen = old / nloc;
        if (old + 1u == (gen + 1u) * nloc) {
            __builtin_amdgcn_fence(__ATOMIC_RELEASE, "agent");
            asm volatile("s_waitcnt vmcnt(0)" ::: "memory");
            const unsigned og = xb_add(&bar[XB_TOP], 1u);
            const unsigned tg = og / nx;
            if (og + 1u == (tg + 1u) * nx) xb_add(&bar[XB_TOPGEN], 1u);
            else XB_SPIN(xb_ld(&bar[XB_TOPGEN]) == tg, bar);
            __builtin_amdgcn_fence(__ATOMIC_ACQUIRE, "agent");
            xb_add(&bar[XB_XGEN(b.x)], 1u);
            asm volatile("s_waitcnt vmcnt(0)" ::: "memory");
        } else {
            XB_SPIN(xb_ld(&bar[XB_XGEN(b.x)]) == gen, bar);
            __builtin_amdgcn_fence(__ATOMIC_ACQUIRE, "agent");
            asm volatile("s_waitcnt vmcnt(0)" ::: "memory");
        }
    }
    __syncthreads();
}
namespace pg8 {
typedef short bf16x8 __attribute__((ext_vector_type(8)));
typedef float f32x4 __attribute__((ext_vector_type(4)));
typedef unsigned u32x4 __attribute__((ext_vector_type(4)));
constexpr int BM = 256, BK = 64, HALF = 128, HTB = HALF * BK * 2, STAGE_BYTES = 8 * HTB, KP = 1024  ;
__host__ __device__ __forceinline__ int lds_byte(int r, int c) { const int st = (r >> 4) * 2 + (c >> 5), rr = r & 15, cc = c & 31, ob = rr * 64 + cc * 2; return st * 1024 + (ob ^ (((ob >> 9) & 1) << 5)); }
__host__ __device__ __forceinline__ void stage_rc(int b, int& R, int& C) { const int st = b / 1024, sb = b % 1024, swz = sb ^ (((sb >> 9) & 1) << 5); R = (st >> 1) * 16 + swz / 64; C = (st & 1) * 32 + (swz % 64) / 2; }
__host__ __device__ __forceinline__ int perm32(int rho) { const int n = rho >> 4, i = rho & 15; return 8 * (i >> 2) + 4 * n + (i & 3); }
struct Unit { int pm, pn, kind; };

template <class Epi, class Sched, class Prob, bool ALIGN_EPI>
__device__ __forceinline__ void gemm_phase(LAS unsigned char* lds, const Prob& P, const Sched& S, const Epi& E) {
    const int tid = threadIdx.x, wid = __builtin_amdgcn_readfirstlane(tid >> 6), lane = tid & 63, wr = wid >> 2, wc = wid & 3, fr = lane & 15, fq = lane >> 4;
    unsigned voffA[2], voffB[2];
#pragma unroll
    for (int i = 0; i < 2; ++i) { int R, C; stage_rc(tid * 16 + i * 8192, R, C); const int Rb = Epi::PERM ? ((R & ~31) + perm32(R & 31)) : R;
        voffA[i] = (unsigned)(R * KP + C) * 2u; voffB[i] = (unsigned)(Rb * KP + C) * 2u; }
    const size_t hstep = (size_t)HALF * KP * 2;
    const unsigned ldsw = (unsigned)wid * 1024u;
    const int aoff = lds_byte(wr * 64 + fr, fq * 8), boff = lds_byte(wc * 32 + fr, fq * 8);
#define PG8_SA(b, h) (((b) * 2 + (h)) * HTB)
#define PG8_SB(b, h) ((4 + (b) * 2 + (h)) * HTB)
#define PG8_STAGE(bufoff, gbase, voff) do { _Pragma("unroll") for (int _i = 0; _i < 2; ++_i) \
        __builtin_amdgcn_global_load_lds((const unsigned*)((const char*)(gbase) + (voff)[_i]), (LAS unsigned*)(lds + (bufoff) + ldsw + _i * 8192), 16, 0, 0); } while (0)
#define PG8_LDA(dst, b, h) do { _Pragma("unroll") for (int m = 0; m < 4; ++m) _Pragma("unroll") for (int k = 0; k < 2; ++k) dst[m][k] = *(const LAS bf16x8*)(lds + PG8_SA(b, h) + aoff + m * 2048 + k * 1024); } while (0)
#define PG8_LDB(dst, b, h) do { _Pragma("unroll") for (int n = 0; n < 2; ++n) _Pragma("unroll") for (int k = 0; k < 2; ++k) dst[n][k] = *(const LAS bf16x8*)(lds + PG8_SB(b, h) + boff + n * 2048 + k * 1024); } while (0)
#define PG8_MMA(ai, bj, At, Bt) do { __builtin_amdgcn_s_setprio(1); _Pragma("unroll") for (int m = 0; m < 4; ++m) _Pragma("unroll") for (int n = 0; n < 2; ++n) _Pragma("unroll") for (int k = 0; k < 2; ++k) \
        acc[ai][bj][m][n] = __builtin_amdgcn_mfma_f32_16x16x32_bf16(Bt[n][k], At[m][k], acc[ai][bj][m][n], 0, 0, 0); __builtin_amdgcn_s_setprio(0); } while (0)
#define PG8_WAIT_V(n) asm volatile("s_waitcnt vmcnt(" #n ")" ::: "memory")
#define PG8_WAIT_L(n) asm volatile("s_waitcnt lgkmcnt(" #n ")" ::: "memory")
#define PG8_BAR __builtin_amdgcn_s_barrier()
#define PG8_SCHED __builtin_amdgcn_sched_barrier(0)
    Unit cur, nxt; int ui = 0;
    if (!S.next(0, cur)) return;
    f32x4 acc[2][2][4][2];
#pragma unroll
    for (int a = 0; a < 2; ++a)
#pragma unroll
        for (int b = 0; b < 2; ++b)
#pragma unroll
            for (int m = 0; m < 4; ++m)
#pragma unroll
                for (int n = 0; n < 2; ++n) acc[a][b][m][n] = (f32x4){0.f, 0.f, 0.f, 0.f};
    bf16x8 At[4][2], B0[2][2], B1[2][2];
    {
        const char* a0 = P.a(cur, 0); const char* b0 = P.b(cur, 0); const char* a1 = P.a(cur, 1); const char* b1 = P.b(cur, 1);
        PG8_STAGE(PG8_SB(0, 0), b0, voffB); PG8_STAGE(PG8_SB(0, 1), b0 + hstep, voffB); PG8_STAGE(PG8_SA(0, 0), a0, voffA); PG8_STAGE(PG8_SA(0, 1), a0 + hstep, voffA);
        if (wr == 1) PG8_BAR;
        PG8_WAIT_V(2); PG8_BAR;
        PG8_STAGE(PG8_SB(1, 0), b1, voffB); PG8_STAGE(PG8_SA(1, 0), a1, voffA); PG8_STAGE(PG8_SB(1, 1), b1 + hstep, voffB);
        PG8_WAIT_V(6); PG8_BAR;
    }
    for (;;) {
        const bool has_next = S.next(ui + 1, nxt);
        const Unit nu = has_next ? nxt : cur;
        const int nt = P.nt(cur);
        for (int t = 0; t < nt; t += 2) {
            const bool last = (t == nt - 2);
            const char* a1 = P.a(cur, t + 1);
            const char* a2 = last ? P.a(nu, 0) : P.a(cur, t + 2); const char* b2 = last ? P.b(nu, 0) : P.b(cur, t + 2);
            const char* a3 = last ? P.a(nu, 1) : P.a(cur, t + 3); const char* b3 = last ? P.b(nu, 1) : P.b(cur, t + 3);
            PG8_LDB(B0, 0, 0); PG8_LDB(B1, 0, 1); PG8_SCHED; PG8_LDA(At, 0, 0); PG8_STAGE(PG8_SA(1, 1), a1 + hstep, voffA);
            PG8_WAIT_V(8); PG8_WAIT_L(0); PG8_BAR; PG8_MMA(0, 0, At, B0); PG8_MMA(0, 1, At, B1); PG8_BAR; PG8_SCHED;
            PG8_LDA(At, 0, 1); PG8_STAGE(PG8_SB(0, 0), b2, voffB); PG8_STAGE(PG8_SB(0, 1), b2 + hstep, voffB); PG8_STAGE(PG8_SA(0, 0), a2, voffA);
            PG8_WAIT_V(8); PG8_WAIT_L(0); PG8_BAR; PG8_MMA(1, 0, At, B0); PG8_MMA(1, 1, At, B1); PG8_BAR; PG8_SCHED;
            PG8_LDB(B0, 1, 0); PG8_LDB(B1, 1, 1); PG8_SCHED; PG8_LDA(At, 1, 0); PG8_STAGE(PG8_SA(0, 1), a2 + hstep, voffA);
            PG8_WAIT_V(8); PG8_WAIT_L(0); PG8_BAR; PG8_MMA(0, 0, At, B0); PG8_MMA(0, 1, At, B1); PG8_BAR; PG8_SCHED;
            PG8_LDA(At, 1, 1); PG8_STAGE(PG8_SB(1, 0), b3, voffB); PG8_STAGE(PG8_SB(1, 1), b3 + hstep, voffB); PG8_STAGE(PG8_SA(1, 0), a3, voffA);
            PG8_WAIT_V(8); PG8_WAIT_L(0); PG8_BAR; PG8_MMA(1, 0, At, B0); PG8_MMA(1, 1, At, B1); PG8_BAR; PG8_SCHED;
        }
        if constexpr (ALIGN_EPI) { if (wr == 0) PG8_BAR; }
        if constexpr (!Epi::AFTER_DRAIN) { E(acc, cur, wr, wc, fr, fq); }
        if (!has_next) break;
#pragma unroll
        for (int a = 0; a < 2; ++a)
#pragma unroll
            for (int b = 0; b < 2; ++b)
#pragma unroll
                for (int m = 0; m < 4; ++m)
#pragma unroll
                    for (int n = 0; n < 2; ++n) acc[a][b][m][n] = (f32x4){0.f, 0.f, 0.f, 0.f};
        cur = nxt; ++ui;
        if constexpr (ALIGN_EPI) { if (wr == 1) PG8_BAR; }
    }
    PG8_WAIT_V(0);
    if constexpr (!ALIGN_EPI) { if (wr == 0) PG8_BAR; }
    PG8_BAR;
    if constexpr (Epi::AFTER_DRAIN) { E.fused(acc, cur, wr, wc, fr, fq, lds, wid, lane); }
#undef PG8_SA
#undef PG8_SB
#undef PG8_STAGE
#undef PG8_LDA
#undef PG8_LDB
#undef PG8_MMA
#undef PG8_WAIT_V
#undef PG8_WAIT_L
#undef PG8_BAR
#undef PG8_SCHED
}
}
typedef float f32x4 __attribute__((ext_vector_type(4)));
typedef unsigned u32x4 __attribute__((ext_vector_type(4)));
typedef unsigned u32x2 __attribute__((ext_vector_type(2)));

struct ProbProj {
    const bf16_t *XH, *XL, *W1T, *W1L;
    __device__ __forceinline__ int nt(const pg8::Unit& u) const { return u.kind ? 48 : 16; }
    __device__ __forceinline__ const char* a(const pg8::Unit& u, int t) const {
        const bf16_t* base = (u.kind && t >= 16 && t < 32) ? XL : XH;
        return (const char*)(base + (size_t)u.pm * 256 * pg8::KP) + (size_t)(t & 15) * 128; }
    __device__ __forceinline__ const char* b(const pg8::Unit& u, int t) const {
        const bf16_t* base = (u.kind && t >= 32) ? (W1L + (size_t)(u.pn - 14) * 256 * pg8::KP) : (W1T + (size_t)u.pn * 256 * pg8::KP);
        return (const char*)base + (size_t)(t & 15) * 128; }
};
struct SchedProj {
    int G, c;
    __device__ __forceinline__ bool next(int i, pg8::Unit& u) const {
        if (G == 256) {
            const int role = c & 3; u.pm = c >> 2;
            if (role < 2) { if (i >= 3) return false; if (i == 0) { u.pn = 14 + role; u.kind = 1; } else { u.pn = role * 2 + (i - 1); u.kind = 0; } }
            else { if (i >= 5) return false; u.pn = 4 + (role - 2) * 5 + i; u.kind = 0; }
            return true;
        }
        const long L = (long)i * G + c; if (L >= 64 * 16) return false;
        const int pn = 15 - (int)(L / 64); u.pm = (int)(L % 64); u.pn = pn; u.kind = pn >= 14 ? 1 : 0; return true;
    }
};
__device__ __forceinline__ void split_store8(const f32x4& v0, const f32x4& v1, bf16_t* ph, bf16_t* pl) {
    u32x4 h; h.x = pk2(v0[0], v0[1]); h.y = pk2(v0[2], v0[3]); h.z = pk2(v1[0], v1[1]); h.w = pk2(v1[2], v1[3]);
    f32x4 l0, l1;
    l0[0] = v0[0] - __builtin_bit_cast(float, h.x << 16); l0[1] = v0[1] - __builtin_bit_cast(float, h.x & 0xffff0000u);
    l0[2] = v0[2] - __builtin_bit_cast(float, h.y << 16); l0[3] = v0[3] - __builtin_bit_cast(float, h.y & 0xffff0000u);
    l1[0] = v1[0] - __builtin_bit_cast(float, h.z << 16); l1[1] = v1[1] - __builtin_bit_cast(float, h.z & 0xffff0000u);
    l1[2] = v1[2] - __builtin_bit_cast(float, h.w << 16); l1[3] = v1[3] - __builtin_bit_cast(float, h.w & 0xffff0000u);
    u32x4 l; l.x = pk2(l0[0], l0[1]); l.y = pk2(l0[2], l0[3]); l.z = pk2(l1[0], l1[1]); l.w = pk2(l1[2], l1[3]);
    *(u32x4*)ph = h; *(u32x4*)pl = l;
}
struct EpiProj {
    static constexpr bool PERM = true, AFTER_DRAIN = false;
    unsigned char* ws;
    __device__ __forceinline__ void operator()(const f32x4 (&acc)[2][2][4][2], const pg8::Unit& u, int wr, int wc, int fr, int fq) const {
        const int pn = u.pn;
        const float* rstd = (const float*)(ws + WS_RSTD); const float* rope = (const float*)(ws + WS_ROPE);
        const bool rope_tile = (pn < 4) || (pn >= 14);
        const bool rope_wave = rope_tile && ((wc & 1) == 0);
        int mode, ld, coloff; unsigned char* base; float sc = 1.f;
        if (pn < 2)       { mode = 0; base = ws + WS_Q;   ld = 512;  coloff = pn * 256; sc = C2; }
        else if (pn < 4)  { mode = 0; base = ws + WS_K;   ld = 512;  coloff = (pn - 2) * 256; }
        else if (pn < 6)  { mode = 0; base = ws + WS_V;   ld = 512;  coloff = (pn - 4) * 256; }
        else if (pn < 8)  { mode = 1; base = ws + WS_MIX; ld = 1024; coloff = (pn - 6) * 256; }
        else if (pn == 8) { mode = 0; base = ws + WS_GQ;  ld = 256;  coloff = 0; }
        else if (pn == 9) { mode = 0; base = ws + WS_GK;  ld = 256;  coloff = 0; }
        else if (pn < 12) { mode = 0; base = ws + WS_GV;  ld = 512;  coloff = (pn - 10) * 256; }
        else if (pn < 14) { mode = 1; base = ws + WS_MIX; ld = 1024; coloff = 512 + (pn - 12) * 256; }
        else if (pn == 14){ mode = 2; base = ws + WS_IQH; ld = 256;  coloff = 0; }
        else              { mode = 3; base = ws + WS_IKH; ld = 64;   coloff = 0; }
        const int row0 = u.pm * 256 + wr * 64 + fr;
#pragma unroll
        for (int ai = 0; ai < 2; ++ai)
#pragma unroll
            for (int m = 0; m < 4; ++m) {
                const int row = row0 + ai * 128 + m * 16;
                const float r = rstd[row];
                f32x4 c_lo = {1.f, 1.f, 1.f, 1.f}, c_hi = c_lo, s_lo = {0.f, 0.f, 0.f, 0.f}, s_hi = s_lo;
                if (rope_wave) { const f32x4* rp = (const f32x4*)(rope + (size_t)row * 16); c_lo = rp[0]; c_hi = rp[1]; s_lo = rp[2]; s_hi = rp[3]; }
#pragma unroll
                for (int bj = 0; bj < 2; ++bj) {
                    f32x4 v0 = acc[ai][bj][m][0] * r, v1 = acc[ai][bj][m][1] * r;
                    if (rope_wave && (pn != 15 || (bj == 0 && wc == 0))) {
                        f32x4 p0, p1;
#pragma unroll
                        for (int j = 0; j < 4; ++j) { p0[j] = __shfl_xor(v0[j], 16); p1[j] = __shfl_xor(v1[j], 16); }
                        if (fq == 0) { v0 = v0 * c_lo - p0 * s_lo; v1 = v1 * c_hi - p1 * s_hi; }
                        else if (fq == 1) { v0 = v0 * c_lo + p0 * s_lo; v1 = v1 * c_hi + p1 * s_hi; }
                    }
                    const int c0 = bj * 128 + wc * 32 + 8 * fq;
                    if (mode == 0 || mode == 1) {
                        if (mode == 1) {
#pragma unroll
                            for (int j = 0; j < 4; ++j) { v0[j] = silu(v0[j]); v1[j] = silu(v1[j]); }
                        } else { v0 = v0 * sc; v1 = v1 * sc; }
                        u32x4 w; w.x = pk2(v0[0], v0[1]); w.y = pk2(v0[2], v0[3]); w.z = pk2(v1[0], v1[1]); w.w = pk2(v1[2], v1[3]);
                        *(u32x4*)((bf16_t*)base + (size_t)row * ld + coloff + c0) = w;
                    } else if (mode == 2) {
                        split_store8(v0, v1, (bf16_t*)(ws + WS_IQH) + (size_t)row * 256 + c0, (bf16_t*)(ws + WS_IQL) + (size_t)row * 256 + c0);
                    } else {
                        if (c0 < 64) split_store8(v0, v1, (bf16_t*)(ws + WS_IKH) + (size_t)row * 64 + c0, (bf16_t*)(ws + WS_IKL) + (size_t)row * 64 + c0);
                        else if (c0 == 64) { *(f32x4*)((float*)(ws + WS_IW) + (size_t)row * 4) = v0 * (0.5f * 0.125f); }
                        else if (c0 == 72) { float* p = (float*)(ws + WS_GLR) + (size_t)row * 16; *(f32x4*)p = v0; *(f32x4*)(p + 4) = v1; }
                        else if (c0 == 80) { float* p = (float*)(ws + WS_GLR) + (size_t)row * 16 + 8; *(f32x4*)p = v0; *(f32x4*)(p + 4) = v1; }
                    }
                }
            }
    }
};

template <bool MAPPED>
__device__ __forceinline__ void p0_transpose_item(const float* W, int Nsrc, const float* ksc, bf16_t* WT, bf16_t* WL, LAS float* scr, int item, int nblk, int lane) {
    const int kb = item / nblk, nb = item % nblk, k0 = 64 * kb, n0 = 32 * nb;
    const int srcc = MAPPED ? cmap(n0 + (lane & 31)) : (n0 + (lane & 31));
#pragma unroll 8
    for (int i = 0; i < 32; ++i) { const int kk = 2 * i + (lane >> 5);
        float v = W[(size_t)(k0 + kk) * Nsrc + (srcc < 0 ? 0 : srcc)]; if (MAPPED) v *= ksc[k0 + kk];
        scr[kk * 33 + (lane & 31)] = (srcc < 0) ? 0.f : v; }
    asm volatile("s_waitcnt lgkmcnt(0)" ::: "memory");
    const int c = lane & 7;
#pragma unroll
    for (int j = 0; j < 4; ++j) { const int n = (lane >> 3) + 8 * j; const LAS float* s = scr + (8 * c) * 33 + n;
        float v[8];
#pragma unroll
        for (int q = 0; q < 8; ++q) v[q] = s[q * 33];
        u32x4 o; o.x = pk2(v[0], v[1]); o.y = pk2(v[2], v[3]); o.z = pk2(v[4], v[5]); o.w = pk2(v[6], v[7]);
        *(u32x4*)(WT + (size_t)(n0 + n) * 1024 + k0 + 8 * c) = o;
        if (MAPPED && n0 >= 3584) {
            float l[8];
#pragma unroll
            for (int q = 0; q < 8; ++q) l[q] = v[q] - bf2f(f2bf(v[q]));
            u32x4 ol; ol.x = pk2(l[0], l[1]); ol.y = pk2(l[2], l[3]); ol.z = pk2(l[4], l[5]); ol.w = pk2(l[6], l[7]);
            *(u32x4*)(WL + (size_t)(n0 - 3584 + n) * 1024 + k0 + 8 * c) = ol;
        }
    }
    asm volatile("s_waitcnt lgkmcnt(0)" ::: "memory");
}
__device__ __forceinline__ void p0_row(const float* x, const int* pos, unsigned char* ws, int row, int lane) {
    const f32x4* xr = (const f32x4*)(x + (size_t)row * DM) + lane;
    f32x4 v[4]; float s = 0.f;
#pragma unroll
    for (int j = 0; j < 4; ++j) { v[j] = xr[64 * j]; s += (v[j][0] * v[j][0] + v[j][1] * v[j][1]) + (v[j][2] * v[j][2] + v[j][3] * v[j][3]); }
    s = wave_sum(s);
    u32x2* oh = (u32x2*)((bf16_t*)(ws + WS_XH) + (size_t)row * DM) + lane;
    u32x2* ol = (u32x2*)((bf16_t*)(ws + WS_XL) + (size_t)row * DM) + lane;
#pragma unroll
    for (int j = 0; j < 4; ++j) {
        u32x2 h; h.x = pk2(v[j][0], v[j][1]); h.y = pk2(v[j][2], v[j][3]);
        f32x4 l; l[0] = v[j][0] - __builtin_bit_cast(float, h.x << 16); l[1] = v[j][1] - __builtin_bit_cast(float, h.x & 0xffff0000u);
        l[2] = v[j][2] - __builtin_bit_cast(float, h.y << 16); l[3] = v[j][3] - __builtin_bit_cast(float, h.y & 0xffff0000u);
        u32x2 lo; lo.x = pk2(l[0], l[1]); lo.y = pk2(l[2], l[3]);
        oh[64 * j] = h; ol[64 * j] = lo;
    }
    if (lane == 0) ((float*)(ws + WS_RSTD))[row] = 1.0f / sqrtf(s * (1.0f / DM) + NORM_EPS);
    if (lane < 8) {
        const float inv = (float)pow(500000.0, -(double)lane / 8.0);
        const float ang = (float)pos[row] * inv;
        float* rope = (float*)(ws + WS_ROPE);
        rope[row * 16 + lane] = (float)cos((double)ang);
        rope[row * 16 + 8 + lane] = (float)sin((double)ang);
    }
}
struct ProbOut {
    const bf16_t *A, *Bt;
    __device__ __forceinline__ int nt(const pg8::Unit&) const { return 16; }
    __device__ __forceinline__ const char* a(const pg8::Unit& u, int t) const { return (const char*)(A + (size_t)u.pm * 256 * pg8::KP) + (size_t)(t & 15) * 128; }
    __device__ __forceinline__ const char* b(const pg8::Unit& u, int t) const { return (const char*)(Bt + (size_t)u.pn * 256 * pg8::KP) + (size_t)(t & 15) * 128; }
};
struct SchedOut {
    int G, c;
    __device__ __forceinline__ bool next(int i, pg8::Unit& u) const { const long L = (long)i * G + c; if (L >= 256) return false; u.pm = (int)(L >> 2); u.pn = (int)(L & 3); u.kind = 0; return true; }
};
struct EpiY {
    static constexpr bool PERM = false, AFTER_DRAIN = false;
    float* Y;
    __device__ __forceinline__ void operator()(const f32x4 (&acc)[2][2][4][2], const pg8::Unit& u, int wr, int wc, int fr, int fq) const {
        const int row0 = u.pm * 256 + wr * 64 + fr, col0 = u.pn * 256 + wc * 32 + 4 * fq;
#pragma unroll
        for (int ai = 0; ai < 2; ++ai)
#pragma unroll
            for (int m = 0; m < 4; ++m) { float* rowp = Y + (size_t)(row0 + ai * 128 + m * 16) * DM + col0;
#pragma unroll
                for (int bj = 0; bj < 2; ++bj)
#pragma unroll
                    for (int n = 0; n < 2; ++n) *(f32x4*)(rowp + bj * 128 + n * 16) = acc[ai][bj][m][n]; }
    }
};
__device__ __forceinline__ void p6_row(const float* x, const float* Y, const float* pw, float* out, int row, int lane) {
    const f32x4* yr = (const f32x4*)(Y + (size_t)row * DM) + lane;
    f32x4 v[4]; float s = 0.f;
#pragma unroll
    for (int j = 0; j < 4; ++j) { v[j] = yr[64 * j]; s += (v[j][0] * v[j][0] + v[j][1] * v[j][1]) + (v[j][2] * v[j][2] + v[j][3] * v[j][3]); }
    s = wave_sum(s);
    const float r = 1.0f / sqrtf(s * (1.0f / DM) + NORM_EPS);
#pragma unroll
    for (int j = 0; j < 4; ++j) {
        const f32x4 xv = ((const f32x4*)(x + (size_t)row * DM) + lane)[64 * j], w = ((const f32x4*)pw + lane)[64 * j];
        ((f32x4*)(out + (size_t)row * DM) + lane)[64 * j] = xv + v[j] * r * w;
    }
}
#include <hip/hip_bf16.h>
#include <cmath>
namespace attn_body {
using bf16=__hip_bfloat16;
using bf16x8=__attribute__((ext_vector_type(8)))short;
using s16x4=__attribute__((ext_vector_type(4)))short;
using f32x16=__attribute__((ext_vector_type(16)))float;
using u32x4=__attribute__((ext_vector_type(4)))unsigned;
constexpr int BATCH=4,NHEAD=8,SEQ=4096,D=64,DM=NHEAD*D,OPITCH=1024;
constexpr int NW=8,QBLK=32,QB=QBLK*NW,KVBLK=64,NQB=SEQ/QB;
constexpr int ATTN_PITCH=DM, ATTN_UNIT_ROWS=QB;
__device__ __forceinline__ int crow(int r,int hi){return (r&3)+8*(r>>2)+4*hi;}
#define SBAR() __builtin_amdgcn_sched_barrier(0)
__device__ __forceinline__ void cmask(f32x16&p0,f32x16&p1,int jb,int qrel,int hi){
  const float NEG=-INFINITY; int kb=64*jb+4*hi;
  #pragma unroll
  for(int r=0;r<16;++r){int kv=kb+(r&3)+8*(r>>2); if(kv>qrel)p0[r]=NEG; if(kv+32>qrel)p1[r]=NEG;}
}

constexpr int NSLOT=3, SLOTB=8192;
constexpr int LDS_K=0, LDS_V=NSLOT*SLOTB, LDS_WS=2*NSLOT*SLOTB, LDS_OST=LDS_WS+NW*64*4, LDS_MSK=LDS_OST+NW*4096, LDS_BYTES=LDS_MSK+NW*512;
constexpr float C2=0.125f*1.4426950408889634f;
__device__ __forceinline__ void glds16(const void*gsrc,unsigned lds_dst){unsigned keep;
  asm volatile("s_mov_b32 %0, m0\n\ts_mov_b32 m0, %2\n\ts_nop 0\n\tglobal_load_lds_dwordx4 %1, off\n\ts_mov_b32 m0, %0":"=&s"(keep):"v"(gsrc),"s"(lds_dst):"memory");}
__device__ __forceinline__ void glds4(const void*gsrc,unsigned lds_dst){unsigned keep;
  asm volatile("s_mov_b32 %0, m0\n\ts_mov_b32 m0, %2\n\ts_nop 0\n\tglobal_load_lds_dword %1, off\n\ts_mov_b32 m0, %0":"=&s"(keep):"v"(gsrc),"s"(lds_dst):"memory");}
__device__ __forceinline__ float max3f(float a,float b,float c){float r;asm("v_max3_f32 %0, %1, %2, %3":"=v"(r):"v"(a),"v"(b),"v"(c));return r;}
__device__ __forceinline__ float max2f(float a,float b){float r;asm("v_max_f32_e32 %0, %1, %2":"=v"(r):"v"(a),"v"(b));return r;}
__device__ __forceinline__ float fadd_s(float a,float b){float r;asm("v_add_f32_e32 %0, %1, %2":"=v"(r):"v"(a),"v"(b));return r;}
__device__ __forceinline__ float fsub_s(float a,float b){float r;asm("v_sub_f32_e32 %0, %1, %2":"=v"(r):"v"(a),"v"(b));return r;}
typedef float f32x2_t __attribute__((ext_vector_type(2))); typedef __bf16 bf16x2_t __attribute__((ext_vector_type(2)));
__device__ __forceinline__ unsigned cvtpk_s(float lo,float hi){f32x2_t v={lo,hi};bf16x2_t b=__builtin_convertvector(v,bf16x2_t);return __builtin_bit_cast(unsigned,b);}
#define WAIT_BAR(N) asm volatile("s_waitcnt vmcnt(" #N ") lgkmcnt(0)\n\ts_barrier":::"memory")

__device__ __forceinline__ void qkt(f32x16&p0,f32x16&p1,const char*Kslot,const bf16x8*qr,const f32x16&negm,int r32,int hi){
  const char*kb=Kslot+hi*1024+r32*16;
  #pragma unroll
  for(int d0=0;d0<4;++d0){
    const bf16x8 b0=*reinterpret_cast<const bf16x8*>(kb+d0*2048);
    const bf16x8 b1=*reinterpret_cast<const bf16x8*>(kb+d0*2048+512);
    if(d0==0){p0=__builtin_amdgcn_mfma_f32_32x32x16_bf16(b0,qr[0],negm,0,0,0);p1=__builtin_amdgcn_mfma_f32_32x32x16_bf16(b1,qr[0],negm,0,0,0);}
    else{p0=__builtin_amdgcn_mfma_f32_32x32x16_bf16(b0,qr[d0],p0,0,0,0);p1=__builtin_amdgcn_mfma_f32_32x32x16_bf16(b1,qr[d0],p1,0,0,0);}}
}
typedef __attribute__((address_space(3))) const char* lds_cptr;
typedef short v4i16_t __attribute__((ext_vector_type(4)));
__device__ __forceinline__ void kload8(bf16x8*kf,lds_cptr kp){
  kf[0]=*(const __attribute__((address_space(3))) bf16x8*)(kp);      kf[1]=*(const __attribute__((address_space(3))) bf16x8*)(kp+512);
  kf[2]=*(const __attribute__((address_space(3))) bf16x8*)(kp+2048); kf[3]=*(const __attribute__((address_space(3))) bf16x8*)(kp+2560);
  kf[4]=*(const __attribute__((address_space(3))) bf16x8*)(kp+4096); kf[5]=*(const __attribute__((address_space(3))) bf16x8*)(kp+4608);
  kf[6]=*(const __attribute__((address_space(3))) bf16x8*)(kp+6144); kf[7]=*(const __attribute__((address_space(3))) bf16x8*)(kp+6656);
}
__device__ __forceinline__ void kload2(bf16x8*kf,lds_cptr kp,int j){ kf[2*j]=*(const __attribute__((address_space(3))) bf16x8*)(kp+j*2048); kf[2*j+1]=*(const __attribute__((address_space(3))) bf16x8*)(kp+j*2048+512); }
__device__ __forceinline__ s16x4 vtr(lds_cptr p){ return __builtin_bit_cast(s16x4,__builtin_amdgcn_ds_read_tr16_b64_v4i16((__attribute__((address_space(3))) v4i16_t*)p)); }
__device__ __forceinline__ float rowmax(const f32x16&p0,const f32x16&p1){
  float a=max3f(p0[0],p0[1],p1[0]),b=max3f(p0[2],p0[3],p1[1]);a=max3f(a,p1[2],p1[3]);
  #pragma unroll
  for(int r=4;r<16;r+=4){a=max3f(a,p0[r],p0[r+1]);b=max3f(b,p0[r+2],p0[r+3]);a=max3f(a,p1[r],p1[r+1]);b=max3f(b,p1[r+2],p1[r+3]);}
  const float m=max2f(a,b);
  auto rr=__builtin_amdgcn_permlane32_swap(__float_as_uint(m),__float_as_uint(m),false,false);
  return max2f(__uint_as_float(rr[0]),__uint_as_float(rr[1]));
}
__device__ __forceinline__ void pv(f32x16*o,int vb,bf16x8 pa0,bf16x8 pa1,bf16x8 pa2,bf16x8 pa3){
  #pragma unroll
  for(int d0=0;d0<2;++d0){s16x4 lo[4],hi[4];
    #pragma unroll
    for(int ks=0;ks<4;++ks){
      asm volatile("ds_read_b64_tr_b16 %0,%1 offset:%c2":"=&v"(lo[ks]):"v"(vb),"i"(d0*4096+ks*1024):"memory");
      asm volatile("ds_read_b64_tr_b16 %0,%1 offset:%c2":"=&v"(hi[ks]):"v"(vb),"i"(d0*4096+ks*1024+512):"memory");}
    asm volatile("s_waitcnt lgkmcnt(0)":::"memory");SBAR();
    #define PK(k) (bf16x8){lo[k][0],lo[k][1],lo[k][2],lo[k][3],hi[k][0],hi[k][1],hi[k][2],hi[k][3]}
    o[d0]=__builtin_amdgcn_mfma_f32_32x32x16_bf16(pa0,PK(0),o[d0],0,0,0);
    o[d0]=__builtin_amdgcn_mfma_f32_32x32x16_bf16(pa1,PK(1),o[d0],0,0,0);
    o[d0]=__builtin_amdgcn_mfma_f32_32x32x16_bf16(pa2,PK(2),o[d0],0,0,0);
    o[d0]=__builtin_amdgcn_mfma_f32_32x32x16_bf16(pa3,PK(3),o[d0],0,0,0);
    #undef PK
  }
}

#ifndef ATTN_STORE16
#define ATTN_STORE16(p,v) (*(u32x4*)(p)=(v))
#endif
template<int THRL> __device__ __forceinline__ void attn_unit(int b,int h,int qb,const bf16*Q,const bf16*__restrict__ K,const bf16*__restrict__ V,const unsigned*__restrict__ MASK32,bf16*O,char*shm){
  const int tid=threadIdx.x,lane=tid&63,r32=lane&31,hi=lane>>5; const int wid=__builtin_amdgcn_readfirstlane(tid>>6);
  const long rowbase=(long)b*SEQ; const int q0=qb*QB;
  const bf16*Qw=Q+(rowbase+q0+wid*QBLK)*DM+h*D;
  const bf16*Kh=K+rowbase*DM+h*D,*Vh=V+rowbase*DM+h*D;
  const unsigned lds0=(unsigned)(uintptr_t)shm;
  float*wsf=(float*)(shm+LDS_WS)+wid*64;
  const bf16*ksrc=Kh+(long)lane*DM+wid*8;
  const bf16*vsrc=Vh+(long)(16*(wid&3)+(lane>>2))*DM+(wid>>2)*32+(lane&3)*8;
  const unsigned kdst=lds0+LDS_K+wid*1024, vdst=lds0+LDS_V+wid*1024;
  #define DMA_K(t,slot) glds16(ksrc+(long)(t)*KVBLK*DM,(unsigned)__builtin_amdgcn_readfirstlane(kdst+(slot)))
  #define DMA_V(t,slot) glds16(vsrc+(long)(t)*KVBLK*DM,(unsigned)__builtin_amdgcn_readfirstlane(vdst+(slot)))
  const unsigned*msrc=MASK32+(size_t)(rowbase+q0+wid*QBLK+(lane>>1))*128+(lane&1);
  const unsigned mdst=lds0+LDS_MSK+wid*512;
  #define DMA_M(t) glds4(msrc+2*(t),(unsigned)__builtin_amdgcn_readfirstlane(mdst+(((t)&1)<<8)))
  typedef __attribute__((address_space(3))) const unsigned long long* lds_u64p;
  #define MSK(v,W,b) __uint_as_float(__float_as_uint(v)&(unsigned)__builtin_amdgcn_sbfe((int)(W),(b),1))
  #define BP(B) (((B)&3)+8*((B)>>2))
  const int vb0=(int)(lds0+LDS_V)+((lane>>4)&1)*32+(lane&3)*8+(4*hi+((lane&15)>>2))*64;
  const char*Kbase=shm+LDS_K; bf16x8 kf[8];
  const lds_cptr shm3=(lds_cptr)shm; const lds_cptr kp0=shm3+LDS_K+hi*1024+r32*16; const lds_cptr vp0=shm3+LDS_V+((lane>>4)&1)*32+(lane&3)*8+(4*hi+((lane&15)>>2))*64;
  const lds_cptr mp0=shm3+LDS_MSK+wid*512+r32*8;
  const int NT=(q0+QB)/KVBLK;
  DMA_M(0);DMA_M(1);DMA_K(0,0);DMA_V(0,0);DMA_K(1,SLOTB);
  bf16x8 qr[4];
  #pragma unroll
  for(int d0=0;d0<4;++d0)qr[d0]=*reinterpret_cast<const bf16x8*>(&Qw[(long)r32*DM+d0*16+hi*8]);
  float mhat=0.f,l_reg=0.f;f32x16 o[2];o[0]=f32x16{};o[1]=f32x16{};f32x16 negm=f32x16{};asm volatile("":"+v"(negm));
  const int qrel=wid*QBLK+r32;
  #define CMASK(P0,P1,t) do{}while(0)
  bool resc=false;
  #define START(P0,P1) do{ const float rm=rowmax(P0,P1); resc=false; \
    { const float dl=rm; mhat=fadd_s(mhat,dl); \
      _Pragma("unroll") for(int r=0;r<16;++r){P0[r]=fsub_s(P0[r],dl);P1[r]=fsub_s(P1[r],dl);} \
      _Pragma("unroll") for(int r=0;r<16;++r)negm[r]=-mhat; asm volatile("":"+v"(negm)); } \
    _Pragma("unroll") for(int r=0;r<16;++r)P0[r]=__builtin_amdgcn_exp2f(P0[r]); }while(0)
  #define RESC() do{ if(resc){ asm volatile("s_waitcnt lgkmcnt(0)":::"memory"); \
      _Pragma("unroll") for(int d_=0;d_<2;++d_) _Pragma("unroll") for(int r=0;r<16;++r)o[d_][r]*=wsf[crow(r,hi)]; } }while(0)
  f32x16 pA0,pA1,pB0,pB1;
  int sl_prev=0,sl_cur=0,sl_next=SLOTB;
  #define ROT() do{sl_prev=sl_cur;sl_cur=sl_next;sl_next=(sl_next==(NSLOT-1)*SLOTB)?0:sl_next+SLOTB;}while(0)
  DMA_K(2,2*SLOTB);
  WAIT_BAR(3);
  qkt(pA0,pA1,Kbase,qr,negm,r32,hi);asm volatile("s_nop 15\n\ts_nop 7":"+v"(pA0),"+v"(pA1));
  START(pA0,pA1);
  _Pragma("unroll") for(int r=0;r<16;++r)pA1[r]=__builtin_amdgcn_exp2f(pA1[r]);
  { const unsigned long long mw_=*(lds_u64p)(mp0); const unsigned mwl_=(unsigned)mw_>>(4*hi), mwh_=(unsigned)(mw_>>32)>>(4*hi);
    _Pragma("unroll") for(int r=0;r<16;++r){pA0[r]=MSK(pA0[r],mwl_,BP(r));pA1[r]=MSK(pA1[r],mwh_,BP(r));} }
  WAIT_BAR(0);
  DMA_K(3,0);DMA_V(1,SLOTB);
  ROT();
  kload8(kf,kp0+sl_cur);
  WAIT_BAR(2);
  s16x4 vlo[8],vhi[8]; u32x4 pw0,pw1,pw2,pw3;
  #define PKW(P,B) cvtpk_s(P[B],P[B+1])
  #define PAF(k) __builtin_bit_cast(bf16x8,pw##k)
  #define VFR(i) (bf16x8){vlo[i][0],vlo[i][1],vlo[i][2],vlo[i][3],vhi[i][0],vhi[i][1],vhi[i][2],vhi[i][3]}
  #define PIN(x) asm volatile("":"+v"(x))
  #define MX3(a,b,c) __builtin_fmaxf(__builtin_fmaxf((a),(b)),(c))
  #define GAPA(MF,A0,A1,A2,A3,W0,W1,PW) do{ MF; sacc+=A0; sacc+=A1; sacc+=A2; sacc+=A3; PIN(sacc); W0; W1; PIN(PW); SBAR(); }while(0)
  #define EX(v) __builtin_amdgcn_exp2f(v)
  #define GAPB(MF,X,W,B) do{ MF; X[B]=MSK(EX(X[B]),W,BP(B)); X[B+1]=MSK(EX(X[B+1]),W,BP(B+1)); X[B+2]=MSK(EX(X[B+2]),W,BP(B+2)); X[B+3]=MSK(EX(X[B+3]),W,BP(B+3)); PIN(X); SBAR(); }while(0)
  #define VRD(i) do{ vlo[i]=vtr(vp_+(((i)>>2)*4096+((i)&3)*1024)); vhi[i]=vtr(vp_+(((i)>>2)*4096+((i)&3)*1024+512)); }while(0)
  #define KRD(G,j) do{ if(G){ kload2(kf,kp0+sl_next,j); SBAR(); } }while(0)
  #define STEP(C0,C1,P0,P1,t,GK,GV,GL) do{ SBAR(); \
    if(GV){DMA_M((t)+1);} \
    const unsigned long long mw_=*(lds_u64p)(mp0+(((t)&1)<<8)); const unsigned mwl_=(unsigned)mw_>>(4*hi), mwh_=(unsigned)(mw_>>32)>>(4*hi); \
    const lds_cptr vp_=vp0+sl_prev; \
    VRD(0); SBAR(); float sacc=(P0[0]+P0[1]); \
    GAPA(C0=__builtin_amdgcn_mfma_f32_32x32x16_bf16(kf[0],qr[0],negm,0,0,0), P0[2],P0[3],P0[4],P0[5],     pw0[0]=PKW(P0,0), pw0[1]=PKW(P0,2), pw0); \
    VRD(4); SBAR(); GAPA(C1=__builtin_amdgcn_mfma_f32_32x32x16_bf16(kf[1],qr[0],negm,0,0,0), P0[6],P0[7],P0[8],P0[9],     pw0[2]=PKW(P0,4), pw0[3]=PKW(P0,6), pw0); \
    VRD(1); SBAR(); GAPA(C0=__builtin_amdgcn_mfma_f32_32x32x16_bf16(kf[2],qr[1],C0,0,0,0),   P0[10],P0[11],P0[12],P0[13], pw1[0]=PKW(P0,8), pw1[1]=PKW(P0,10), pw1); \
    VRD(5); SBAR(); GAPA(C1=__builtin_amdgcn_mfma_f32_32x32x16_bf16(kf[3],qr[1],C1,0,0,0),   P0[14],P0[15],P1[0],P1[1],   pw1[2]=PKW(P0,12),pw1[3]=PKW(P0,14), pw1); \
    VRD(2); SBAR(); GAPA(C0=__builtin_amdgcn_mfma_f32_32x32x16_bf16(kf[4],qr[2],C0,0,0,0),   P1[2],P1[3],P1[4],P1[5],     pw2[0]=PKW(P1,0), pw2[1]=PKW(P1,2), pw2); \
    VRD(6); SBAR(); GAPA(C1=__builtin_amdgcn_mfma_f32_32x32x16_bf16(kf[5],qr[2],C1,0,0,0),   P1[6],P1[7],P1[8],P1[9],     pw2[2]=PKW(P1,4), pw2[3]=PKW(P1,6), pw2); \
    VRD(3); SBAR(); GAPA(C0=__builtin_amdgcn_mfma_f32_32x32x16_bf16(kf[6],qr[3],C0,0,0,0),   P1[10],P1[11],P1[12],P1[13], pw3[0]=PKW(P1,8), pw3[1]=PKW(P1,10), pw3); \
    VRD(7); SBAR(); GAPA(C1=__builtin_amdgcn_mfma_f32_32x32x16_bf16(kf[7],qr[3],C1,0,0,0),   P1[14],P1[15],0.f,0.f,       pw3[2]=PKW(P1,12),pw3[3]=PKW(P1,14), pw3); \
    l_reg+=sacc; \
    if(GK){DMA_K((t)+3,sl_cur);} if(GV){DMA_V((t)+1,sl_next);} \
    CMASK(C0,C1,t); \
    { float a=MX3(C0[0],C0[1],C1[0]),b=MX3(C0[2],C0[3],C1[1]); a=MX3(a,C1[2],C1[3]); \
      _Pragma("unroll") for(int r=4;r<16;r+=4){a=MX3(a,C0[r],C0[r+1]);b=MX3(b,C0[r+2],C0[r+3]);a=MX3(a,C1[r],C1[r+1]);b=MX3(b,C1[r+2],C1[r+3]);} \
      float rm=__builtin_fmaxf(a,b); { auto rr=__builtin_amdgcn_permlane32_swap(__float_as_uint(rm),__float_as_uint(rm),false,false); rm=__builtin_fmaxf(__uint_as_float(rr[0]),__uint_as_float(rr[1])); } \
      resc=false; \
      if(__builtin_expect(__any(rm>(float)THRL),0)){ const float dl=__builtin_fmaxf(rm,0.f); mhat+=dl; \
        _Pragma("unroll") for(int r=0;r<16;++r){C0[r]-=dl;C1[r]-=dl;} \
        _Pragma("unroll") for(int r=0;r<16;++r)negm[r]=-mhat; asm volatile("":"+v"(negm)); \
        const float f=__builtin_amdgcn_exp2f(-dl); l_reg*=f; if(hi==0)wsf[r32]=f; resc=true; } } \
    SBAR(); \
    GAPB(o[0]=__builtin_amdgcn_mfma_f32_32x32x16_bf16(PAF(0),VFR(0),o[0],0,0,0), C0,mwl_,0); \
    GAPB(o[1]=__builtin_amdgcn_mfma_f32_32x32x16_bf16(PAF(0),VFR(4),o[1],0,0,0), C0,mwl_,4); \
    KRD(GL,0); GAPB(o[0]=__builtin_amdgcn_mfma_f32_32x32x16_bf16(PAF(1),VFR(1),o[0],0,0,0), C0,mwl_,8); \
    KRD(GL,1); GAPB(o[1]=__builtin_amdgcn_mfma_f32_32x32x16_bf16(PAF(1),VFR(5),o[1],0,0,0), C0,mwl_,12); \
    KRD(GL,2); GAPB(o[0]=__builtin_amdgcn_mfma_f32_32x32x16_bf16(PAF(2),VFR(2),o[0],0,0,0), C1,mwh_,0); \
    KRD(GL,3); GAPB(o[1]=__builtin_amdgcn_mfma_f32_32x32x16_bf16(PAF(2),VFR(6),o[1],0,0,0), C1,mwh_,4); \
    GAPB(o[0]=__builtin_amdgcn_mfma_f32_32x32x16_bf16(PAF(3),VFR(3),o[0],0,0,0), C1,mwh_,8); \
    GAPB(o[1]=__builtin_amdgcn_mfma_f32_32x32x16_bf16(PAF(3),VFR(7),o[1],0,0,0), C1,mwh_,12); \
    }while(0)
  int t=1;
  #undef CMASK
  #define CMASK(P0,P1,t) do{}while(0)
  for(;t+5<NT;t+=2){
    STEP(pB0,pB1,pA0,pA1,t,true,true,true);     WAIT_BAR(2); RESC(); ROT();
    STEP(pA0,pA1,pB0,pB1,t+1,true,true,true);   WAIT_BAR(2); RESC(); ROT();
  }
  #undef CMASK
  #define CMASK(P0,P1,t) do{}while(0)
  #define ENDW(tt) do{ if((tt)+3<NT){WAIT_BAR(2);} else if((tt)+2<NT){WAIT_BAR(1);} else {WAIT_BAR(0);} }while(0)
  for(;t+1<NT;t+=2){
    STEP(pB0,pB1,pA0,pA1,t,(t+3<NT),(t+1<NT),(t+1<NT));       ENDW(t);   RESC(); ROT();
    STEP(pA0,pA1,pB0,pB1,t+1,(t+4<NT),(t+2<NT),(t+2<NT));     ENDW(t+1); RESC(); ROT();
  }
  STEP(pB0,pB1,pA0,pA1,NT-1,false,false,false); RESC();
  { float sacc=pB0[0]+pB0[1]; _Pragma("unroll") for(int r=2;r<16;++r)sacc+=pB0[r]; _Pragma("unroll") for(int r=0;r<16;++r)sacc+=pB1[r]; l_reg+=sacc;
    pw0=(u32x4){PKW(pB0,0),PKW(pB0,2),PKW(pB0,4),PKW(pB0,6)};pw1=(u32x4){PKW(pB0,8),PKW(pB0,10),PKW(pB0,12),PKW(pB0,14)};pw2=(u32x4){PKW(pB1,0),PKW(pB1,2),PKW(pB1,4),PKW(pB1,6)};pw3=(u32x4){PKW(pB1,8),PKW(pB1,10),PKW(pB1,12),PKW(pB1,14)};
    SBAR(); pv(o,vb0+sl_cur,PAF(0),PAF(1),PAF(2),PAF(3)); }
  #undef PKW
  #undef PAF
  #undef VFR
  #undef PIN
  #undef MX3
  #undef GAPA
  #undef GAPB
  #undef EX
  #undef VRD
  #undef KRD
  #undef STEP
  #undef ENDW
  {auto rr=__builtin_amdgcn_permlane32_swap(__float_as_uint(l_reg),__float_as_uint(l_reg),false,false);l_reg=__uint_as_float(rr[0])+__uint_as_float(rr[1]);}
  if(hi==0)wsf[32+r32]=l_reg;asm volatile("s_waitcnt lgkmcnt(0)":::"memory");
  float rli[16];
  #pragma unroll
  for(int r=0;r<16;++r)rli[r]=__builtin_amdgcn_rcpf(wsf[32+crow(r,hi)]);
  bf16*Ow=O+(rowbase+q0+wid*QBLK)*OPITCH+h*D;
  { bf16*stg=(bf16*)(shm+LDS_OST)+wid*2048;
    #pragma unroll
    for(int r=0;r<16;++r){const int orow=crow(r,hi);
      #pragma unroll
      for(int d0=0;d0<2;++d0)stg[orow*64+d0*32+r32]=__float2bfloat16(o[d0][r]*rli[r]);}
    asm volatile("s_waitcnt lgkmcnt(0)":::"memory");
    #pragma unroll
    for(int i=0;i<4;++i){const int row=i*8+(lane>>3),ch=lane&7; const u32x4 v=*(const u32x4*)(stg+row*64+ch*8); bf16*dst=Ow+(long)row*OPITCH+ch*8; const u32x4 g=*(const u32x4*)dst; u32x4 w;
      _Pragma("unroll") for(int e=0;e<4;++e){ const float a0=__uint_as_float(v[e]<<16),a1=__uint_as_float(v[e]&0xffff0000u),g0=__uint_as_float(g[e]<<16),g1=__uint_as_float(g[e]&0xffff0000u); w[e]=cvtpk_s(a0*g0,a1*g1); }
      *(u32x4*)dst=w;} }
  asm volatile("s_waitcnt lgkmcnt(0)\n\ts_barrier":::"memory");
  #undef DMA_K
  #undef DMA_V
  #undef DMA_M
  #undef MSK
  #undef BP
  #undef CMASK
  #undef START
  #undef RESC
  #undef ROT
}
constexpr int ATTN_LDS_BYTES=LDS_BYTES;
struct AttnTensors { const bf16* Q; const bf16* K; const bf16* V; const unsigned* MASK32; bf16* O; };
struct AttnUnit { int bh; int qb; };
struct StaticOrder {
  int vcu,G;
  __device__ __forceinline__ StaticOrder(int grid,int v):vcu(v),G(grid){}
  __device__ __forceinline__ bool next(int i,AttnUnit&u)const{
    if(G==256){ if(i>=2)return false; const int s=vcu&7; u.bh=vcu>>3; u.qb=(i==0)?15-s:s; return true; }
    const long L=(long)i*G+vcu; if(L>=BATCH*NHEAD*NQB)return false; u.qb=NQB-1-(int)(L/(BATCH*NHEAD)); u.bh=(int)(L%(BATCH*NHEAD)); return true; }
  __device__ __forceinline__ void a_ready(const AttnUnit&)const{}
  __device__ __forceinline__ void done(const AttnUnit&)const{}
};
template<class Sched,int THRL=8> __device__ __forceinline__ void attn_phase(char*lds,const AttnTensors&T,const Sched&S){
  AttnUnit u;
  for(int i=0;S.next(i,u);++i){ S.a_ready(u); attn_unit<THRL>(u.bh/NHEAD,u.bh%NHEAD,u.qb,T.Q,T.K,T.V,T.MASK32,T.O,lds); S.done(u); }
}
#undef SBAR
#undef WAIT_BAR
}
namespace sel {
typedef short bf16x8 __attribute__((ext_vector_type(8)));
typedef float f32x16 __attribute__((ext_vector_type(16)));
constexpr int QF_OFF = 0;
constexpr int ROW_OFF = 0;
constexpr int HIST_OFF = 131072;
constexpr int WBUF_OFF = 131072 + 8192;
constexpr int NUNITS = BATCH * (SEQ / 32);
__device__ __forceinline__ unsigned mono(float f) { const unsigned u = __builtin_bit_cast(unsigned, f); return (u & 0x80000000u) ? ~u : (u | 0x80000000u); }
__device__ __forceinline__ void unit_of(int u, int& b, int& j) { j = (SEQ / 32 - 1) - (u >> 2); b = u & 3; }
__device__ __forceinline__ size_t scratch_bytes(int v) { return (size_t)4096 * (size_t)((SEQ / 32) - (v >> 2)); }

__device__ __forceinline__ void unit(int b, int j, unsigned char* ws, float* sc, LAS unsigned char* lds) {
    const int tid = threadIdx.x, lane = tid & 63, wid = __builtin_amdgcn_readfirstlane(tid >> 6), r32 = lane & 31, hi = lane >> 5;
    const int q0 = j * 32, row0 = b * SEQ + q0, nkt = j + 1;
    const bf16_t* IQH = (const bf16_t*)(ws + WS_IQH); const bf16_t* IQL = (const bf16_t*)(ws + WS_IQL);
    const bf16_t* IKH = (const bf16_t*)(ws + WS_IKH); const bf16_t* IKL = (const bf16_t*)(ws + WS_IKL);
#pragma unroll
    for (int i = 0; i < 2; ++i) {
        const int f = tid + 512 * i, h = f >> 8, s = (f >> 6) & 3, l = f & 63, r = l & 31, half = l >> 5;
        const size_t src = (size_t)(row0 + r) * 256 + h * 64 + 16 * s + 8 * half;
        const u32x4 vh = *(const u32x4*)(IQH + src), vl = *(const u32x4*)(IQL + src);
        *(LAS u32x4*)(lds + QF_OFF + ((h * 4 + s) * 2 + 0) * 1024 + l * 16) = vh;
        *(LAS u32x4*)(lds + QF_OFF + ((h * 4 + s) * 2 + 1) * 1024 + l * 16) = vl;
    }
    const f32x4 w = *(const f32x4*)((const float*)(ws + WS_IW) + (size_t)(row0 + r32) * 4);
    __syncthreads();
    for (int kt = wid; kt < nkt; kt += 8) {
        const size_t krow = (size_t)(b * SEQ + kt * 32 + r32) * 64 + 8 * hi;
        bf16x8 kh[4], kl[4];
#pragma unroll
        for (int s = 0; s < 4; ++s) { kh[s] = *(const bf16x8*)(IKH + krow + 16 * s); kl[s] = *(const bf16x8*)(IKL + krow + 16 * s); }
        f32x16 score;
#pragma unroll
        for (int i = 0; i < 16; ++i) score[i] = 0.f;
        int qoff = lane * 16; asm volatile("" : "+v"(qoff));
#pragma unroll
        for (int h = 0; h < 4; ++h) {
            f32x16 acc;
#pragma unroll
            for (int i = 0; i < 16; ++i) acc[i] = 0.f;
#pragma unroll
            for (int s = 0; s < 4; ++s) {
                const bf16x8 qh = *(const LAS bf16x8*)(lds + QF_OFF + ((h * 4 + s) * 2 + 0) * 1024 + qoff);
                const bf16x8 ql = *(const LAS bf16x8*)(lds + QF_OFF + ((h * 4 + s) * 2 + 1) * 1024 + qoff);
                acc = __builtin_amdgcn_mfma_f32_32x32x16_bf16(kh[s], qh, acc, 0, 0, 0);
                acc = __builtin_amdgcn_mfma_f32_32x32x16_bf16(kh[s], ql, acc, 0, 0, 0);
                acc = __builtin_amdgcn_mfma_f32_32x32x16_bf16(kl[s], qh, acc, 0, 0, 0);
            }
            const float wh = w[h];
#pragma unroll
            for (int i = 0; i < 16; ++i) score[i] += wh * fmaxf(acc[i], 0.f);
        }
        float* dst = sc + ((size_t)(kt * 32 + r32) * 32 + 4 * hi);
#pragma unroll
        for (int g = 0; g < 4; ++g) *(f32x4*)(dst + 8 * g) = (f32x4){score[4 * g], score[4 * g + 1], score[4 * g + 2], score[4 * g + 3]};
    }
    asm volatile("s_waitcnt vmcnt(0)" ::: "memory");
    __syncthreads();
    LAS unsigned* hist = (LAS unsigned*)(lds + HIST_OFF + wid * 1024);
    LAS unsigned* rowb = (LAS unsigned*)(lds + ROW_OFF + wid * 16384);
    LAS unsigned long long* wbuf = (LAS unsigned long long*)(lds + WBUF_OFF + wid * 512);
    for (int qi = 0; qi < 4; ++qi) {
        const int qq = wid * 4 + qi, t = q0 + qq, n = t + 1, nj = (n + 63) >> 6, nj8 = (nj + 7) & ~7;
        const float* urow = sc + (size_t)qq * 32 + hi * 1024 + r32;
        for (int j0 = 0; j0 < nj8; j0 += 8) {
            float v[8];
#pragma unroll
            for (int i = 0; i < 8; ++i) v[i] = __builtin_nontemporal_load(urow + (size_t)(j0 + i) * 2048);
            asm volatile("" : "+v"(v[0]), "+v"(v[1]), "+v"(v[2]), "+v"(v[3]), "+v"(v[4]), "+v"(v[5]), "+v"(v[6]), "+v"(v[7]));
#pragma unroll
            for (int i = 0; i < 8; ++i) rowb[(j0 + i) * 64 + lane] = (lane < n - 64 * (j0 + i)) ? mono(v[i]) : 0u;
        }
        unsigned thr = 0u; int need = 1 << 30;
        if (n > TOPK) {
            unsigned prefix = 0u; unsigned kneed = TOPK;
#pragma unroll 1
            for (int p = 0; p < 4; ++p) {
                const int shift = 24 - 8 * p;
                *(LAS u32x4*)(hist + 4 * lane) = (u32x4){0u, 0u, 0u, 0u};
#pragma unroll 4
                for (int jj = 0; jj < nj; ++jj) {
                    const unsigned k = rowb[jj * 64 + lane];
                    const bool part = (k != 0u) && (p == 0 || (k >> (shift + 8)) == prefix);
                    if (part) __hip_atomic_fetch_add(hist + ((k >> shift) & 255u), 1u, __ATOMIC_RELAXED, __HIP_MEMORY_SCOPE_WORKGROUP);
                }
                asm volatile("s_waitcnt lgkmcnt(0)" ::: "memory");
                const u32x4 hv = *(const LAS u32x4*)(hist + 4 * lane);
                const unsigned tot = (hv.x + hv.y) + (hv.z + hv.w);
                unsigned suf = tot;
#pragma unroll
                for (int o = 1; o < 64; o <<= 1) { const unsigned v = __shfl_down(suf, o); if (lane + o < 64) suf += v; }
                const unsigned c3 = suf - tot, c2 = c3 + hv.w, c1 = c2 + hv.z, c0 = c1 + hv.y;
                int fb = -1; unsigned cab = 0u;
                if (c3 < kneed && kneed <= c3 + hv.w) { fb = 3; cab = c3; }
                else if (c2 < kneed && kneed <= c2 + hv.z) { fb = 2; cab = c2; }
                else if (c1 < kneed && kneed <= c1 + hv.y) { fb = 1; cab = c1; }
                else if (c0 < kneed && kneed <= c0 + hv.x) { fb = 0; cab = c0; }
                const unsigned long long fm = __ballot(fb >= 0);
                const int src = (int)__builtin_ctzll(fm | (1ull << 63));
                const unsigned bin = 4u * (unsigned)src + (unsigned)__builtin_amdgcn_readlane(fb, src);
                kneed -= (unsigned)__builtin_amdgcn_readlane((int)cab, src);
                prefix = (prefix << 8) | bin;
                asm volatile("s_waitcnt lgkmcnt(0)" ::: "memory");
            }
            thr = prefix; need = (int)kneed;
        }
        wbuf[lane] = 0ull;
        int eqcnt = 0;
        const unsigned long long lt = (1ull << lane) - 1ull;
        const bool all = (n <= TOPK);
#pragma unroll 2
        for (int jj = 0; jj < nj; ++jj) {
            const unsigned k = rowb[jj * 64 + lane];
            const bool valid = (k != 0u);
            const bool gt = valid && (all || k > thr), eq = valid && !all && k == thr;
            const unsigned long long meq = __ballot(eq);
            const int rank = eqcnt + (int)__popcll(meq & lt);
            const bool selb = gt || (eq && rank < need);
            const unsigned long long bits = __ballot(selb);
            eqcnt += (int)__popcll(meq);
            if (lane == 0) wbuf[jj] = bits;
        }
        asm volatile("s_waitcnt lgkmcnt(0)" ::: "memory");
        ((unsigned long long*)(ws + WS_MASK))[(size_t)(row0 + qq) * 64 + lane] = wbuf[lane];
        asm volatile("s_waitcnt lgkmcnt(0)" ::: "memory");
    }
    __syncthreads();
}

__device__ __forceinline__ void phase(unsigned char* ws, unsigned char* scbase, LAS unsigned char* lds, int G, int v) {
    const int GE = G < 256 ? G : 256;
    if (v >= GE) return;
    size_t off = 0;
    for (int i = 0; i < v; ++i) off += scratch_bytes(i);
    float* sc = (float*)(scbase + off);
    for (int r = 0;; ++r) {
        const int u = (r & 1) ? ((r + 1) * GE - 1 - v) : (r * GE + v);
        if (u >= NUNITS) break;
        int b, j; unit_of(u, b, j);
        unit(b, j, ws, sc, lds);
    }
}
}
namespace gla {
typedef short bf16x8 __attribute__((ext_vector_type(8)));
typedef float f32x16 __attribute__((ext_vector_type(16)));
constexpr int NUNITS = BATCH * 4 * (SEQ / 64);
constexpr int LP = 72;
constexpr int L_GLR = 0, L_WUP = 4096, L_GT = 8192, L_RED = 10240, L_A = 12288, L_B = L_A + 64 * LP * 2, L_V = L_B + 64 * LP * 2, L_A2 = L_V + 128 * LP * 2, L_END = L_A2 + 64 * LP * 2;
__device__ __forceinline__ int crow(int r, int hi) { return (r & 3) + 8 * (r >> 2) + 4 * hi; }

__device__ __forceinline__ void cum_gates(const float* GLR, const float* wup, const float* bias, int tok0, int h, LAS unsigned char* lds, float (&bv)[8], float& blast) {
    const int tid = threadIdx.x, d = tid & 63, tg = tid >> 6;
    LAS float* sg = (LAS float*)(lds + L_GLR); LAS float* sw = (LAS float*)(lds + L_WUP); LAS float* gt = (LAS float*)(lds + L_GT);
#pragma unroll
    for (int i = 0; i < 2; ++i) { const int e = tid + 512 * i; sg[e] = GLR[(size_t)tok0 * 16 + e]; sw[e] = wup[(e >> 6) * 256 + h * 64 + (e & 63)]; }
    __syncthreads();
    float wu[16];
#pragma unroll
    for (int r = 0; r < 16; ++r) wu[r] = sw[r * 64 + d];
    const float bi = bias[h * 64 + d];
    float run = 0.f;
#pragma unroll
    for (int i = 0; i < 8; ++i) {
        const int t = tg * 8 + i;
        float z = bi;
#pragma unroll
        for (int r = 0; r < 16; ++r) z = fmaf(sg[t * 16 + r], wu[r], z);
        const float ls = fminf(z, 0.f) - log1pf(expf(-fabsf(z)));
        run += ls * (1.0f / 16.0f);
        bv[i] = run;
    }
    gt[tg * 64 + d] = run;
    __syncthreads();
    float pre = 0.f, tot = 0.f;
#pragma unroll
    for (int g = 0; g < 8; ++g) { const float v = gt[g * 64 + d]; tot += v; if (g < tg) pre += v; }
#pragma unroll
    for (int i = 0; i < 8; ++i) bv[i] += pre;
    blast = tot;
}
__device__ __forceinline__ void stage_vT(const bf16_t* GV, int tok0, int h, LAS unsigned char* lds) {
    const int tid = threadIdx.x, e = tid & 127, tq = tid >> 7;
    unsigned pk[8];
#pragma unroll
    for (int i = 0; i < 8; ++i) {
        const unsigned lo = GV[(size_t)(tok0 + tq * 16 + 2 * i) * 512 + h * 128 + e], hi = GV[(size_t)(tok0 + tq * 16 + 2 * i + 1) * 512 + h * 128 + e];
        pk[i] = lo | (hi << 16);
    }
    LAS u32x4* dst = (LAS u32x4*)(lds + L_V + (e * LP + tq * 16) * 2);
    dst[0] = (u32x4){pk[0], pk[1], pk[2], pk[3]}; dst[1] = (u32x4){pk[4], pk[5], pk[6], pk[7]};
}

__device__ __forceinline__ void g1_unit(int u, const MkPtrs& P, LAS unsigned char* lds) {
    const int tid = threadIdx.x, lane = tid & 63, wid = __builtin_amdgcn_readfirstlane(tid >> 6), r32 = lane & 31, hi = lane >> 5;
    const int bh = u >> 6, c = u & 63, b = bh >> 2, h = bh & 3, tok0 = b * SEQ + c * 64, d = tid & 63, tg = tid >> 6;
    float bv[8], blast;
    cum_gates(P.GLR, P.wup, P.bias, tok0, h, lds, bv, blast);
    {
        float kl[8];
#pragma unroll
        for (int i = 0; i < 8; ++i) kl[i] = bf2f(P.GK[(size_t)(tok0 + tg * 8 + i) * 256 + h * 64 + d]) * expf(blast - bv[i]);
        *(LAS u32x4*)(lds + L_A + (d * LP + tg * 8) * 2) = (u32x4){pk2(kl[0], kl[1]), pk2(kl[2], kl[3]), pk2(kl[4], kl[5]), pk2(kl[6], kl[7])};
    }
    stage_vT(P.GV, tok0, h, lds);
    if (tid < 64) P.DV[(size_t)u * 64 + tid] = expf(blast);
    __syncthreads();
    {
        const int wd = wid & 1, we = wid >> 1;
        f32x16 acc;
#pragma unroll
        for (int i = 0; i < 16; ++i) acc[i] = 0.f;
#pragma unroll
        for (int s = 0; s < 4; ++s) {
            const bf16x8 af = *(const LAS bf16x8*)(lds + L_A + ((wd * 32 + r32) * LP + 16 * s + 8 * hi) * 2);
            const bf16x8 bf = *(const LAS bf16x8*)(lds + L_V + ((we * 32 + r32) * LP + 16 * s + 8 * hi) * 2);
            acc = __builtin_amdgcn_mfma_f32_32x32x16_bf16(af, bf, acc, 0, 0, 0);
        }
        bf16_t* dst = P.UT + ((size_t)u * 128 + we * 32 + r32) * 64 + wd * 32 + 4 * hi;
#pragma unroll
        for (int g = 0; g < 4; ++g) *(u32x2*)(dst + 8 * g) = (u32x2){pk2(acc[4 * g], acc[4 * g + 1]), pk2(acc[4 * g + 2], acc[4 * g + 3])};
    }
    __syncthreads();
}
__device__ __forceinline__ void g2_item(int item, const MkPtrs& P, bf16_t* STout) {
    const int tid = threadIdx.x, bh = item >> 4, idx = (item & 15) * 512 + tid, d = idx & 63;
    bf16_t* p = P.UT + (size_t)bh * 64 * 8192 + idx; const float* dvp = P.DV + (size_t)bh * 64 * 64 + d;
    bf16_t* po = STout + (size_t)bh * 64 * 8192 + idx;
    float S = 0.f;
#pragma unroll 1
    for (int c0 = 0; c0 < 64; c0 += 16) {
        float uu[16], dd[16];
#pragma unroll
        for (int i = 0; i < 16; ++i) { uu[i] = bf2f(p[(size_t)(c0 + i) * 8192]); dd[i] = dvp[(c0 + i) * 64]; }
        asm volatile("" ::: "memory");
#pragma unroll
        for (int i = 0; i < 16; ++i) { po[(size_t)(c0 + i) * 8192] = f2bf(S); S = fmaf(dd[i], S, uu[i]); }
    }
}
__device__ __forceinline__ void g3_unit(int u, const MkPtrs& P, bf16_t* MIXo, LAS unsigned char* lds) {
    const int tid = threadIdx.x, lane = tid & 63, wid = __builtin_amdgcn_readfirstlane(tid >> 6), r32 = lane & 31, hi = lane >> 5;
    const int bh = u >> 6, c = u & 63, b = bh >> 2, h = bh & 3, tok0 = b * SEQ + c * 64, d = tid & 63, tg = tid >> 6;
    float bv[8], blast;
    cum_gates(P.GLR, P.wup, P.bias, tok0, h, lds, bv, blast);
    {
        LAS bf16_t* qa = (LAS bf16_t*)(lds + L_A); LAS bf16_t* kb = (LAS bf16_t*)(lds + L_B);
#pragma unroll
        for (int i = 0; i < 8; ++i) {
            const int t = tg * 8 + i; const size_t g = (size_t)(tok0 + t) * 256 + h * 64 + d;
            qa[t * LP + d] = f2bf(bf2f(P.GQ[g]) * 0.125f * expf(bv[i]));
            kb[t * LP + d] = f2bf(bf2f(P.GK[g]) * expf(-bv[i]));
        }
    }
    stage_vT(P.GV, tok0, h, lds);
    __syncthreads();
    if (wid < 4) {
        const int ss = wid & 1, tt = wid >> 1;
        f32x16 acc;
#pragma unroll
        for (int i = 0; i < 16; ++i) acc[i] = 0.f;
        if (ss <= tt) {
#pragma unroll
            for (int s = 0; s < 4; ++s) {
                const bf16x8 af = *(const LAS bf16x8*)(lds + L_B + ((ss * 32 + r32) * LP + 16 * s + 8 * hi) * 2);
                const bf16x8 bf = *(const LAS bf16x8*)(lds + L_A + ((tt * 32 + r32) * LP + 16 * s + 8 * hi) * 2);
                acc = __builtin_amdgcn_mfma_f32_32x32x16_bf16(af, bf, acc, 0, 0, 0);
            }
        }
        const int t = tt * 32 + r32;
#pragma unroll
        for (int g = 0; g < 4; ++g) {
            float x[4];
#pragma unroll
            for (int e = 0; e < 4; ++e) { const int s = ss * 32 + 8 * g + 4 * hi + e; x[e] = (s <= t) ? acc[4 * g + e] : 0.f; }
            *(LAS u32x2*)(lds + L_A2 + (t * LP + ss * 32 + 8 * g + 4 * hi) * 2) = (u32x2){pk2(x[0], x[1]), pk2(x[2], x[3])};
        }
    }
    __syncthreads();
    const int ee = wid >> 1, tt = wid & 1;
    f32x16 o;
#pragma unroll
    for (int i = 0; i < 16; ++i) o[i] = 0.f;
    {
        const bf16_t* st = P.UT + ((size_t)u * 128 + ee * 32 + r32) * 64 + 8 * hi;
#pragma unroll
        for (int s = 0; s < 4; ++s) {
            const bf16x8 af = *(const bf16x8*)(st + 16 * s);
            const bf16x8 bf = *(const LAS bf16x8*)(lds + L_A + ((tt * 32 + r32) * LP + 16 * s + 8 * hi) * 2);
            o = __builtin_amdgcn_mfma_f32_32x32x16_bf16(af, bf, o, 0, 0, 0);
        }
#pragma unroll
        for (int s = 0; s < 4; ++s) {
            const bf16x8 af = *(const LAS bf16x8*)(lds + L_V + ((ee * 32 + r32) * LP + 16 * s + 8 * hi) * 2);
            const bf16x8 bf = *(const LAS bf16x8*)(lds + L_A2 + ((tt * 32 + r32) * LP + 16 * s + 8 * hi) * 2);
            o = __builtin_amdgcn_mfma_f32_32x32x16_bf16(af, bf, o, 0, 0, 0);
        }
    }
    float ssq = 0.f;
#pragma unroll
    for (int i = 0; i < 16; ++i) ssq = fmaf(o[i], o[i], ssq);
    ssq += __shfl_xor(ssq, 32);
    LAS float* red = (LAS float*)(lds + L_RED);
    const int t = tt * 32 + r32;
    if (hi == 0) red[ee * 64 + t] = ssq;
    __syncthreads();
    const float tot = (red[t] + red[64 + t]) + (red[128 + t] + red[192 + t]);
    const float rs = 1.0f / sqrtf(tot * (1.0f / 128.0f) + NORM_EPS);
    bf16_t* mrow = MIXo + (size_t)(tok0 + t) * 1024 + 512 + h * 128 + ee * 32 + 4 * hi;
    const float* gw = P.gnw + ee * 32 + 4 * hi;
#pragma unroll
    for (int g = 0; g < 4; ++g) {
        const u32x2 gg = *(const u32x2*)(mrow + 8 * g);
        const f32x4 w4 = *(const f32x4*)(gw + 8 * g);
        const float y0 = o[4 * g] * rs * w4[0] * __builtin_bit_cast(float, gg.x << 16), y1 = o[4 * g + 1] * rs * w4[1] * __builtin_bit_cast(float, gg.x & 0xffff0000u);
        const float y2 = o[4 * g + 2] * rs * w4[2] * __builtin_bit_cast(float, gg.y << 16), y3 = o[4 * g + 3] * rs * w4[3] * __builtin_bit_cast(float, gg.y & 0xffff0000u);
        *(u32x2*)(mrow + 8 * g) = (u32x2){pk2(y0, y1), pk2(y2, y3)};
    }
    __syncthreads();
}
}
constexpr int MK_LDS = 147456;
constexpr int N_PHASES = 9;
struct MkArgs { const float* x; const int* pos; const float* w_in; const float* wup; const float* bgate; const float* gnw; const float* w_out; const float* prew; const float* postw;
                float* out; unsigned char* ws; int ph_lo, ph_hi; };
__global__ void __launch_bounds__(512, 2) mk_fwd(MkArgs a) {
    extern __shared__ __attribute__((aligned(16))) unsigned char lds_raw[];
    LAS unsigned char* lds = (LAS unsigned char*)lds_raw;
    cg::grid_group grid = cg::this_grid();
    const int tid = threadIdx.x, lane = tid & 63, wave = __builtin_amdgcn_readfirstlane(tid >> 6);
    const int G = gridDim.x, bx = blockIdx.x;
    const int vcu = (G % 8 == 0) ? (bx % 8) * (G / 8) + bx / 8 : bx;
    unsigned char* ws = a.ws;
    const MkPtrs PT{(const float*)(ws + WS_GLR), a.wup, a.bgate, a.gnw, (const bf16_t*)(ws + WS_GQ), (const bf16_t*)(ws + WS_GK), (const bf16_t*)(ws + WS_GV),
                    (bf16_t*)(ws + WS_UT), (float*)(ws + WS_DV), (bf16_t*)(ws + WS_MIX)};
#define IN(k) (a.ph_lo <= (k) && (k) < a.ph_hi)
    volatile LAS unsigned* bst = (volatile LAS unsigned*)(lds + MK_LDS - 16);
    if (tid < 4) bst[tid] = 0u;
    __syncthreads();
    XcdBarrier xbar = xcd_barrier_post((unsigned*)(ws + WS_CTL) + CW_BAR, bst);
    if (a.ph_hi > 1000) grid.sync();
#ifndef MK_REPS
#define MK_REPS {1, 1, 1, 1, 1, 1, 1, 1, 1}
#endif
#ifndef MK_XSYNC
#define MK_XSYNC 0
#endif
    constexpr int REPS[N_PHASES] = MK_REPS;
    MkPtrs PTD = PT; PTD.UT = (bf16_t*)(ws + WS_DUMMY); PTD.MIX = (bf16_t*)(ws + WS_DUMMY);
#define SEAM(k) do { if (IN(k) && IN((k) + 1)) { xcd_barrier(xbar); for (int xs_ = 0; xs_ < MK_XSYNC; ++xs_) xcd_barrier(xbar); } } while (0)
    if (IN(0)) for (int rep = 0; rep < REPS[0]; ++rep) {
        LAS float* scr = (LAS float*)(lds + wave * 16384);
        const int gw = vcu * 8 + wave, NGW = G * 8;
        constexpr int I_W1 = 16 * (NF / 32), I_W2 = 16 * (DM / 32);
        for (int it = gw; it < I_W1 + I_W2; it += NGW) {
            if (it < I_W1) p0_transpose_item<true>(a.w_in, NPROJ, a.prew, (bf16_t*)(ws + WS_W1T), (bf16_t*)(ws + WS_W1L), scr, it, NF / 32, lane);
            else p0_transpose_item<false>(a.w_out, DM, nullptr, (bf16_t*)(ws + WS_W2T), nullptr, scr, it - I_W1, DM / 32, lane);
        }
        for (int row = gw; row < M; row += NGW) p0_row(a.x, a.pos, ws, row, lane);
    }
    SEAM(0);
    if (IN(1)) for (int rep = 0; rep < REPS[1]; ++rep) {
        ProbProj P{(const bf16_t*)(ws + WS_XH), (const bf16_t*)(ws + WS_XL), (const bf16_t*)(ws + WS_W1T), (const bf16_t*)(ws + WS_W1L)};
        SchedProj S{G, vcu};
        EpiProj E{ws};
        pg8::gemm_phase<EpiProj, SchedProj, ProbProj, true>(lds, P, S, E);
    }
    SEAM(1);
    if (IN(2)) for (int rep = 0; rep < REPS[2]; ++rep) { for (int u = vcu; u < gla::NUNITS; u += G) gla::g1_unit(u, PT, lds); }
    SEAM(2);
    if (IN(3)) for (int rep = 0; rep < REPS[3]; ++rep) { for (int it = vcu; it < 256; it += G) gla::g2_item(it, PT, rep ? PTD.UT : PT.UT); }
    SEAM(3);
    if (IN(4)) for (int rep = 0; rep < REPS[4]; ++rep) { for (int u = vcu; u < gla::NUNITS; u += G) gla::g3_unit(u, PT, rep ? PTD.MIX : PT.MIX, lds); }
    SEAM(4);
    if (IN(5)) for (int rep = 0; rep < REPS[5]; ++rep) sel::phase(ws, ws + WS_SC, lds, G, vcu);
    SEAM(5);
    if (IN(6)) for (int rep = 0; rep < REPS[6]; ++rep) {
        const attn_body::AttnTensors AT{(const attn_body::bf16*)(ws + WS_Q), (const attn_body::bf16*)(ws + WS_K), (const attn_body::bf16*)(ws + WS_V), (const unsigned*)(ws + WS_MASK), (attn_body::bf16*)(ws + (rep ? WS_DUMMY : WS_MIX))};
        const attn_body::StaticOrder S(G, vcu);
        attn_body::attn_phase<attn_body::StaticOrder>((char*)lds_raw, AT, S);
    }
    SEAM(6);
    if (IN(7)) for (int rep = 0; rep < REPS[7]; ++rep) {
        ProbOut P{(const bf16_t*)(ws + WS_MIX), (const bf16_t*)(ws + WS_W2T)};
        SchedOut S{G, vcu};
        EpiY E{(float*)(ws + WS_TMP)};
        pg8::gemm_phase<EpiY, SchedOut, ProbOut, false>(lds, P, S, E);
    }
    SEAM(7);
    if (IN(8)) for (int rep = 0; rep < REPS[8]; ++rep) {
        const int gw = vcu * 8 + wave, NGW = G * 8;
        for (int row = gw; row < M; row += NGW) p6_row(a.x, (const float*)(ws + WS_TMP), a.postw, a.out, row, lane);
    }
#undef IN
#undef SEAM
}

#ifndef MK_CUTS
#define MK_CUTS {0, 9}
#endif
extern "C" void kernel_launch(void* const* d_in, const int* in_sizes, int n_in, void* d_out, int out_size, void* d_ws, size_t ws_size, hipStream_t stream) {
    const float* x = (const float*)d_in[0]; const int* pos = (const int*)d_in[1]; const float* w_in = (const float*)d_in[2];
    const float* wup = (const float*)d_in[3]; const float* bgate = (const float*)d_in[4]; const float* gnw = (const float*)d_in[5];
    const float* w_out = (const float*)d_in[6]; const float* prew = (const float*)d_in[7]; const float* postw = (const float*)d_in[8];
    unsigned char* ws = (unsigned char*)d_ws; float* out = (float*)d_out;
    static int grid_blocks = 0;
    if (!grid_blocks) {
        int dev = 0, cus = 0, per_cu = 0;
        (void)hipGetDevice(&dev);
        (void)hipDeviceGetAttribute(&cus, hipDeviceAttributeMultiprocessorCount, dev);
        (void)hipFuncSetAttribute((const void*)mk_fwd, hipFuncAttributeMaxDynamicSharedMemorySize, MK_LDS);
        (void)hipOccupancyMaxActiveBlocksPerMultiprocessor(&per_cu, (const void*)mk_fwd, 512, MK_LDS);
        if (per_cu < 1) per_cu = 1;
        grid_blocks = cus * per_cu;
    }
    auto launch = [&](int lo, int hi) {
        MkArgs a{}; a.x = x; a.pos = pos; a.w_in = w_in; a.wup = wup; a.bgate = bgate; a.gnw = gnw; a.w_out = w_out; a.prew = prew; a.postw = postw;
        a.out = out; a.ws = ws; a.ph_lo = lo; a.ph_hi = hi;
        void* args[] = {&a};
        hipError_t e = hipLaunchCooperativeKernel((const void*)mk_fwd, dim3(grid_blocks), dim3(512), args, MK_LDS, stream);
        if (e != hipSuccess) fprintf(stderr, "cooperative launch [%d,%d) failed: %s (grid %d)\n", lo, hi, hipGetErrorString(e), grid_blocks);
    };
    (void)hipMemsetAsync(ws + WS_CTL, 0, CTL_ZERO_BYTES, stream);
    const int cuts[] = MK_CUTS;
    for (int i = 0; i + 1 < (int)(sizeof(cuts) / sizeof(cuts[0])); ++i) launch(cuts[i], cuts[i + 1]);
}
```

```cpp
#include <hip/hip_runtime.h>
#include <hip/hip_cooperative_groups.h>
#include <stdint.h>
#include <cstdio>
namespace cg = cooperative_groups;

constexpr int BATCH = 4, SEQ = 4096, M = BATCH * SEQ, DM = 1024, NPROJ = 3924;
constexpr int OFF_AQ = 0, OFF_AK = 512, OFF_AV = 1024, OFF_IQ = 1536, OFF_IK = 1792, OFF_IW = 1856, OFF_AG = 1860,
              OFF_GQ = 2372, OFF_GK = 2628, OFF_GV = 2884, OFF_GLR = 3396, OFF_GG = 3412;
constexpr int TOPK = 256;
constexpr float NORM_EPS = 1e-6f;
constexpr float C2 = 0.125f * 1.4426950408889634f;
constexpr int NF = 4096;

constexpr size_t MiB = 1u << 20;
constexpr size_t WS_CTL = 0, WS_RSTD = 1 * MiB, WS_ROPE = 2 * MiB, WS_W2T = 3 * MiB, WS_Q = 6 * MiB, WS_K = 22 * MiB, WS_V = 38 * MiB, WS_MIX = 54 * MiB,
                 WS_GQ = 86 * MiB, WS_GK = 94 * MiB, WS_GV = 102 * MiB, WS_IQH = 118 * MiB, WS_IQL = 126 * MiB, WS_IKH = 134 * MiB, WS_IKL = 136 * MiB, WS_IW = 138 * MiB, WS_GLR = 139 * MiB,
                 WS_MASK = 140 * MiB, WS_XH = 148 * MiB, WS_XL = 180 * MiB, WS_W1T = 212 * MiB, WS_W1L = 220 * MiB, WS_TMP = 148 * MiB, WS_SC = 148 * MiB, WS_UT = 148 * MiB, WS_DV = 166 * MiB, WS_DUMMY = 180 * MiB;

constexpr int CW_BAR = 4096;
constexpr size_t CTL_ZERO_BYTES = 65536;
typedef unsigned short bf16_t;
#define LAS __attribute__((address_space(3)))
__device__ __forceinline__ unsigned f2bf_u(float f) { unsigned u = __builtin_bit_cast(unsigned, f); return (u + 0x7fffu + ((u >> 16) & 1u)) >> 16; }
__device__ __forceinline__ bf16_t f2bf(float f) { return (bf16_t)f2bf_u(f); }
__device__ __forceinline__ float bf2f(bf16_t b) { return __builtin_bit_cast(float, (unsigned)b << 16); }
__device__ __forceinline__ unsigned pk2(float lo, float hi) { return f2bf_u(lo) | (f2bf_u(hi) << 16); }
__device__ __forceinline__ float wave_sum(float v) {
#pragma unroll
    for (int o = 1; o < 64; o <<= 1) v += __shfl_xor(v, o);
    return v;
}
__device__ __forceinline__ float silu(float x) { return x / (1.f + __expf(-x)); }
__device__ __forceinline__ int cmap(int n) {
    if (n < 512) return OFF_AQ + n;
    if (n < 1024) return OFF_AK + (n - 512);
    if (n < 1536) return OFF_AV + (n - 1024);
    if (n < 2048) return OFF_AG + (n - 1536);
    if (n < 2304) return OFF_GQ + (n - 2048);
    if (n < 2560) return OFF_GK + (n - 2304);
    if (n < 3072) return OFF_GV + (n - 2560);
    if (n < 3584) return OFF_GG + (n - 3072);
    if (n < 3840) return OFF_IQ + (n - 3584);
    const int l = n - 3840;
    if (l < 64) return OFF_IK + l;
    if (l < 68) return OFF_IW + (l - 64);
    if (l >= 72 && l < 88) return OFF_GLR + (l - 72);
    return -1;
}

struct MkPtrs { const float* GLR; const float* wup; const float* bias; const float* gnw; const bf16_t* GQ; const bf16_t* GK; const bf16_t* GV; bf16_t* UT; float* DV; bf16_t* MIX; };
#define XB_TMO      128
#define XB_XCNT(j)  (256  + 64 * (j))
#define XB_XSUB(j)  (1280 + 64 * (j))
#define XB_XGEN(j)  (2304 + 64 * (j))
#define XB_TOP      3328
#define XB_TOPGEN   3392
#define XCD_BAR_WORDS 3456
#define XB_SPIN_CAP (1u << 18)

__device__ __forceinline__ unsigned xb_ld(unsigned* p)              { return __hip_atomic_load(p, __ATOMIC_RELAXED, __HIP_MEMORY_SCOPE_AGENT); }
__device__ __forceinline__ unsigned xb_add(unsigned* p, unsigned v) { return __hip_atomic_fetch_add(p, v, __ATOMIC_RELAXED, __HIP_MEMORY_SCOPE_AGENT); }
__device__ __forceinline__ unsigned xb_xcc_id() { return (unsigned)__builtin_amdgcn_s_getreg((3 << 11) | 20) & 0xFu; }
#define XB_SPIN(cond, bar) do { unsigned _sp = 0; while (cond) { __builtin_amdgcn_s_sleep(1); \
    if ((++_sp & 255u) == 0u) { if (xb_ld(&(bar)[XB_TMO])) break; if (_sp > XB_SPIN_CAP) { atomicAdd(&(bar)[XB_TMO], 1u); break; } } } } while (0)

struct XcdBarrier {
    unsigned* bar; unsigned x;
    volatile LAS unsigned* st;
};

__device__ __forceinline__ XcdBarrier xcd_barrier_post(unsigned* bar, volatile LAS unsigned* st) {
    XcdBarrier b; b.bar = bar; b.x = xb_xcc_id(); b.st = st;
    if (threadIdx.x == 0) (void)xb_add(&bar[XB_XCNT(b.x)], 1u);
    return b;
}
__device__ __forceinline__ void xcd_barrier_complete(unsigned* bar, unsigned x, unsigned& nloc, unsigned& nx) {
    const unsigned G = gridDim.x * gridDim.y * gridDim.z;
    unsigned sum, cnt, mine, sp = 0u;
    for (;;) {
        sum = 0u; cnt = 0u; mine = 0u;
#pragma unroll
        for (unsigned j = 0; j < 16; ++j) { const unsigned c = xb_ld(&bar[XB_XCNT(j)]); sum += c; cnt += (c > 0u) ? 1u : 0u; mine = (j == x) ? c : mine; }
        if (sum == G) break;
        __builtin_amdgcn_s_sleep(1);
        if ((++sp & 255u) == 0u) { if (xb_ld(&bar[XB_TMO])) break; if (sp > XB_SPIN_CAP) { atomicAdd(&bar[XB_TMO], 1u); break; } }
    }
    nloc = mine > 0u ? mine : 1u; nx = cnt > 0u ? cnt : 1u;
}

__device__ __forceinline__ void xcd_barrier(const XcdBarrier& b) {
    asm volatile("s_waitcnt vmcnt(0)" ::: "memory");
    __syncthreads();
    if (threadIdx.x == 0) {
        unsigned* bar = b.bar;
        __builtin_amdgcn_s_waitcnt(0);
        unsigned nloc = b.st[0], nx = b.st[1];
        if (nloc == 0u) { xcd_barrier_complete(bar, b.x, nloc, nx); b.st[0] = nloc; b.st[1] = nx; }
        const unsigned old = xb_add(&bar[XB_XSUB(b.x)], 1u);
        const unsigned gen = old / nloc;
        if (old + 1u == (gen + 1u) * nloc) {
            __builtin_amdgcn_fence(__ATOMIC_RELEASE, "agent");
            asm volatile("s_waitcnt vmcnt(0)" ::: "memory");
            const unsigned og = xb_add(&bar[XB_TOP], 1u);
            const unsigned tg = og / nx;
            if (og + 1u == (tg + 1u) * nx) xb_add(&bar[XB_TOPGEN], 1u);
            else XB_SPIN(xb_ld(&bar[XB_TOPGEN]) == tg, bar);
            __builtin_amdgcn_fence(__ATOMIC_ACQUIRE, "agent");
            xb_add(&bar[XB_XGEN(b.x)], 1u);
            asm volatile("s_waitcnt vmcnt(0)" ::: "memory");
        } else {
            XB_SPIN(xb_ld(&bar[XB_XGEN(b.x)]) == gen, bar);
            __builtin_amdgcn_fence(__ATOMIC_ACQUIRE, "agent");
            asm volatile("s_waitcnt vmcnt(0)" ::: "memory");
        }
    }
    __syncthreads();
}
namespace pg8 {
typedef short bf16x8 __attribute__((ext_vector_type(8)));
typedef float f32x4 __attribute__((ext_vector_type(4)));
typedef unsigned u32x4 __attribute__((ext_vector_type(4)));
constexpr int BM = 256, BK = 64, HALF = 128, HTB = HALF * BK * 2, STAGE_BYTES = 8 * HTB, KP = 1024  ;
__host__ __device__ __forceinline__ int lds_byte(int r, int c) { const int st = (r >> 4) * 2 + (c >> 5), rr = r & 15, cc = c & 31, ob = rr * 64 + cc * 2; return st * 1024 + (ob ^ (((ob >> 9) & 1) << 5)); }
__host__ __device__ __forceinline__ void stage_rc(int b, int& R, int& C) { const int st = b / 1024, sb = b % 1024, swz = sb ^ (((sb >> 9) & 1) << 5); R = (st >> 1) * 16 + swz / 64; C = (st & 1) * 32 + (swz % 64) / 2; }
__host__ __device__ __forceinline__ int perm32(int rho) { const int n = rho >> 4, i = rho & 15; return 8 * (i >> 2) + 4 * n + (i & 3); }
struct Unit { int pm, pn, kind; };

template <class Epi, class Sched, class Prob, bool ALIGN_EPI>
__device__ __forceinline__ void gemm_phase(LAS unsigned char* lds, const Prob& P, const Sched& S, const Epi& E) {
    const int tid = threadIdx.x, wid = __builtin_amdgcn_readfirstlane(tid >> 6), lane = tid & 63, wr = wid >> 2, wc = wid & 3, fr = lane & 15, fq = lane >> 4;
    unsigned voffA[2], voffB[2];
#pragma unroll
    for (int i = 0; i < 2; ++i) { int R, C; stage_rc(tid * 16 + i * 8192, R, C); const int Rb = Epi::PERM ? ((R & ~31) + perm32(R & 31)) : R;
        voffA[i] = (unsigned)(R * KP + C) * 2u; voffB[i] = (unsigned)(Rb * KP + C) * 2u; }
    const size_t hstep = (size_t)HALF * KP * 2;
    const unsigned ldsw = (unsigned)wid * 1024u;
    const int aoff = lds_byte(wr * 64 + fr, fq * 8), boff = lds_byte(wc * 32 + fr, fq * 8);
#define PG8_SA(b, h) (((b) * 2 + (h)) * HTB)
#define PG8_SB(b, h) ((4 + (b) * 2 + (h)) * HTB)
#define PG8_STAGE(bufoff, gbase, voff) do { _Pragma("unroll") for (int _i = 0; _i < 2; ++_i) \
        __builtin_amdgcn_global_load_lds((const unsigned*)((const char*)(gbase) + (voff)[_i]), (LAS unsigned*)(lds + (bufoff) + ldsw + _i * 8192), 16, 0, 0); } while (0)
#define PG8_LDA(dst, b, h) do { _Pragma("unroll") for (int m = 0; m < 4; ++m) _Pragma("unroll") for (int k = 0; k < 2; ++k) dst[m][k] = *(const LAS bf16x8*)(lds + PG8_SA(b, h) + aoff + m * 2048 + k * 1024); } while (0)
#define PG8_LDB(dst, b, h) do { _Pragma("unroll") for (int n = 0; n < 2; ++n) _Pragma("unroll") for (int k = 0; k < 2; ++k) dst[n][k] = *(const LAS bf16x8*)(lds + PG8_SB(b, h) + boff + n * 2048 + k * 1024); } while (0)
#define PG8_MMA(ai, bj, At, Bt) do { __builtin_amdgcn_s_setprio(1); _Pragma("unroll") for (int m = 0; m < 4; ++m) _Pragma("unroll") for (int n = 0; n < 2; ++n) _Pragma("unroll") for (int k = 0; k < 2; ++k) \
        acc[ai][bj][m][n] = __builtin_amdgcn_mfma_f32_16x16x32_bf16(Bt[n][k], At[m][k], acc[ai][bj][m][n], 0, 0, 0); __builtin_amdgcn_s_setprio(0); } while (0)
#define PG8_WAIT_V(n) asm volatile("s_waitcnt vmcnt(" #n ")" ::: "memory")
#define PG8_WAIT_L(n) asm volatile("s_waitcnt lgkmcnt(" #n ")" ::: "memory")
#define PG8_BAR __builtin_amdgcn_s_barrier()
#define PG8_SCHED __builtin_amdgcn_sched_barrier(0)
    Unit cur, nxt; int ui = 0;
    if (!S.next(0, cur)) return;
    f32x4 acc[2][2][4][2];
#pragma unroll
    for (int a = 0; a < 2; ++a)
#pragma unroll
        for (int b = 0; b < 2; ++b)
#pragma unroll
            for (int m = 0; m < 4; ++m)
#pragma unroll
                for (int n = 0; n < 2; ++n) acc[a][b][m][n] = (f32x4){0.f, 0.f, 0.f, 0.f};
    bf16x8 At[4][2], B0[2][2], B1[2][2];
    {
        const char* a0 = P.a(cur, 0); const char* b0 = P.b(cur, 0); const char* a1 = P.a(cur, 1); const char* b1 = P.b(cur, 1);
        PG8_STAGE(PG8_SB(0, 0), b0, voffB); PG8_STAGE(PG8_SB(0, 1), b0 + hstep, voffB); PG8_STAGE(PG8_SA(0, 0), a0, voffA); PG8_STAGE(PG8_SA(0, 1), a0 + hstep, voffA);
        if (wr == 1) PG8_BAR;
        PG8_WAIT_V(2); PG8_BAR;
        PG8_STAGE(PG8_SB(1, 0), b1, voffB); PG8_STAGE(PG8_SA(1, 0), a1, voffA); PG8_STAGE(PG8_SB(1, 1), b1 + hstep, voffB);
        PG8_WAIT_V(6); PG8_BAR;
    }
    for (;;) {
        const bool has_next = S.next(ui + 1, nxt);
        const Unit nu = has_next ? nxt : cur;
        const int nt = P.nt(cur);
        for (int t = 0; t < nt; t += 2) {
            const bool last = (t == nt - 2);
            const char* a1 = P.a(cur, t + 1);
            const char* a2 = last ? P.a(nu, 0) : P.a(cur, t + 2); const char* b2 = last ? P.b(nu, 0) : P.b(cur, t + 2);
            const char* a3 = last ? P.a(nu, 1) : P.a(cur, t + 3); const char* b3 = last ? P.b(nu, 1) : P.b(cur, t + 3);
            PG8_LDB(B0, 0, 0); PG8_LDB(B1, 0, 1); PG8_SCHED; PG8_LDA(At, 0, 0); PG8_STAGE(PG8_SA(1, 1), a1 + hstep, voffA);
            PG8_WAIT_V(8); PG8_WAIT_L(0); PG8_BAR; PG8_MMA(0, 0, At, B0); PG8_MMA(0, 1, At, B1); PG8_BAR; PG8_SCHED;
            PG8_LDA(At, 0, 1); PG8_STAGE(PG8_SB(0, 0), b2, voffB); PG8_STAGE(PG8_SB(0, 1), b2 + hstep, voffB); PG8_STAGE(PG8_SA(0, 0), a2, voffA);
            PG8_WAIT_V(8); PG8_WAIT_L(0); PG8_BAR; PG8_MMA(1, 0, At, B0); PG8_MMA(1, 1, At, B1); PG8_BAR; PG8_SCHED;
            PG8_LDB(B0, 1, 0); PG8_LDB(B1, 1, 1); PG8_SCHED; PG8_LDA(At, 1, 0); PG8_STAGE(PG8_SA(0, 1), a2 + hstep, voffA);
            PG8_WAIT_V(8); PG8_WAIT_L(0); PG8_BAR; PG8_MMA(0, 0, At, B0); PG8_MMA(0, 1, At, B1); PG8_BAR; PG8_SCHED;
            PG8_LDA(At, 1, 1); PG8_STAGE(PG8_SB(1, 0), b3, voffB); PG8_STAGE(PG8_SB(1, 1), b3 + hstep, voffB); PG8_STAGE(PG8_SA(1, 0), a3, voffA);
            PG8_WAIT_V(8); PG8_WAIT_L(0); PG8_BAR; PG8_MMA(1, 0, At, B0); PG8_MMA(1, 1, At, B1); PG8_BAR; PG8_SCHED;
        }
        if constexpr (ALIGN_EPI) { if (wr == 0) PG8_BAR; }
        if constexpr (!Epi::AFTER_DRAIN) { E(acc, cur, wr, wc, fr, fq); }
        if (!has_next) break;
#pragma unroll
        for (int a = 0; a < 2; ++a)
#pragma unroll
            for (int b = 0; b < 2; ++b)
#pragma unroll
                for (int m = 0; m < 4; ++m)
#pragma unroll
                    for (int n = 0; n < 2; ++n) acc[a][b][m][n] = (f32x4){0.f, 0.f, 0.f, 0.f};
        cur = nxt; ++ui;
        if constexpr (ALIGN_EPI) { if (wr == 1) PG8_BAR; }
    }
    PG8_WAIT_V(0);
    if constexpr (!ALIGN_EPI) { if (wr == 0) PG8_BAR; }
    PG8_BAR;
    if constexpr (Epi::AFTER_DRAIN) { E.fused(acc, cur, wr, wc, fr, fq, lds, wid, lane); }
#undef PG8_SA
#undef PG8_SB
#undef PG8_STAGE
#undef PG8_LDA
#undef PG8_LDB
#undef PG8_MMA
#undef PG8_WAIT_V
#undef PG8_WAIT_L
#undef PG8_BAR
#undef PG8_SCHED
}
}
typedef float f32x4 __attribute__((ext_vector_type(4)));
typedef unsigned u32x4 __attribute__((ext_vector_type(4)));
typedef unsigned u32x2 __attribute__((ext_vector_type(2)));

struct ProbProj {
    const bf16_t *XH, *XL, *W1T, *W1L;
    __device__ __forceinline__ int nt(const pg8::Unit& u) const { return u.kind ? 48 : 16; }
    __device__ __forceinline__ const char* a(const pg8::Unit& u, int t) const {
        const bf16_t* base = (u.kind && t >= 16 && t < 32) ? XL : XH;
        return (const char*)(base + (size_t)u.pm * 256 * pg8::KP) + (size_t)(t & 15) * 128; }
    __device__ __forceinline__ const char* b(const pg8::Unit& u, int t) const {
        const bf16_t* base = (u.kind && t >= 32) ? (W1L + (size_t)(u.pn - 14) * 256 * pg8::KP) : (W1T + (size_t)u.pn * 256 * pg8::KP);
        return (const char*)base + (size_t)(t & 15) * 128; }
};
struct SchedProj {
    int G, c;
    __device__ __forceinline__ bool next(int i, pg8::Unit& u) const {
        if (G == 256) {
            const int role = c & 3; u.pm = c >> 2;
            if (role < 2) { if (i >= 3) return false; if (i == 0) { u.pn = 14 + role; u.kind = 1; } else { u.pn = role * 2 + (i - 1); u.kind = 0; } }
            else { if (i >= 5) return false; u.pn = 4 + (role - 2) * 5 + i; u.kind = 0; }
            return true;
        }
        const long L = (long)i * G + c; if (L >= 64 * 16) return false;
        const int pn = 15 - (int)(L / 64); u.pm = (int)(L % 64); u.pn = pn; u.kind = pn >= 14 ? 1 : 0; return true;
    }
};
__device__ __forceinline__ void split_store8(const f32x4& v0, const f32x4& v1, bf16_t* ph, bf16_t* pl) {
    u32x4 h; h.x = pk2(v0[0], v0[1]); h.y = pk2(v0[2], v0[3]); h.z = pk2(v1[0], v1[1]); h.w = pk2(v1[2], v1[3]);
    f32x4 l0, l1;
    l0[0] = v0[0] - __builtin_bit_cast(float, h.x << 16); l0[1] = v0[1] - __builtin_bit_cast(float, h.x & 0xffff0000u);
    l0[2] = v0[2] - __builtin_bit_cast(float, h.y << 16); l0[3] = v0[3] - __builtin_bit_cast(float, h.y & 0xffff0000u);
    l1[0] = v1[0] - __builtin_bit_cast(float, h.z << 16); l1[1] = v1[1] - __builtin_bit_cast(float, h.z & 0xffff0000u);
    l1[2] = v1[2] - __builtin_bit_cast(float, h.w << 16); l1[3] = v1[3] - __builtin_bit_cast(float, h.w & 0xffff0000u);
    u32x4 l; l.x = pk2(l0[0], l0[1]); l.y = pk2(l0[2], l0[3]); l.z = pk2(l1[0], l1[1]); l.w = pk2(l1[2], l1[3]);
    *(u32x4*)ph = h; *(u32x4*)pl = l;
}
struct EpiProj {
    static constexpr bool PERM = true, AFTER_DRAIN = false;
    unsigned char* ws;
    __device__ __forceinline__ void operator()(const f32x4 (&acc)[2][2][4][2], const pg8::Unit& u, int wr, int wc, int fr, int fq) const {
        const int pn = u.pn;
        const float* rstd = (const float*)(ws + WS_RSTD); const float* rope = (const float*)(ws + WS_ROPE);
        const bool rope_tile = (pn < 4) || (pn >= 14);
        const bool rope_wave = rope_tile && ((wc & 1) == 0);
        int mode, ld, coloff; unsigned char* base; float sc = 1.f;
        if (pn < 2)       { mode = 0; base = ws + WS_Q;   ld = 512;  coloff = pn * 256; sc = C2; }
        else if (pn < 4)  { mode = 0; base = ws + WS_K;   ld = 512;  coloff = (pn - 2) * 256; }
        else if (pn < 6)  { mode = 0; base = ws + WS_V;   ld = 512;  coloff = (pn - 4) * 256; }
        else if (pn < 8)  { mode = 1; base = ws + WS_MIX; ld = 1024; coloff = (pn - 6) * 256; }
        else if (pn == 8) { mode = 0; base = ws + WS_GQ;  ld = 256;  coloff = 0; }
        else if (pn == 9) { mode = 0; base = ws + WS_GK;  ld = 256;  coloff = 0; }
        else if (pn < 12) { mode = 0; base = ws + WS_GV;  ld = 512;  coloff = (pn - 10) * 256; }
        else if (pn < 14) { mode = 1; base = ws + WS_MIX; ld = 1024; coloff = 512 + (pn - 12) * 256; }
        else if (pn == 14){ mode = 2; base = ws + WS_IQH; ld = 256;  coloff = 0; }
        else              { mode = 3; base = ws + WS_IKH; ld = 64;   coloff = 0; }
        const int row0 = u.pm * 256 + wr * 64 + fr;
#pragma unroll
        for (int ai = 0; ai < 2; ++ai)
#pragma unroll
            for (int m = 0; m < 4; ++m) {
                const int row = row0 + ai * 128 + m * 16;
                const float r = rstd[row];
                f32x4 c_lo = {1.f, 1.f, 1.f, 1.f}, c_hi = c_lo, s_lo = {0.f, 0.f, 0.f, 0.f}, s_hi = s_lo;
                if (rope_wave) { const f32x4* rp = (const f32x4*)(rope + (size_t)row * 16); c_lo = rp[0]; c_hi = rp[1]; s_lo = rp[2]; s_hi = rp[3]; }
#pragma unroll
                for (int bj = 0; bj < 2; ++bj) {
                    f32x4 v0 = acc[ai][bj][m][0] * r, v1 = acc[ai][bj][m][1] * r;
                    if (rope_wave && (pn != 15 || (bj == 0 && wc == 0))) {
                        f32x4 p0, p1;
#pragma unroll
                        for (int j = 0; j < 4; ++j) { p0[j] = __shfl_xor(v0[j], 16); p1[j] = __shfl_xor(v1[j], 16); }
                        if (fq == 0) { v0 = v0 * c_lo - p0 * s_lo; v1 = v1 * c_hi - p1 * s_hi; }
                        else if (fq == 1) { v0 = v0 * c_lo + p0 * s_lo; v1 = v1 * c_hi + p1 * s_hi; }
                    }
                    const int c0 = bj * 128 + wc * 32 + 8 * fq;
                    if (mode == 0 || mode == 1) {
                        if (mode == 1) {
#pragma unroll
                            for (int j = 0; j < 4; ++j) { v0[j] = silu(v0[j]); v1[j] = silu(v1[j]); }
                        } else { v0 = v0 * sc; v1 = v1 * sc; }
                        u32x4 w; w.x = pk2(v0[0], v0[1]); w.y = pk2(v0[2], v0[3]); w.z = pk2(v1[0], v1[1]); w.w = pk2(v1[2], v1[3]);
                        *(u32x4*)((bf16_t*)base + (size_t)row * ld + coloff + c0) = w;
                    } else if (mode == 2) {
                        split_store8(v0, v1, (bf16_t*)(ws + WS_IQH) + (size_t)row * 256 + c0, (bf16_t*)(ws + WS_IQL) + (size_t)row * 256 + c0);
                    } else {
                        if (c0 < 64) split_store8(v0, v1, (bf16_t*)(ws + WS_IKH) + (size_t)row * 64 + c0, (bf16_t*)(ws + WS_IKL) + (size_t)row * 64 + c0);
                        else if (c0 == 64) { *(f32x4*)((float*)(ws + WS_IW) + (size_t)row * 4) = v0 * (0.5f * 0.125f); }
                        else if (c0 == 72) { float* p = (float*)(ws + WS_GLR) + (size_t)row * 16; *(f32x4*)p = v0; *(f32x4*)(p + 4) = v1; }
                        else if (c0 == 80) { float* p = (float*)(ws + WS_GLR) + (size_t)row * 16 + 8; *(f32x4*)p = v0; *(f32x4*)(p + 4) = v1; }
                    }
                }
            }
    }
};

template <bool MAPPED>
__device__ __forceinline__ void p0_transpose_item(const float* W, int Nsrc, const float* ksc, bf16_t* WT, bf16_t* WL, LAS float* scr, int item, int nblk, int lane) {
    const int kb = item / nblk, nb = item % nblk, k0 = 64 * kb, n0 = 32 * nb;
    const int srcc = MAPPED ? cmap(n0 + (lane & 31)) : (n0 + (lane & 31));
#pragma unroll 8
    for (int i = 0; i < 32; ++i) { const int kk = 2 * i + (lane >> 5);
        float v = W[(size_t)(k0 + kk) * Nsrc + (srcc < 0 ? 0 : srcc)]; if (MAPPED) v *= ksc[k0 + kk];
        scr[kk * 33 + (lane & 31)] = (srcc < 0) ? 0.f : v; }
    asm volatile("s_waitcnt lgkmcnt(0)" ::: "memory");
    const int c = lane & 7;
#pragma unroll
    for (int j = 0; j < 4; ++j) { const int n = (lane >> 3) + 8 * j; const LAS float* s = scr + (8 * c) * 33 + n;
        float v[8];
#pragma unroll
        for (int q = 0; q < 8; ++q) v[q] = s[q * 33];
        u32x4 o; o.x = pk2(v[0], v[1]); o.y = pk2(v[2], v[3]); o.z = pk2(v[4], v[5]); o.w = pk2(v[6], v[7]);
        *(u32x4*)(WT + (size_t)(n0 + n) * 1024 + k0 + 8 * c) = o;
        if (MAPPED && n0 >= 3584) {
            float l[8];
#pragma unroll
            for (int q = 0; q < 8; ++q) l[q] = v[q] - bf2f(f2bf(v[q]));
            u32x4 ol; ol.x = pk2(l[0], l[1]); ol.y = pk2(l[2], l[3]); ol.z = pk2(l[4], l[5]); ol.w = pk2(l[6], l[7]);
            *(u32x4*)(WL + (size_t)(n0 - 3584 + n) * 1024 + k0 + 8 * c) = ol;
        }
    }
    asm volatile("s_waitcnt lgkmcnt(0)" ::: "memory");
}
__device__ __forceinline__ void p0_row(const float* x, const int* pos, unsigned char* ws, int row, int lane) {
    const f32x4* xr = (const f32x4*)(x + (size_t)row * DM) + lane;
    f32x4 v[4]; float s = 0.f;
#pragma unroll
    for (int j = 0; j < 4; ++j) { v[j] = xr[64 * j]; s += (v[j][0] * v[j][0] + v[j][1] * v[j][1]) + (v[j][2] * v[j][2] + v[j][3] * v[j][3]); }
    s = wave_sum(s);
    u32x2* oh = (u32x2*)((bf16_t*)(ws + WS_XH) + (size_t)row * DM) + lane;
    u32x2* ol = (u32x2*)((bf16_t*)(ws + WS_XL) + (size_t)row * DM) + lane;
#pragma unroll
    for (int j = 0; j < 4; ++j) {
        u32x2 h; h.x = pk2(v[j][0], v[j][1]); h.y = pk2(v[j][2], v[j][3]);
        f32x4 l; l[0] = v[j][0] - __builtin_bit_cast(float, h.x << 16); l[1] = v[j][1] - __builtin_bit_cast(float, h.x & 0xffff0000u);
        l[2] = v[j][2] - __builtin_bit_cast(float, h.y << 16); l[3] = v[j][3] - __builtin_bit_cast(float, h.y & 0xffff0000u);
        u32x2 lo; lo.x = pk2(l[0], l[1]); lo.y = pk2(l[2], l[3]);
        oh[64 * j] = h; ol[64 * j] = lo;
    }
    if (lane == 0) ((float*)(ws + WS_RSTD))[row] = 1.0f / sqrtf(s * (1.0f / DM) + NORM_EPS);
    if (lane < 8) {
        const float inv = (float)pow(500000.0, -(double)lane / 8.0);
        const float ang = (float)pos[row] * inv;
        float* rope = (float*)(ws + WS_ROPE);
        rope[row * 16 + lane] = (float)cos((double)ang);
        rope[row * 16 + 8 + lane] = (float)sin((double)ang);
    }
}
struct ProbOut {
    const bf16_t *A, *Bt;
    __device__ __forceinline__ int nt(const pg8::Unit&) const { return 16; }
    __device__ __forceinline__ const char* a(const pg8::Unit& u, int t) const { return (const char*)(A + (size_t)u.pm * 256 * pg8::KP) + (size_t)(t & 15) * 128; }
    __device__ __forceinline__ const char* b(const pg8::Unit& u, int t) const { return (const char*)(Bt + (size_t)u.pn * 256 * pg8::KP) + (size_t)(t & 15) * 128; }
};
struct SchedOut {
    int G, c;
    __device__ __forceinline__ bool next(int i, pg8::Unit& u) const { const long L = (long)i * G + c; if (L >= 256) return false; u.pm = (int)(L >> 2); u.pn = (int)(L & 3); u.kind = 0; return true; }
};
struct EpiY {
    static constexpr bool PERM = false, AFTER_DRAIN = false;
    float* Y;
    __device__ __forceinline__ void operator()(const f32x4 (&acc)[2][2][4][2], const pg8::Unit& u, int wr, int wc, int fr, int fq) const {
        const int row0 = u.pm * 256 + wr * 64 + fr, col0 = u.pn * 256 + wc * 32 + 4 * fq;
#pragma unroll
        for (int ai = 0; ai < 2; ++ai)
#pragma unroll
            for (int m = 0; m < 4; ++m) { float* rowp = Y + (size_t)(row0 + ai * 128 + m * 16) * DM + col0;
#pragma unroll
                for (int bj = 0; bj < 2; ++bj)
#pragma unroll
                    for (int n = 0; n < 2; ++n) *(f32x4*)(rowp + bj * 128 + n * 16) = acc[ai][bj][m][n]; }
    }
};
__device__ __forceinline__ void p6_row(const float* x, const float* Y, const float* pw, float* out, int row, int lane) {
    const f32x4* yr = (const f32x4*)(Y + (size_t)row * DM) + lane;
    f32x4 v[4]; float s = 0.f;
#pragma unroll
    for (int j = 0; j < 4; ++j) { v[j] = yr[64 * j]; s += (v[j][0] * v[j][0] + v[j][1] * v[j][1]) + (v[j][2] * v[j][2] + v[j][3] * v[j][3]); }
    s = wave_sum(s);
    const float r = 1.0f / sqrtf(s * (1.0f / DM) + NORM_EPS);
#pragma unroll
    for (int j = 0; j < 4; ++j) {
        const f32x4 xv = ((const f32x4*)(x + (size_t)row * DM) + lane)[64 * j], w = ((const f32x4*)pw + lane)[64 * j];
        ((f32x4*)(out + (size_t)row * DM) + lane)[64 * j] = xv + v[j] * r * w;
    }
}
#include <hip/hip_bf16.h>
#include <cmath>
namespace attn_body {
using bf16=__hip_bfloat16;
using bf16x8=__attribute__((ext_vector_type(8)))short;
using s16x4=__attribute__((ext_vector_type(4)))short;
using f32x16=__attribute__((ext_vector_type(16)))float;
using u32x4=__attribute__((ext_vector_type(4)))unsigned;
constexpr int BATCH=4,NHEAD=8,SEQ=4096,D=64,DM=NHEAD*D,OPITCH=1024;
constexpr int NW=8,QBLK=32,QB=QBLK*NW,KVBLK=64,NQB=SEQ/QB;
constexpr int ATTN_PITCH=DM, ATTN_UNIT_ROWS=QB;
__device__ __forceinline__ int crow(int r,int hi){return (r&3)+8*(r>>2)+4*hi;}
#define SBAR() __builtin_amdgcn_sched_barrier(0)
__device__ __forceinline__ void cmask(f32x16&p0,f32x16&p1,int jb,int qrel,int hi){
  const float NEG=-INFINITY; int kb=64*jb+4*hi;
  #pragma unroll
  for(int r=0;r<16;++r){int kv=kb+(r&3)+8*(r>>2); if(kv>qrel)p0[r]=NEG; if(kv+32>qrel)p1[r]=NEG;}
}

constexpr int NSLOT=3, SLOTB=8192;
constexpr int LDS_K=0, LDS_V=NSLOT*SLOTB, LDS_WS=2*NSLOT*SLOTB, LDS_OST=LDS_WS+NW*64*4, LDS_MSK=LDS_OST+NW*4096, LDS_BYTES=LDS_MSK+NW*512;
constexpr float C2=0.125f*1.4426950408889634f;
__device__ __forceinline__ void glds16(const void*gsrc,unsigned lds_dst){unsigned keep;
  asm volatile("s_mov_b32 %0, m0\n\ts_mov_b32 m0, %2\n\ts_nop 0\n\tglobal_load_lds_dwordx4 %1, off\n\ts_mov_b32 m0, %0":"=&s"(keep):"v"(gsrc),"s"(lds_dst):"memory");}
__device__ __forceinline__ void glds4(const void*gsrc,unsigned lds_dst){unsigned keep;
  asm volatile("s_mov_b32 %0, m0\n\ts_mov_b32 m0, %2\n\ts_nop 0\n\tglobal_load_lds_dword %1, off\n\ts_mov_b32 m0, %0":"=&s"(keep):"v"(gsrc),"s"(lds_dst):"memory");}
__device__ __forceinline__ float max3f(float a,float b,float c){float r;asm("v_max3_f32 %0, %1, %2, %3":"=v"(r):"v"(a),"v"(b),"v"(c));return r;}
__device__ __forceinline__ float max2f(float a,float b){float r;asm("v_max_f32_e32 %0, %1, %2":"=v"(r):"v"(a),"v"(b));return r;}
__device__ __forceinline__ float fadd_s(float a,float b){float r;asm("v_add_f32_e32 %0, %1, %2":"=v"(r):"v"(a),"v"(b));return r;}
__device__ __forceinline__ float fsub_s(float a,float b){float r;asm("v_sub_f32_e32 %0, %1, %2":"=v"(r):"v"(a),"v"(b));return r;}
typedef float f32x2_t __attribute__((ext_vector_type(2))); typedef __bf16 bf16x2_t __attribute__((ext_vector_type(2)));
__device__ __forceinline__ unsigned cvtpk_s(float lo,float hi){f32x2_t v={lo,hi};bf16x2_t b=__builtin_convertvector(v,bf16x2_t);return __builtin_bit_cast(unsigned,b);}
#define WAIT_BAR(N) asm volatile("s_waitcnt vmcnt(" #N ") lgkmcnt(0)\n\ts_barrier":::"memory")

__device__ __forceinline__ void qkt(f32x16&p0,f32x16&p1,const char*Kslot,const bf16x8*qr,const f32x16&negm,int r32,int hi){
  const char*kb=Kslot+hi*1024+r32*16;
  #pragma unroll
  for(int d0=0;d0<4;++d0){
    const bf16x8 b0=*reinterpret_cast<const bf16x8*>(kb+d0*2048);
    const bf16x8 b1=*reinterpret_cast<const bf16x8*>(kb+d0*2048+512);
    if(d0==0){p0=__builtin_amdgcn_mfma_f32_32x32x16_bf16(b0,qr[0],negm,0,0,0);p1=__builtin_amdgcn_mfma_f32_32x32x16_bf16(b1,qr[0],negm,0,0,0);}
    else{p0=__builtin_amdgcn_mfma_f32_32x32x16_bf16(b0,qr[d0],p0,0,0,0);p1=__builtin_amdgcn_mfma_f32_32x32x16_bf16(b1,qr[d0],p1,0,0,0);}}
}
typedef __attribute__((address_space(3))) const char* lds_cptr;
typedef short v4i16_t __attribute__((ext_vector_type(4)));
__device__ __forceinline__ void kload8(bf16x8*kf,lds_cptr kp){
  kf[0]=*(const __attribute__((address_space(3))) bf16x8*)(kp);      kf[1]=*(const __attribute__((address_space(3))) bf16x8*)(kp+512);
  kf[2]=*(const __attribute__((address_space(3))) bf16x8*)(kp+2048); kf[3]=*(const __attribute__((address_space(3))) bf16x8*)(kp+2560);
  kf[4]=*(const __attribute__((address_space(3))) bf16x8*)(kp+4096); kf[5]=*(const __attribute__((address_space(3))) bf16x8*)(kp+4608);
  kf[6]=*(const __attribute__((address_space(3))) bf16x8*)(kp+6144); kf[7]=*(const __attribute__((address_space(3))) bf16x8*)(kp+6656);
}
__device__ __forceinline__ void kload2(bf16x8*kf,lds_cptr kp,int j){ kf[2*j]=*(const __attribute__((address_space(3))) bf16x8*)(kp+j*2048); kf[2*j+1]=*(const __attribute__((address_space(3))) bf16x8*)(kp+j*2048+512); }
__device__ __forceinline__ s16x4 vtr(lds_cptr p){ return __builtin_bit_cast(s16x4,__builtin_amdgcn_ds_read_tr16_b64_v4i16((__attribute__((address_space(3))) v4i16_t*)p)); }
__device__ __forceinline__ float rowmax(const f32x16&p0,const f32x16&p1){
  float a=max3f(p0[0],p0[1],p1[0]),b=max3f(p0[2],p0[3],p1[1]);a=max3f(a,p1[2],p1[3]);
  #pragma unroll
  for(int r=4;r<16;r+=4){a=max3f(a,p0[r],p0[r+1]);b=max3f(b,p0[r+2],p0[r+3]);a=max3f(a,p1[r],p1[r+1]);b=max3f(b,p1[r+2],p1[r+3]);}
  const float m=max2f(a,b);
  auto rr=__builtin_amdgcn_permlane32_swap(__float_as_uint(m),__float_as_uint(m),false,false);
  return max2f(__uint_as_float(rr[0]),__uint_as_float(rr[1]));
}
__device__ __forceinline__ void pv(f32x16*o,int vb,bf16x8 pa0,bf16x8 pa1,bf16x8 pa2,bf16x8 pa3){
  #pragma unroll
  for(int d0=0;d0<2;++d0){s16x4 lo[4],hi[4];
    #pragma unroll
    for(int ks=0;ks<4;++ks){
      asm volatile("ds_read_b64_tr_b16 %0,%1 offset:%c2":"=&v"(lo[ks]):"v"(vb),"i"(d0*4096+ks*1024):"memory");
      asm volatile("ds_read_b64_tr_b16 %0,%1 offset:%c2":"=&v"(hi[ks]):"v"(vb),"i"(d0*4096+ks*1024+512):"memory");}
    asm volatile("s_waitcnt lgkmcnt(0)":::"memory");SBAR();
    #define PK(k) (bf16x8){lo[k][0],lo[k][1],lo[k][2],lo[k][3],hi[k][0],hi[k][1],hi[k][2],hi[k][3]}
    o[d0]=__builtin_amdgcn_mfma_f32_32x32x16_bf16(pa0,PK(0),o[d0],0,0,0);
    o[d0]=__builtin_amdgcn_mfma_f32_32x32x16_bf16(pa1,PK(1),o[d0],0,0,0);
    o[d0]=__builtin_amdgcn_mfma_f32_32x32x16_bf16(pa2,PK(2),o[d0],0,0,0);
    o[d0]=__builtin_amdgcn_mfma_f32_32x32x16_bf16(pa3,PK(3),o[d0],0,0,0);
    #undef PK
  }
}

#ifndef ATTN_STORE16
#define ATTN_STORE16(p,v) (*(u32x4*)(p)=(v))
#endif
template<int THRL> __device__ __forceinline__ void attn_unit(int b,int h,int qb,const bf16*Q,const bf16*__restrict__ K,const bf16*__restrict__ V,const unsigned*__restrict__ MASK32,bf16*O,char*shm){
  const int tid=threadIdx.x,lane=tid&63,r32=lane&31,hi=lane>>5; const int wid=__builtin_amdgcn_readfirstlane(tid>>6);
  const long rowbase=(long)b*SEQ; const int q0=qb*QB;
  const bf16*Qw=Q+(rowbase+q0+wid*QBLK)*DM+h*D;
  const bf16*Kh=K+rowbase*DM+h*D,*Vh=V+rowbase*DM+h*D;
  const unsigned lds0=(unsigned)(uintptr_t)shm;
  float*wsf=(float*)(shm+LDS_WS)+wid*64;
  const bf16*ksrc=Kh+(long)lane*DM+wid*8;
  const bf16*vsrc=Vh+(long)(16*(wid&3)+(lane>>2))*DM+(wid>>2)*32+(lane&3)*8;
  const unsigned kdst=lds0+LDS_K+wid*1024, vdst=lds0+LDS_V+wid*1024;
  #define DMA_K(t,slot) glds16(ksrc+(long)(t)*KVBLK*DM,(unsigned)__builtin_amdgcn_readfirstlane(kdst+(slot)))
  #define DMA_V(t,slot) glds16(vsrc+(long)(t)*KVBLK*DM,(unsigned)__builtin_amdgcn_readfirstlane(vdst+(slot)))
  const unsigned*msrc=MASK32+(size_t)(rowbase+q0+wid*QBLK+(lane>>1))*128+(lane&1);
  const unsigned mdst=lds0+LDS_MSK+wid*512;
  #define DMA_M(t) glds4(msrc+2*(t),(unsigned)__builtin_amdgcn_readfirstlane(mdst+(((t)&1)<<8)))
  typedef __attribute__((address_space(3))) const unsigned long long* lds_u64p;
  #define MSK(v,W,b) __uint_as_float(__float_as_uint(v)&(unsigned)__builtin_amdgcn_sbfe((int)(W),(b),1))
  #define BP(B) (((B)&3)+8*((B)>>2))
  const int vb0=(int)(lds0+LDS_V)+((lane>>4)&1)*32+(lane&3)*8+(4*hi+((lane&15)>>2))*64;
  const char*Kbase=shm+LDS_K; bf16x8 kf[8];
  const lds_cptr shm3=(lds_cptr)shm; const lds_cptr kp0=shm3+LDS_K+hi*1024+r32*16; const lds_cptr vp0=shm3+LDS_V+((lane>>4)&1)*32+(lane&3)*8+(4*hi+((lane&15)>>2))*64;
  const lds_cptr mp0=shm3+LDS_MSK+wid*512+r32*8;
  const int NT=(q0+QB)/KVBLK;
  DMA_M(0);DMA_M(1);DMA_K(0,0);DMA_V(0,0);DMA_K(1,SLOTB);
  bf16x8 qr[4];
  #pragma unroll
  for(int d0=0;d0<4;++d0)qr[d0]=*reinterpret_cast<const bf16x8*>(&Qw[(long)r32*DM+d0*16+hi*8]);
  float mhat=0.f,l_reg=0.f;f32x16 o[2];o[0]=f32x16{};o[1]=f32x16{};f32x16 negm=f32x16{};asm volatile("":"+v"(negm));
  const int qrel=wid*QBLK+r32;
  #define CMASK(P0,P1,t) do{}while(0)
  bool resc=false;
  #define START(P0,P1) do{ const float rm=rowmax(P0,P1); resc=false; \
    { const float dl=rm; mhat=fadd_s(mhat,dl); \
      _Pragma("unroll") for(int r=0;r<16;++r){P0[r]=fsub_s(P0[r],dl);P1[r]=fsub_s(P1[r],dl);} \
      _Pragma("unroll") for(int r=0;r<16;++r)negm[r]=-mhat; asm volatile("":"+v"(negm)); } \
    _Pragma("unroll") for(int r=0;r<16;++r)P0[r]=__builtin_amdgcn_exp2f(P0[r]); }while(0)
  #define RESC() do{ if(resc){ asm volatile("s_waitcnt lgkmcnt(0)":::"memory"); \
      _Pragma("unroll") for(int d_=0;d_<2;++d_) _Pragma("unroll") for(int r=0;r<16;++r)o[d_][r]*=wsf[crow(r,hi)]; } }while(0)
  f32x16 pA0,pA1,pB0,pB1;
  int sl_prev=0,sl_cur=0,sl_next=SLOTB;
  #define ROT() do{sl_prev=sl_cur;sl_cur=sl_next;sl_next=(sl_next==(NSLOT-1)*SLOTB)?0:sl_next+SLOTB;}while(0)
  DMA_K(2,2*SLOTB);
  WAIT_BAR(3);
  qkt(pA0,pA1,Kbase,qr,negm,r32,hi);asm volatile("s_nop 15\n\ts_nop 7":"+v"(pA0),"+v"(pA1));
  START(pA0,pA1);
  _Pragma("unroll") for(int r=0;r<16;++r)pA1[r]=__builtin_amdgcn_exp2f(pA1[r]);
  { const unsigned long long mw_=*(lds_u64p)(mp0); const unsigned mwl_=(unsigned)mw_>>(4*hi), mwh_=(unsigned)(mw_>>32)>>(4*hi);
    _Pragma("unroll") for(int r=0;r<16;++r){pA0[r]=MSK(pA0[r],mwl_,BP(r));pA1[r]=MSK(pA1[r],mwh_,BP(r));} }
  WAIT_BAR(0);
  DMA_K(3,0);DMA_V(1,SLOTB);
  ROT();
  kload8(kf,kp0+sl_cur);
  WAIT_BAR(2);
  s16x4 vlo[8],vhi[8]; u32x4 pw0,pw1,pw2,pw3;
  #define PKW(P,B) cvtpk_s(P[B],P[B+1])
  #define PAF(k) __builtin_bit_cast(bf16x8,pw##k)
  #define VFR(i) (bf16x8){vlo[i][0],vlo[i][1],vlo[i][2],vlo[i][3],vhi[i][0],vhi[i][1],vhi[i][2],vhi[i][3]}
  #define PIN(x) asm volatile("":"+v"(x))
  #define MX3(a,b,c) __builtin_fmaxf(__builtin_fmaxf((a),(b)),(c))
  #define GAPA(MF,A0,A1,A2,A3,W0,W1,PW) do{ MF; sacc+=A0; sacc+=A1; sacc+=A2; sacc+=A3; PIN(sacc); W0; W1; PIN(PW); SBAR(); }while(0)
  #define EX(v) __builtin_amdgcn_exp2f(v)
  #define GAPB(MF,X,W,B) do{ MF; X[B]=MSK(EX(X[B]),W,BP(B)); X[B+1]=MSK(EX(X[B+1]),W,BP(B+1)); X[B+2]=MSK(EX(X[B+2]),W,BP(B+2)); X[B+3]=MSK(EX(X[B+3]),W,BP(B+3)); PIN(X); SBAR(); }while(0)
  #define VRD(i) do{ vlo[i]=vtr(vp_+(((i)>>2)*4096+((i)&3)*1024)); vhi[i]=vtr(vp_+(((i)>>2)*4096+((i)&3)*1024+512)); }while(0)
  #define KRD(G,j) do{ if(G){ kload2(kf,kp0+sl_next,j); SBAR(); } }while(0)
  #define STEP(C0,C1,P0,P1,t,GK,GV,GL) do{ SBAR(); \
    if(GV){DMA_M((t)+1);} \
    const unsigned long long mw_=*(lds_u64p)(mp0+(((t)&1)<<8)); const unsigned mwl_=(unsigned)mw_>>(4*hi), mwh_=(unsigned)(mw_>>32)>>(4*hi); \
    const lds_cptr vp_=vp0+sl_prev; \
    VRD(0); SBAR(); float sacc=(P0[0]+P0[1]); \
    GAPA(C0=__builtin_amdgcn_mfma_f32_32x32x16_bf16(kf[0],qr[0],negm,0,0,0), P0[2],P0[3],P0[4],P0[5],     pw0[0]=PKW(P0,0), pw0[1]=PKW(P0,2), pw0); \
    VRD(4); SBAR(); GAPA(C1=__builtin_amdgcn_mfma_f32_32x32x16_bf16(kf[1],qr[0],negm,0,0,0), P0[6],P0[7],P0[8],P0[9],     pw0[2]=PKW(P0,4), pw0[3]=PKW(P0,6), pw0); \
    VRD(1); SBAR(); GAPA(C0=__builtin_amdgcn_mfma_f32_32x32x16_bf16(kf[2],qr[1],C0,0,0,0),   P0[10],P0[11],P0[12],P0[13], pw1[0]=PKW(P0,8), pw1[1]=PKW(P0,10), pw1); \
    VRD(5); SBAR(); GAPA(C1=__builtin_amdgcn_mfma_f32_32x32x16_bf16(kf[3],qr[1],C1,0,0,0),   P0[14],P0[15],P1[0],P1[1],   pw1[2]=PKW(P0,12),pw1[3]=PKW(P0,14), pw1); \
    VRD(2); SBAR(); GAPA(C0=__builtin_amdgcn_mfma_f32_32x32x16_bf16(kf[4],qr[2],C0,0,0,0),   P1[2],P1[3],P1[4],P1[5],     pw2[0]=PKW(P1,0), pw2[1]=PKW(P1,2), pw2); \
    VRD(6); SBAR(); GAPA(C1=__builtin_amdgcn_mfma_f32_32x32x16_bf16(kf[5],qr[2],C1,0,0,0),   P1[6],P1[7],P1[8],P1[9],     pw2[2]=PKW(P1,4), pw2[3]=PKW(P1,6), pw2); \
    VRD(3); SBAR(); GAPA(C0=__builtin_amdgcn_mfma_f32_32x32x16_bf16(kf[6],qr[3],C0,0,0,0),   P1[10],P1[11],P1[12],P1[13], pw3[0]=PKW(P1,8), pw3[1]=PKW(P1,10), pw3); \
    VRD(7); SBAR(); GAPA(C1=__builtin_amdgcn_mfma_f32_32x32x16_bf16(kf[7],qr[3],C1,0,0,0),   P1[14],P1[15],0.f,0.f,       pw3[2]=PKW(P1,12),pw3[3]=PKW(P1,14), pw3); \
    l_reg+=sacc; \
    if(GK){DMA_K((t)+3,sl_cur);} if(GV){DMA_V((t)+1,sl_next);} \
    CMASK(C0,C1,t); \
    { float a=MX3(C0[0],C0[1],C1[0]),b=MX3(C0[2],C0[3],C1[1]); a=MX3(a,C1[2],C1[3]); \
      _Pragma("unroll") for(int r=4;r<16;r+=4){a=MX3(a,C0[r],C0[r+1]);b=MX3(b,C0[r+2],C0[r+3]);a=MX3(a,C1[r],C1[r+1]);b=MX3(b,C1[r+2],C1[r+3]);} \
      float rm=__builtin_fmaxf(a,b); { auto rr=__builtin_amdgcn_permlane32_swap(__float_as_uint(rm),__float_as_uint(rm),false,false); rm=__builtin_fmaxf(__uint_as_float(rr[0]),__uint_as_float(rr[1])); } \
      resc=false; \
      if(__builtin_expect(__any(rm>(float)THRL),0)){ const float dl=__builtin_fmaxf(rm,0.f); mhat+=dl; \
        _Pragma("unroll") for(int r=0;r<16;++r){C0[r]-=dl;C1[r]-=dl;} \
        _Pragma("unroll") for(int r=0;r<16;++r)negm[r]=-mhat; asm volatile("":"+v"(negm)); \
        const float f=__builtin_amdgcn_exp2f(-dl); l_reg*=f; if(hi==0)wsf[r32]=f; resc=true; } } \
    SBAR(); \
    GAPB(o[0]=__builtin_amdgcn_mfma_f32_32x32x16_bf16(PAF(0),VFR(0),o[0],0,0,0), C0,mwl_,0); \
    GAPB(o[1]=__builtin_amdgcn_mfma_f32_32x32x16_bf16(PAF(0),VFR(4),o[1],0,0,0), C0,mwl_,4); \
    KRD(GL,0); GAPB(o[0]=__builtin_amdgcn_mfma_f32_32x32x16_bf16(PAF(1),VFR(1),o[0],0,0,0), C0,mwl_,8); \
    KRD(GL,1); GAPB(o[1]=__builtin_amdgcn_mfma_f32_32x32x16_bf16(PAF(1),VFR(5),o[1],0,0,0), C0,mwl_,12); \
    KRD(GL,2); GAPB(o[0]=__builtin_amdgcn_mfma_f32_32x32x16_bf16(PAF(2),VFR(2),o[0],0,0,0), C1,mwh_,0); \
    KRD(GL,3); GAPB(o[1]=__builtin_amdgcn_mfma_f32_32x32x16_bf16(PAF(2),VFR(6),o[1],0,0,0), C1,mwh_,4); \
    GAPB(o[0]=__builtin_amdgcn_mfma_f32_32x32x16_bf16(PAF(3),VFR(3),o[0],0,0,0), C1,mwh_,8); \
    GAPB(o[1]=__builtin_amdgcn_mfma_f32_32x32x16_bf16(PAF(3),VFR(7),o[1],0,0,0), C1,mwh_,12); \
    }while(0)
  int t=1;
  #undef CMASK
  #define CMASK(P0,P1,t) do{}while(0)
  for(;t+5<NT;t+=2){
    STEP(pB0,pB1,pA0,pA1,t,true,true,true);     WAIT_BAR(2); RESC(); ROT();
    STEP(pA0,pA1,pB0,pB1,t+1,true,true,true);   WAIT_BAR(2); RESC(); ROT();
  }
  #undef CMASK
  #define CMASK(P0,P1,t) do{}while(0)
  #define ENDW(tt) do{ if((tt)+3<NT){WAIT_BAR(2);} else if((tt)+2<NT){WAIT_BAR(1);} else {WAIT_BAR(0);} }while(0)
  for(;t+1<NT;t+=2){
    STEP(pB0,pB1,pA0,pA1,t,(t+3<NT),(t+1<NT),(t+1<NT));       ENDW(t);   RESC(); ROT();
    STEP(pA0,pA1,pB0,pB1,t+1,(t+4<NT),(t+2<NT),(t+2<NT));     ENDW(t+1); RESC(); ROT();
  }
  STEP(pB0,pB1,pA0,pA1,NT-1,false,false,false); RESC();
  { float sacc=pB0[0]+pB0[1]; _Pragma("unroll") for(int r=2;r<16;++r)sacc+=pB0[r]; _Pragma("unroll") for(int r=0;r<16;++r)sacc+=pB1[r]; l_reg+=sacc;
    pw0=(u32x4){PKW(pB0,0),PKW(pB0,2),PKW(pB0,4),PKW(pB0,6)};pw1=(u32x4){PKW(pB0,8),PKW(pB0,10),PKW(pB0,12),PKW(pB0,14)};pw2=(u32x4){PKW(pB1,0),PKW(pB1,2),PKW(pB1,4),PKW(pB1,6)};pw3=(u32x4){PKW(pB1,8),PKW(pB1,10),PKW(pB1,12),PKW(pB1,14)};
    SBAR(); pv(o,vb0+sl_cur,PAF(0),PAF(1),PAF(2),PAF(3)); }
  #undef PKW
  #undef PAF
  #undef VFR
  #undef PIN
  #undef MX3
  #undef GAPA
  #undef GAPB
  #undef EX
  #undef VRD
  #undef KRD
  #undef STEP
  #undef ENDW
  {auto rr=__builtin_amdgcn_permlane32_swap(__float_as_uint(l_reg),__float_as_uint(l_reg),false,false);l_reg=__uint_as_float(rr[0])+__uint_as_float(rr[1]);}
  if(hi==0)wsf[32+r32]=l_reg;asm volatile("s_waitcnt lgkmcnt(0)":::"memory");
  float rli[16];
  #pragma unroll
  for(int r=0;r<16;++r)rli[r]=__builtin_amdgcn_rcpf(wsf[32+crow(r,hi)]);
  bf16*Ow=O+(rowbase+q0+wid*QBLK)*OPITCH+h*D;
  { bf16*stg=(bf16*)(shm+LDS_OST)+wid*2048;
    #pragma unroll
    for(int r=0;r<16;++r){const int orow=crow(r,hi);
      #pragma unroll
      for(int d0=0;d0<2;++d0)stg[orow*64+d0*32+r32]=__float2bfloat16(o[d0][r]*rli[r]);}
    asm volatile("s_waitcnt lgkmcnt(0)":::"memory");
    #pragma unroll
    for(int i=0;i<4;++i){const int row=i*8+(lane>>3),ch=lane&7; const u32x4 v=*(const u32x4*)(stg+row*64+ch*8); bf16*dst=Ow+(long)row*OPITCH+ch*8; const u32x4 g=*(const u32x4*)dst; u32x4 w;
      _Pragma("unroll") for(int e=0;e<4;++e){ const float a0=__uint_as_float(v[e]<<16),a1=__uint_as_float(v[e]&0xffff0000u),g0=__uint_as_float(g[e]<<16),g1=__uint_as_float(g[e]&0xffff0000u); w[e]=cvtpk_s(a0*g0,a1*g1); }
      *(u32x4*)dst=w;} }
  asm volatile("s_waitcnt lgkmcnt(0)\n\ts_barrier":::"memory");
  #undef DMA_K
  #undef DMA_V
  #undef DMA_M
  #undef MSK
  #undef BP
  #undef CMASK
  #undef START
  #undef RESC
  #undef ROT
}
constexpr int ATTN_LDS_BYTES=LDS_BYTES;
struct AttnTensors { const bf16* Q; const bf16* K; const bf16* V; const unsigned* MASK32; bf16* O; };
struct AttnUnit { int bh; int qb; };
struct StaticOrder {
  int vcu,G;
  __device__ __forceinline__ StaticOrder(int grid,int v):vcu(v),G(grid){}
  __device__ __forceinline__ bool next(int i,AttnUnit&u)const{
    if(G==256){ if(i>=2)return false; const int s=vcu&7; u.bh=vcu>>3; u.qb=(i==0)?15-s:s; return true; }
    const long L=(long)i*G+vcu; if(L>=BATCH*NHEAD*NQB)return false; u.qb=NQB-1-(int)(L/(BATCH*NHEAD)); u.bh=(int)(L%(BATCH*NHEAD)); return true; }
  __device__ __forceinline__ void a_ready(const AttnUnit&)const{}
  __device__ __forceinline__ void done(const AttnUnit&)const{}
};
template<class Sched,int THRL=8> __device__ __forceinline__ void attn_phase(char*lds,const AttnTensors&T,const Sched&S){
  AttnUnit u;
  for(int i=0;S.next(i,u);++i){ S.a_ready(u); attn_unit<THRL>(u.bh/NHEAD,u.bh%NHEAD,u.qb,T.Q,T.K,T.V,T.MASK32,T.O,lds); S.done(u); }
}
#undef SBAR
#undef WAIT_BAR
}
namespace sel {
typedef short bf16x8 __attribute__((ext_vector_type(8)));
typedef float f32x16 __attribute__((ext_vector_type(16)));
constexpr int QF_OFF = 0;
constexpr int HIST_OFF = 32768;
constexpr int NUNITS = BATCH * (SEQ / 32);
__device__ __forceinline__ unsigned mono(float f) { const unsigned u = __builtin_bit_cast(unsigned, f); return (u & 0x80000000u) ? ~u : (u | 0x80000000u); }
__device__ __forceinline__ void unit_of(int u, int& b, int& j) { j = (SEQ / 32 - 1) - (u >> 2); b = u & 3; }
__device__ __forceinline__ size_t scratch_bytes(int v) { return (size_t)4096 * (size_t)((SEQ / 32) - (v >> 2)); }

__device__ __forceinline__ void unit(int b, int j, unsigned char* ws, float* sc, LAS unsigned char* lds) {
    const int tid = threadIdx.x, lane = tid & 63, wid = __builtin_amdgcn_readfirstlane(tid >> 6), r32 = lane & 31, hi = lane >> 5;
    const int q0 = j * 32, row0 = b * SEQ + q0, nkt = j + 1;
    const bf16_t* IQH = (const bf16_t*)(ws + WS_IQH); const bf16_t* IQL = (const bf16_t*)(ws + WS_IQL);
    const bf16_t* IKH = (const bf16_t*)(ws + WS_IKH); const bf16_t* IKL = (const bf16_t*)(ws + WS_IKL);
#pragma unroll
    for (int i = 0; i < 2; ++i) {
        const int f = tid + 512 * i, h = f >> 8, s = (f >> 6) & 3, l = f & 63, r = l & 31, half = l >> 5;
        const size_t src = (size_t)(row0 + r) * 256 + h * 64 + 16 * s + 8 * half;
        const u32x4 vh = *(const u32x4*)(IQH + src), vl = *(const u32x4*)(IQL + src);
        *(LAS u32x4*)(lds + QF_OFF + ((h * 4 + s) * 2 + 0) * 1024 + l * 16) = vh;
        *(LAS u32x4*)(lds + QF_OFF + ((h * 4 + s) * 2 + 1) * 1024 + l * 16) = vl;
    }
    const f32x4 w = *(const f32x4*)((const float*)(ws + WS_IW) + (size_t)(row0 + r32) * 4);
    __syncthreads();
#ifndef SEL_REP_SCORE
#define SEL_REP_SCORE 1
#endif
#ifndef SEL_REP_SELECT
#define SEL_REP_SELECT 1
#endif
    for (int rep_ = 0; rep_ < SEL_REP_SCORE; ++rep_)
    for (int kt = wid; kt < nkt; kt += 8) {
        const size_t krow = (size_t)(b * SEQ + kt * 32 + r32) * 64 + 8 * hi;
        bf16x8 kh[4], kl[4];
#pragma unroll
        for (int s = 0; s < 4; ++s) { kh[s] = *(const bf16x8*)(IKH + krow + 16 * s); kl[s] = *(const bf16x8*)(IKL + krow + 16 * s); }
        f32x16 score;
#pragma unroll
        for (int i = 0; i < 16; ++i) score[i] = 0.f;
        int qoff = lane * 16; asm volatile("" : "+v"(qoff));
#pragma unroll
        for (int h = 0; h < 4; ++h) {
            f32x16 acc;
#pragma unroll
            for (int i = 0; i < 16; ++i) acc[i] = 0.f;
#pragma unroll
            for (int s = 0; s < 4; ++s) {
                const bf16x8 qh = *(const LAS bf16x8*)(lds + QF_OFF + ((h * 4 + s) * 2 + 0) * 1024 + qoff);
                const bf16x8 ql = *(const LAS bf16x8*)(lds + QF_OFF + ((h * 4 + s) * 2 + 1) * 1024 + qoff);
                acc = __builtin_amdgcn_mfma_f32_32x32x16_bf16(kh[s], qh, acc, 0, 0, 0);
                acc = __builtin_amdgcn_mfma_f32_32x32x16_bf16(kh[s], ql, acc, 0, 0, 0);
                acc = __builtin_amdgcn_mfma_f32_32x32x16_bf16(kl[s], qh, acc, 0, 0, 0);
            }
            const float wh = w[h];
#pragma unroll
            for (int i = 0; i < 16; ++i) score[i] += wh * fmaxf(acc[i], 0.f);
        }
        float* dst = sc + ((size_t)(kt * 32 + r32) * 32 + 4 * hi);
#pragma unroll
        for (int g = 0; g < 4; ++g) *(f32x4*)(dst + 8 * g) = (f32x4){score[4 * g], score[4 * g + 1], score[4 * g + 2], score[4 * g + 3]};
    }
    asm volatile("s_waitcnt vmcnt(0)" ::: "memory");
    __syncthreads();
    LAS unsigned* hist = (LAS unsigned*)(lds + HIST_OFF + wid * 8192);
    float pre[64];
#define SEL_LOAD_ROW(QQ, NJ) do { const float* urow_ = sc + (size_t)(QQ) * 32 + hi * 1024 + r32; \
        _Pragma("unroll") for (int g_ = 0; g_ < 8; ++g_) { if (g_ * 8 < (NJ)) { _Pragma("unroll") for (int i_ = 0; i_ < 8; ++i_) pre[g_ * 8 + i_] = __builtin_nontemporal_load(urow_ + (size_t)(g_ * 8 + i_) * 2048); } } } while (0)
    for (int rep_ = 0; rep_ < SEL_REP_SELECT; ++rep_) {
    SEL_LOAD_ROW(wid * 4, ((q0 + wid * 4 + 1) + 63) >> 6);
#pragma unroll 1
    for (int qi = 0; qi < 4; ++qi) {
        const int qq = wid * 4 + qi, t = q0 + qq, n = t + 1, nj = (n + 63) >> 6;
        unsigned key[64];
#pragma unroll
        for (int g = 0; g < 8; ++g) {
            if (g * 8 < nj) {
#pragma unroll
                for (int i = 0; i < 8; ++i) { const int jj = g * 8 + i; key[jj] = (lane < n - 64 * jj) ? mono(pre[jj]) : 0u; }
            } else {
#pragma unroll
                for (int i = 0; i < 8; ++i) key[g * 8 + i] = 0u;
            }
        }
        if (qi < 3) SEL_LOAD_ROW(qq + 1, (n + 1 + 63) >> 6);
        unsigned thr = 1u; bool ties = false; int need = 0;
        if (n > TOPK) {
            unsigned prefix = 0u, kneed = TOPK, cfin = 0u;
#pragma unroll 1
            for (int p = 0; p < 3; ++p) {
                const int NBL = (p == 2) ? 4 : 5, NB = 1 << NBL;
                const int shift = (p == 0) ? 21 : (p == 1) ? 10 : 0, pshift = (p == 0) ? 31 : (p == 1) ? 21 : 10;
                const unsigned dmask = (p == 2) ? 1023u : 2047u;
#pragma unroll
                for (int i = 0; i < 8; ++i) *(LAS u32x4*)(hist + (i * 64 + lane) * 4) = (u32x4){0u, 0u, 0u, 0u};
#pragma unroll
                for (int g = 0; g < 8; ++g) {
                    if (g * 8 < nj) {
#pragma unroll
                        for (int i = 0; i < 8; ++i) {
                            const unsigned k = key[g * 8 + i];
                            const bool part = (p == 0) ? (k != 0u) : ((k >> pshift) == prefix);
                            const unsigned dg = (k >> shift) & dmask;
                            if (part) __hip_atomic_fetch_add(hist + (((dg & (unsigned)(NB - 1)) << 6) | (dg >> NBL)), 1u, __ATOMIC_RELAXED, __HIP_MEMORY_SCOPE_WORKGROUP);
                        }
                    }
                }
                asm volatile("s_waitcnt lgkmcnt(0)" ::: "memory");
                unsigned tot = 0u;
#pragma unroll
                for (int i = 0; i < 32; ++i) { if (i < NB) tot += hist[i * 64 + lane]; }
                unsigned suf = tot;
#pragma unroll
                for (int o = 1; o < 64; o <<= 1) { const unsigned v = __shfl_down(suf, o); if (lane + o < 64) suf += v; }
                const unsigned above = suf - tot;
                const unsigned long long fm = __ballot(above < kneed && kneed <= above + tot);
                const int L = (int)__builtin_ctzll(fm | (1ull << 63));
                kneed -= (unsigned)__builtin_amdgcn_readlane((int)above, L);
                const unsigned cj = (lane < NB) ? hist[lane * 64 + L] : 0u;
                unsigned suf2 = cj;
#pragma unroll
                for (int o = 1; o < 32; o <<= 1) { const unsigned v = __shfl_down(suf2, o); if (lane + o < 64) suf2 += v; }
                const unsigned above2 = suf2 - cj;
                const unsigned long long fm2 = __ballot(above2 < kneed && kneed <= above2 + cj);
                const int J = (int)__builtin_ctzll(fm2 | (1ull << 63));
                kneed -= (unsigned)__builtin_amdgcn_readlane((int)above2, J);
                cfin = (unsigned)__builtin_amdgcn_readlane((int)cj, J);
                prefix = (prefix << (p == 2 ? 10 : 11)) | (unsigned)(NB * L + J);
                asm volatile("s_waitcnt lgkmcnt(0)" ::: "memory");
            }
            thr = prefix; need = (int)kneed; ties = (cfin != kneed);
        }
        int mylo = 0, myhi = 0;
        if (!ties) {
#pragma unroll
            for (int g = 0; g < 8; ++g) {
                if (g * 8 < nj) {
#pragma unroll
                    for (int i = 0; i < 8; ++i) {
                        const unsigned long long bits = __ballot(key[g * 8 + i] >= thr);
                        asm volatile("s_nop 1\n\tv_writelane_b32 %0, %2, %4\n\tv_writelane_b32 %1, %3, %4" : "+v"(mylo), "+v"(myhi) : "s"((unsigned)bits), "s"((unsigned)(bits >> 32)), "n"(g * 8 + i));
                    }
                }
            }
        } else {
            int eqcnt = 0;
            const unsigned long long lt = (1ull << lane) - 1ull;
#pragma unroll
            for (int g = 0; g < 8; ++g) {
                if (g * 8 < nj) {
#pragma unroll
                    for (int i = 0; i < 8; ++i) {
                        const unsigned k = key[g * 8 + i];
                        const bool eq = (k == thr);
                        const unsigned long long meq = __ballot(eq);
                        const int rank = eqcnt + (int)__popcll(meq & lt);
                        const unsigned long long bits = __ballot(k > thr || (eq && rank < need));
                        eqcnt += (int)__popcll(meq);
                        asm volatile("s_nop 1\n\tv_writelane_b32 %0, %2, %4\n\tv_writelane_b32 %1, %3, %4" : "+v"(mylo), "+v"(myhi) : "s"((unsigned)bits), "s"((unsigned)(bits >> 32)), "n"(g * 8 + i));
                    }
                }
            }
        }
        ((unsigned long long*)(ws + WS_MASK))[(size_t)(row0 + qq) * 64 + lane] = ((unsigned long long)(unsigned)myhi << 32) | (unsigned long long)(unsigned)mylo;
    }
    }
#undef SEL_LOAD_ROW
    __syncthreads();
}

__device__ __forceinline__ void phase(unsigned char* ws, unsigned char* scbase, LAS unsigned char* lds, int G, int v) {
    const int GE = G < 256 ? G : 256;
    if (v >= GE) return;
    size_t off = 0;
    for (int i = 0; i < v; ++i) off += scratch_bytes(i);
    float* sc = (float*)(scbase + off);
    for (int r = 0;; ++r) {
        const int u = (r & 1) ? ((r + 1) * GE - 1 - v) : (r * GE + v);
        if (u >= NUNITS) break;
        int b, j; unit_of(u, b, j);
        unit(b, j, ws, sc, lds);
    }
}
}
namespace gla {
typedef short bf16x8 __attribute__((ext_vector_type(8)));
typedef float f32x16 __attribute__((ext_vector_type(16)));
constexpr int NUNITS = BATCH * 4 * (SEQ / 64);
constexpr int LP = 72;
constexpr int L_GLR = 0, L_WUP = 4096, L_GT = 8192, L_RED = 10240, L_A = 12288, L_B = L_A + 64 * LP * 2, L_V = L_B + 64 * LP * 2, L_A2 = L_V + 128 * LP * 2, L_END = L_A2 + 64 * LP * 2;
__device__ __forceinline__ int crow(int r, int hi) { return (r & 3) + 8 * (r >> 2) + 4 * hi; }

__device__ __forceinline__ void cum_gates(const float* GLR, const float* wup, const float* bias, int tok0, int h, LAS unsigned char* lds, float (&bv)[8], float& blast) {
    const int tid = threadIdx.x, d = tid & 63, tg = tid >> 6;
    LAS float* sg = (LAS float*)(lds + L_GLR); LAS float* sw = (LAS float*)(lds + L_WUP); LAS float* gt = (LAS float*)(lds + L_GT);
#pragma unroll
    for (int i = 0; i < 2; ++i) { const int e = tid + 512 * i; sg[e] = GLR[(size_t)tok0 * 16 + e]; sw[e] = wup[(e >> 6) * 256 + h * 64 + (e & 63)]; }
    __syncthreads();
    float wu[16];
#pragma unroll
    for (int r = 0; r < 16; ++r) wu[r] = sw[r * 64 + d];
    const float bi = bias[h * 64 + d];
    float run = 0.f;
#pragma unroll
    for (int i = 0; i < 8; ++i) {
        const int t = tg * 8 + i;
        float z = bi;
#pragma unroll
        for (int r = 0; r < 16; ++r) z = fmaf(sg[t * 16 + r], wu[r], z);
        const float ls = fminf(z, 0.f) - log1pf(expf(-fabsf(z)));
        run += ls * (1.0f / 16.0f);
        bv[i] = run;
    }
    gt[tg * 64 + d] = run;
    __syncthreads();
    float pre = 0.f, tot = 0.f;
#pragma unroll
    for (int g = 0; g < 8; ++g) { const float v = gt[g * 64 + d]; tot += v; if (g < tg) pre += v; }
#pragma unroll
    for (int i = 0; i < 8; ++i) bv[i] += pre;
    blast = tot;
}
__device__ __forceinline__ void stage_vT(const bf16_t* GV, int tok0, int h, LAS unsigned char* lds) {
    const int tid = threadIdx.x, e = tid & 127, tq = tid >> 7;
    unsigned pk[8];
#pragma unroll
    for (int i = 0; i < 8; ++i) {
        const unsigned lo = GV[(size_t)(tok0 + tq * 16 + 2 * i) * 512 + h * 128 + e], hi = GV[(size_t)(tok0 + tq * 16 + 2 * i + 1) * 512 + h * 128 + e];
        pk[i] = lo | (hi << 16);
    }
    LAS u32x4* dst = (LAS u32x4*)(lds + L_V + (e * LP + tq * 16) * 2);
    dst[0] = (u32x4){pk[0], pk[1], pk[2], pk[3]}; dst[1] = (u32x4){pk[4], pk[5], pk[6], pk[7]};
}

__device__ __forceinline__ void g1_unit(int u, const MkPtrs& P, LAS unsigned char* lds) {
    const int tid = threadIdx.x, lane = tid & 63, wid = __builtin_amdgcn_readfirstlane(tid >> 6), r32 = lane & 31, hi = lane >> 5;
    const int bh = u >> 6, c = u & 63, b = bh >> 2, h = bh & 3, tok0 = b * SEQ + c * 64, d = tid & 63, tg = tid >> 6;
    float bv[8], blast;
    cum_gates(P.GLR, P.wup, P.bias, tok0, h, lds, bv, blast);
    {
        float kl[8];
#pragma unroll
        for (int i = 0; i < 8; ++i) kl[i] = bf2f(P.GK[(size_t)(tok0 + tg * 8 + i) * 256 + h * 64 + d]) * expf(blast - bv[i]);
        *(LAS u32x4*)(lds + L_A + (d * LP + tg * 8) * 2) = (u32x4){pk2(kl[0], kl[1]), pk2(kl[2], kl[3]), pk2(kl[4], kl[5]), pk2(kl[6], kl[7])};
    }
    stage_vT(P.GV, tok0, h, lds);
    if (tid < 64) P.DV[(size_t)u * 64 + tid] = expf(blast);
    __syncthreads();
    {
        const int wd = wid & 1, we = wid >> 1;
        f32x16 acc;
#pragma unroll
        for (int i = 0; i < 16; ++i) acc[i] = 0.f;
#pragma unroll
        for (int s = 0; s < 4; ++s) {
            const bf16x8 af = *(const LAS bf16x8*)(lds + L_A + ((wd * 32 + r32) * LP + 16 * s + 8 * hi) * 2);
            const bf16x8 bf = *(const LAS bf16x8*)(lds + L_V + ((we * 32 + r32) * LP + 16 * s + 8 * hi) * 2);
            acc = __builtin_amdgcn_mfma_f32_32x32x16_bf16(af, bf, acc, 0, 0, 0);
        }
        bf16_t* dst = P.UT + ((size_t)u * 128 + we * 32 + r32) * 64 + wd * 32 + 4 * hi;
#pragma unroll
        for (int g = 0; g < 4; ++g) *(u32x2*)(dst + 8 * g) = (u32x2){pk2(acc[4 * g], acc[4 * g + 1]), pk2(acc[4 * g + 2], acc[4 * g + 3])};
    }
    __syncthreads();
}
__device__ __forceinline__ void g2_item(int item, const MkPtrs& P, bf16_t* STout) {
    const int tid = threadIdx.x, bh = item >> 4, idx = (item & 15) * 512 + tid, d = idx & 63;
    bf16_t* p = P.UT + (size_t)bh * 64 * 8192 + idx; const float* dvp = P.DV + (size_t)bh * 64 * 64 + d;
    bf16_t* po = STout + (size_t)bh * 64 * 8192 + idx;
    float S = 0.f;
#pragma unroll 1
    for (int c0 = 0; c0 < 64; c0 += 16) {
        float uu[16], dd[16];
#pragma unroll
        for (int i = 0; i < 16; ++i) { uu[i] = bf2f(p[(size_t)(c0 + i) * 8192]); dd[i] = dvp[(c0 + i) * 64]; }
        asm volatile("" ::: "memory");
#pragma unroll
        for (int i = 0; i < 16; ++i) { po[(size_t)(c0 + i) * 8192] = f2bf(S); S = fmaf(dd[i], S, uu[i]); }
    }
}
__device__ __forceinline__ void g3_unit(int u, const MkPtrs& P, bf16_t* MIXo, LAS unsigned char* lds) {
    const int tid = threadIdx.x, lane = tid & 63, wid = __builtin_amdgcn_readfirstlane(tid >> 6), r32 = lane & 31, hi = lane >> 5;
    const int bh = u >> 6, c = u & 63, b = bh >> 2, h = bh & 3, tok0 = b * SEQ + c * 64, d = tid & 63, tg = tid >> 6;
    float bv[8], blast;
    cum_gates(P.GLR, P.wup, P.bias, tok0, h, lds, bv, blast);
    {
        LAS bf16_t* qa = (LAS bf16_t*)(lds + L_A); LAS bf16_t* kb = (LAS bf16_t*)(lds + L_B);
#pragma unroll
        for (int i = 0; i < 8; ++i) {
            const int t = tg * 8 + i; const size_t g = (size_t)(tok0 + t) * 256 + h * 64 + d;
            qa[t * LP + d] = f2bf(bf2f(P.GQ[g]) * 0.125f * expf(bv[i]));
            kb[t * LP + d] = f2bf(bf2f(P.GK[g]) * expf(-bv[i]));
        }
    }
    stage_vT(P.GV, tok0, h, lds);
    __syncthreads();
    if (wid < 4) {
        const int ss = wid & 1, tt = wid >> 1;
        f32x16 acc;
#pragma unroll
        for (int i = 0; i < 16; ++i) acc[i] = 0.f;
        if (ss <= tt) {
#pragma unroll
            for (int s = 0; s < 4; ++s) {
                const bf16x8 af = *(const LAS bf16x8*)(lds + L_B + ((ss * 32 + r32) * LP + 16 * s + 8 * hi) * 2);
                const bf16x8 bf = *(const LAS bf16x8*)(lds + L_A + ((tt * 32 + r32) * LP + 16 * s + 8 * hi) * 2);
                acc = __builtin_amdgcn_mfma_f32_32x32x16_bf16(af, bf, acc, 0, 0, 0);
            }
        }
        const int t = tt * 32 + r32;
#pragma unroll
        for (int g = 0; g < 4; ++g) {
            float x[4];
#pragma unroll
            for (int e = 0; e < 4; ++e) { const int s = ss * 32 + 8 * g + 4 * hi + e; x[e] = (s <= t) ? acc[4 * g + e] : 0.f; }
            *(LAS u32x2*)(lds + L_A2 + (t * LP + ss * 32 + 8 * g + 4 * hi) * 2) = (u32x2){pk2(x[0], x[1]), pk2(x[2], x[3])};
        }
    }
    __syncthreads();
    const int ee = wid >> 1, tt = wid & 1;
    f32x16 o;
#pragma unroll
    for (int i = 0; i < 16; ++i) o[i] = 0.f;
    {
        const bf16_t* st = P.UT + ((size_t)u * 128 + ee * 32 + r32) * 64 + 8 * hi;
#pragma unroll
        for (int s = 0; s < 4; ++s) {
            const bf16x8 af = *(const bf16x8*)(st + 16 * s);
            const bf16x8 bf = *(const LAS bf16x8*)(lds + L_A + ((tt * 32 + r32) * LP + 16 * s + 8 * hi) * 2);
            o = __builtin_amdgcn_mfma_f32_32x32x16_bf16(af, bf, o, 0, 0, 0);
        }
#pragma unroll
        for (int s = 0; s < 4; ++s) {
            const bf16x8 af = *(const LAS bf16x8*)(lds + L_V + ((ee * 32 + r32) * LP + 16 * s + 8 * hi) * 2);
            const bf16x8 bf = *(const LAS bf16x8*)(lds + L_A2 + ((tt * 32 + r32) * LP + 16 * s + 8 * hi) * 2);
            o = __builtin_amdgcn_mfma_f32_32x32x16_bf16(af, bf, o, 0, 0, 0);
        }
    }
    float ssq = 0.f;
#pragma unroll
    for (int i = 0; i < 16; ++i) ssq = fmaf(o[i], o[i], ssq);
    ssq += __shfl_xor(ssq, 32);
    LAS float* red = (LAS float*)(lds + L_RED);
    const int t = tt * 32 + r32;
    if (hi == 0) red[ee * 64 + t] = ssq;
    __syncthreads();
    const float tot = (red[t] + red[64 + t]) + (red[128 + t] + red[192 + t]);
    const float rs = 1.0f / sqrtf(tot * (1.0f / 128.0f) + NORM_EPS);
    bf16_t* mrow = MIXo + (size_t)(tok0 + t) * 1024 + 512 + h * 128 + ee * 32 + 4 * hi;
    const float* gw = P.gnw + ee * 32 + 4 * hi;
#pragma unroll
    for (int g = 0; g < 4; ++g) {
        const u32x2 gg = *(const u32x2*)(mrow + 8 * g);
        const f32x4 w4 = *(const f32x4*)(gw + 8 * g);
        const float y0 = o[4 * g] * rs * w4[0] * __builtin_bit_cast(float, gg.x << 16), y1 = o[4 * g + 1] * rs * w4[1] * __builtin_bit_cast(float, gg.x & 0xffff0000u);
        const float y2 = o[4 * g + 2] * rs * w4[2] * __builtin_bit_cast(float, gg.y << 16), y3 = o[4 * g + 3] * rs * w4[3] * __builtin_bit_cast(float, gg.y & 0xffff0000u);
        *(u32x2*)(mrow + 8 * g) = (u32x2){pk2(y0, y1), pk2(y2, y3)};
    }
    __syncthreads();
}
}
constexpr int MK_LDS = 147456;
constexpr int N_PHASES = 9;
struct MkArgs { const float* x; const int* pos; const float* w_in; const float* wup; const float* bgate; const float* gnw; const float* w_out; const float* prew; const float* postw;
                float* out; unsigned char* ws; int ph_lo, ph_hi; };
__global__ void __launch_bounds__(512, 2) mk_fwd(MkArgs a) {
    extern __shared__ __attribute__((aligned(16))) unsigned char lds_raw[];
    LAS unsigned char* lds = (LAS unsigned char*)lds_raw;
    cg::grid_group grid = cg::this_grid();
    const int tid = threadIdx.x, lane = tid & 63, wave = __builtin_amdgcn_readfirstlane(tid >> 6);
    const int G = gridDim.x, bx = blockIdx.x;
    const int vcu = (G % 8 == 0) ? (bx % 8) * (G / 8) + bx / 8 : bx;
    unsigned char* ws = a.ws;
    const MkPtrs PT{(const float*)(ws + WS_GLR), a.wup, a.bgate, a.gnw, (const bf16_t*)(ws + WS_GQ), (const bf16_t*)(ws + WS_GK), (const bf16_t*)(ws + WS_GV),
                    (bf16_t*)(ws + WS_UT), (float*)(ws + WS_DV), (bf16_t*)(ws + WS_MIX)};
#define IN(k) (a.ph_lo <= (k) && (k) < a.ph_hi)
    volatile LAS unsigned* bst = (volatile LAS unsigned*)(lds + MK_LDS - 16);
    if (tid < 4) bst[tid] = 0u;
    __syncthreads();
    XcdBarrier xbar = xcd_barrier_post((unsigned*)(ws + WS_CTL) + CW_BAR, bst);
    if (a.ph_hi > 1000) grid.sync();
#ifndef MK_REPS
#define MK_REPS {1, 1, 1, 1, 1, 1, 1, 1, 1}
#endif
#ifndef MK_XSYNC
#define MK_XSYNC 0
#endif
    constexpr int REPS[N_PHASES] = MK_REPS;
    MkPtrs PTD = PT; PTD.UT = (bf16_t*)(ws + WS_DUMMY); PTD.MIX = (bf16_t*)(ws + WS_DUMMY);
#define SEAM(k) do { if (IN(k) && IN((k) + 1)) { xcd_barrier(xbar); for (int xs_ = 0; xs_ < MK_XSYNC; ++xs_) xcd_barrier(xbar); } } while (0)
    if (IN(0)) for (int rep = 0; rep < REPS[0]; ++rep) {
        LAS float* scr = (LAS float*)(lds + wave * 16384);
        const int gw = vcu * 8 + wave, NGW = G * 8;
        constexpr int I_W1 = 16 * (NF / 32), I_W2 = 16 * (DM / 32);
        for (int it = gw; it < I_W1 + I_W2; it += NGW) {
            if (it < I_W1) p0_transpose_item<true>(a.w_in, NPROJ, a.prew, (bf16_t*)(ws + WS_W1T), (bf16_t*)(ws + WS_W1L), scr, it, NF / 32, lane);
            else p0_transpose_item<false>(a.w_out, DM, nullptr, (bf16_t*)(ws + WS_W2T), nullptr, scr, it - I_W1, DM / 32, lane);
        }
        for (int row = gw; row < M; row += NGW) p0_row(a.x, a.pos, ws, row, lane);
    }
    SEAM(0);
    if (IN(1)) for (int rep = 0; rep < REPS[1]; ++rep) {
        ProbProj P{(const bf16_t*)(ws + WS_XH), (const bf16_t*)(ws + WS_XL), (const bf16_t*)(ws + WS_W1T), (const bf16_t*)(ws + WS_W1L)};
        SchedProj S{G, vcu};
        EpiProj E{ws};
        pg8::gemm_phase<EpiProj, SchedProj, ProbProj, true>(lds, P, S, E);
    }
    SEAM(1);
    if (IN(2)) for (int rep = 0; rep < REPS[2]; ++rep) { for (int u = vcu; u < gla::NUNITS; u += G) gla::g1_unit(u, PT, lds); }
    SEAM(2);
    if (IN(3)) for (int rep = 0; rep < REPS[3]; ++rep) { for (int it = vcu; it < 256; it += G) gla::g2_item(it, PT, rep ? PTD.UT : PT.UT); }
    SEAM(3);
    if (IN(4)) for (int rep = 0; rep < REPS[4]; ++rep) { for (int u = vcu; u < gla::NUNITS; u += G) gla::g3_unit(u, PT, rep ? PTD.MIX : PT.MIX, lds); }
    SEAM(4);
    if (IN(5)) for (int rep = 0; rep < REPS[5]; ++rep) sel::phase(ws, ws + WS_SC, lds, G, vcu);
    SEAM(5);
    if (IN(6)) for (int rep = 0; rep < REPS[6]; ++rep) {
        const attn_body::AttnTensors AT{(const attn_body::bf16*)(ws + WS_Q), (const attn_body::bf16*)(ws + WS_K), (const attn_body::bf16*)(ws + WS_V), (const unsigned*)(ws + WS_MASK), (attn_body::bf16*)(ws + (rep ? WS_DUMMY : WS_MIX))};
        const attn_body::StaticOrder S(G, vcu);
        attn_body::attn_phase<attn_body::StaticOrder>((char*)lds_raw, AT, S);
    }
    SEAM(6);
    if (IN(7)) for (int rep = 0; rep < REPS[7]; ++rep) {
        ProbOut P{(const bf16_t*)(ws + WS_MIX), (const bf16_t*)(ws + WS_W2T)};
        SchedOut S{G, vcu};
        EpiY E{(float*)(ws + WS_TMP)};
        pg8::gemm_phase<EpiY, SchedOut, ProbOut, false>(lds, P, S, E);
    }
    SEAM(7);
    if (IN(8)) for (int rep = 0; rep < REPS[8]; ++rep) {
        const int gw = vcu * 8 + wave, NGW = G * 8;
        for (int row = gw; row < M; row += NGW) p6_row(a.x, (const float*)(ws + WS_TMP), a.postw, a.out, row, lane);
    }
#undef IN
#undef SEAM
}

#ifndef MK_CUTS
#define MK_CUTS {0, 9}
#endif
extern "C" void kernel_launch(void* const* d_in, const int* in_sizes, int n_in, void* d_out, int out_size, void* d_ws, size_t ws_size, hipStream_t stream) {
    const float* x = (const float*)d_in[0]; const int* pos = (const int*)d_in[1]; const float* w_in = (const float*)d_in[2];
    const float* wup = (const float*)d_in[3]; const float* bgate = (const float*)d_in[4]; const float* gnw = (const float*)d_in[5];
    const float* w_out = (const float*)d_in[6]; const float* prew = (const float*)d_in[7]; const float* postw = (const float*)d_in[8];
    unsigned char* ws = (unsigned char*)d_ws; float* out = (float*)d_out;
    static int grid_blocks = 0;
    if (!grid_blocks) {
        int dev = 0, cus = 0, per_cu = 0;
        (void)hipGetDevice(&dev);
        (void)hipDeviceGetAttribute(&cus, hipDeviceAttributeMultiprocessorCount, dev);
        (void)hipFuncSetAttribute((const void*)mk_fwd, hipFuncAttributeMaxDynamicSharedMemorySize, MK_LDS);
        (void)hipOccupancyMaxActiveBlocksPerMultiprocessor(&per_cu, (const void*)mk_fwd, 512, MK_LDS);
        if (per_cu < 1) per_cu = 1;
        grid_blocks = cus * per_cu;
    }
    auto launch = [&](int lo, int hi) {
        MkArgs a{}; a.x = x; a.pos = pos; a.w_in = w_in; a.wup = wup; a.bgate = bgate; a.gnw = gnw; a.w_out = w_out; a.prew = prew; a.postw = postw;
        a.out = out; a.ws = ws; a.ph_lo = lo; a.ph_hi = hi;
        void* args[] = {&a};
        hipError_t e = hipLaunchCooperativeKernel((const void*)mk_fwd, dim3(grid_blocks), dim3(512), args, MK_LDS, stream);
        if (e != hipSuccess) fprintf(stderr, "cooperative launch [%d,%d) failed: %s (grid %d)\n", lo, hi, hipGetErrorString(e), grid_blocks);
    };
    (void)hipMemsetAsync(ws + WS_CTL, 0, CTL_ZERO_BYTES, stream);
    const int cuts[] = MK_CUTS;
    for (int i = 0; i + 1 < (int)(sizeof(cuts) / sizeof(cuts[0])); ++i) launch(cuts[i], cuts[i + 1]);
}
```

```cpp
#include <hip/hip_runtime.h>
#include <hip/hip_cooperative_groups.h>
#include <stdint.h>
#include <cstdio>
namespace cg = cooperative_groups;

constexpr int BATCH = 4, SEQ = 4096, M = BATCH * SEQ, DM = 1024, NPROJ = 3924;
constexpr int OFF_AQ = 0, OFF_AK = 512, OFF_AV = 1024, OFF_IQ = 1536, OFF_IK = 1792, OFF_IW = 1856, OFF_AG = 1860,
              OFF_GQ = 2372, OFF_GK = 2628, OFF_GV = 2884, OFF_GLR = 3396, OFF_GG = 3412;
constexpr int TOPK = 256;
constexpr float NORM_EPS = 1e-6f;
constexpr float C2 = 0.125f * 1.4426950408889634f;
constexpr int NF = 4096;

constexpr size_t MiB = 1u << 20;
constexpr size_t WS_CTL = 0, WS_RSTD = 1 * MiB, WS_ROPE = 2 * MiB, WS_W2T = 3 * MiB, WS_Q = 6 * MiB, WS_K = 22 * MiB, WS_V = 38 * MiB, WS_MIX = 54 * MiB,
                 WS_GQ = 86 * MiB, WS_GK = 94 * MiB, WS_GV = 102 * MiB, WS_IQH = 118 * MiB, WS_IQL = 126 * MiB, WS_IKH = 134 * MiB, WS_IKL = 136 * MiB, WS_IW = 138 * MiB, WS_GLR = 139 * MiB,
                 WS_MASK = 140 * MiB, WS_XH = 148 * MiB, WS_XL = 180 * MiB, WS_W1T = 212 * MiB, WS_W1L = 220 * MiB, WS_TMP = 148 * MiB, WS_SC = 148 * MiB, WS_UT = 148 * MiB, WS_DV = 166 * MiB, WS_DUMMY = 180 * MiB;

constexpr int CW_BAR = 4096;
constexpr size_t CTL_ZERO_BYTES = 65536;
typedef unsigned short bf16_t;
#define LAS __attribute__((address_space(3)))
__device__ __forceinline__ unsigned f2bf_u(float f) { unsigned u = __builtin_bit_cast(unsigned, f); return (u + 0x7fffu + ((u >> 16) & 1u)) >> 16; }
__device__ __forceinline__ bf16_t f2bf(float f) { return (bf16_t)f2bf_u(f); }
__device__ __forceinline__ float bf2f(bf16_t b) { return __builtin_bit_cast(float, (unsigned)b << 16); }
__device__ __forceinline__ unsigned pk2(float lo, float hi) { return f2bf_u(lo) | (f2bf_u(hi) << 16); }
__device__ __forceinline__ float wave_sum(float v) {
#pragma unroll
    for (int o = 1; o < 64; o <<= 1) v += __shfl_xor(v, o);
    return v;
}
__device__ __forceinline__ float silu(float x) { return x / (1.f + __expf(-x)); }
__device__ __forceinline__ int cmap(int n) {
    if (n < 512) return OFF_AQ + n;
    if (n < 1024) return OFF_AK + (n - 512);
    if (n < 1536) return OFF_AV + (n - 1024);
    if (n < 2048) return OFF_AG + (n - 1536);
    if (n < 2304) return OFF_GQ + (n - 2048);
    if (n < 2560) return OFF_GK + (n - 2304);
    if (n < 3072) return OFF_GV + (n - 2560);
    if (n < 3584) return OFF_GG + (n - 3072);
    if (n < 3840) return OFF_IQ + (n - 3584);
    const int l = n - 3840;
    if (l < 64) return OFF_IK + l;
    if (l < 68) return OFF_IW + (l - 64);
    if (l >= 72 && l < 88) return OFF_GLR + (l - 72);
    return -1;
}

struct MkPtrs { const float* GLR; const float* wup; const float* bias; const float* gnw; const bf16_t* GQ; const bf16_t* GK; const bf16_t* GV; bf16_t* UT; float* DV; bf16_t* MIX; };
#define XB_TMO      128
#define XB_XCNT(j)  (256  + 64 * (j))
#define XB_XSUB(j)  (1280 + 64 * (j))
#define XB_XGEN(j)  (2304 + 64 * (j))
#define XB_TOP      3328
#define XB_TOPGEN   3392
#define XCD_BAR_WORDS 3456
#define XB_SPIN_CAP (1u << 18)

__device__ __forceinline__ unsigned xb_ld(unsigned* p)              { return __hip_atomic_load(p, __ATOMIC_RELAXED, __HIP_MEMORY_SCOPE_AGENT); }
__device__ __forceinline__ unsigned xb_add(unsigned* p, unsigned v) { return __hip_atomic_fetch_add(p, v, __ATOMIC_RELAXED, __HIP_MEMORY_SCOPE_AGENT); }
__device__ __forceinline__ unsigned xb_xcc_id() { return (unsigned)__builtin_amdgcn_s_getreg((3 << 11) | 20) & 0xFu; }
#define XB_SPIN(cond, bar) do { unsigned _sp = 0; while (cond) { __builtin_amdgcn_s_sleep(1); \
    if ((++_sp & 255u) == 0u) { if (xb_ld(&(bar)[XB_TMO])) break; if (_sp > XB_SPIN_CAP) { atomicAdd(&(bar)[XB_TMO], 1u); break; } } } } while (0)

struct XcdBarrier {
    unsigned* bar; unsigned x;
    volatile LAS unsigned* st;
};

__device__ __forceinline__ XcdBarrier xcd_barrier_post(unsigned* bar, volatile LAS unsigned* st) {
    XcdBarrier b; b.bar = bar; b.x = xb_xcc_id(); b.st = st;
    if (threadIdx.x == 0) (void)xb_add(&bar[XB_XCNT(b.x)], 1u);
    return b;
}
__device__ __forceinline__ void xcd_barrier_complete(unsigned* bar, unsigned x, unsigned& nloc, unsigned& nx) {
    const unsigned G = gridDim.x * gridDim.y * gridDim.z;
    unsigned sum, cnt, mine, sp = 0u;
    for (;;) {
        sum = 0u; cnt = 0u; mine = 0u;
#pragma unroll
        for (unsigned j = 0; j < 16; ++j) { const unsigned c = xb_ld(&bar[XB_XCNT(j)]); sum += c; cnt += (c > 0u) ? 1u : 0u; mine = (j == x) ? c : mine; }
        if (sum == G) break;
        __builtin_amdgcn_s_sleep(1);
        if ((++sp & 255u) == 0u) { if (xb_ld(&bar[XB_TMO])) break; if (sp > XB_SPIN_CAP) { atomicAdd(&bar[XB_TMO], 1u); break; } }
    }
    nloc = mine > 0u ? mine : 1u; nx = cnt > 0u ? cnt : 1u;
}

__device__ __forceinline__ void xcd_barrier(const XcdBarrier& b) {
    asm volatile("s_waitcnt vmcnt(0)" ::: "memory");
    __syncthreads();
    if (threadIdx.x == 0) {
        unsigned* bar = b.bar;
        __builtin_amdgcn_s_waitcnt(0);
        unsigned nloc = b.st[0], nx = b.st[1];
        if (nloc == 0u) { xcd_barrier_complete(bar, b.x, nloc, nx); b.st[0] = nloc; b.st[1] = nx; }
        const unsigned old = xb_add(&bar[XB_XSUB(b.x)], 1u);
        const unsigned gen = old / nloc;
        if (old + 1u == (gen + 1u) * nloc) {
            __builtin_amdgcn_fence(__ATOMIC_RELEASE, "agent");
            asm volatile("s_waitcnt vmcnt(0)" ::: "memory");
            const unsigned og = xb_add(&bar[XB_TOP], 1u);
            const unsigned tg = og / nx;
            if (og + 1u == (tg + 1u) * nx) xb_add(&bar[XB_TOPGEN], 1u);
            else XB_SPIN(xb_ld(&bar[XB_TOPGEN]) == tg, bar);
            __builtin_amdgcn_fence(__ATOMIC_ACQUIRE, "agent");
            xb_add(&bar[XB_XGEN(b.x)], 1u);
            asm volatile("s_waitcnt vmcnt(0)" ::: "memory");
        } else {
            XB_SPIN(xb_ld(&bar[XB_XGEN(b.x)]) == gen, bar);
            __builtin_amdgcn_fence(__ATOMIC_ACQUIRE, "agent");
            asm volatile("s_waitcnt vmcnt(0)" ::: "memory");
        }
    }
    __syncthreads();
}
namespace pg8 {
typedef short bf16x8 __attribute__((ext_vector_type(8)));
typedef float f32x4 __attribute__((ext_vector_type(4)));
typedef unsigned u32x4 __attribute__((ext_vector_type(4)));
constexpr int BM = 256, BK = 64, HALF = 128, HTB = HALF * BK * 2, STAGE_BYTES = 8 * HTB, KP = 1024  ;
__host__ __device__ __forceinline__ int lds_byte(int r, int c) { const int st = (r >> 4) * 2 + (c >> 5), rr = r & 15, cc = c & 31, ob = rr * 64 + cc * 2; return st * 1024 + (ob ^ (((ob >> 9) & 1) << 5)); }
__host__ __device__ __forceinline__ void stage_rc(int b, int& R, int& C) { const int st = b / 1024, sb = b % 1024, swz = sb ^ (((sb >> 9) & 1) << 5); R = (st >> 1) * 16 + swz / 64; C = (st & 1) * 32 + (swz % 64) / 2; }
__host__ __device__ __forceinline__ int perm32(int rho) { const int n = rho >> 4, i = rho & 15; return 8 * (i >> 2) + 4 * n + (i & 3); }
struct Unit { int pm, pn, kind; };

template <class Epi, class Sched, class Prob, bool ALIGN_EPI>
__device__ __forceinline__ void gemm_phase(LAS unsigned char* lds, const Prob& P, const Sched& S, const Epi& E) {
    const int tid = threadIdx.x, wid = __builtin_amdgcn_readfirstlane(tid >> 6), lane = tid & 63, wr = wid >> 2, wc = wid & 3, fr = lane & 15, fq = lane >> 4;
    unsigned voffA[2], voffB[2];
#pragma unroll
    for (int i = 0; i < 2; ++i) { int R, C; stage_rc(tid * 16 + i * 8192, R, C); const int Rb = Epi::PERM ? ((R & ~31) + perm32(R & 31)) : R;
        voffA[i] = (unsigned)(R * KP + C) * 2u; voffB[i] = (unsigned)(Rb * KP + C) * 2u; }
    const size_t hstep = (size_t)HALF * KP * 2;
    const unsigned ldsw = (unsigned)wid * 1024u;
    const int aoff = lds_byte(wr * 64 + fr, fq * 8), boff = lds_byte(wc * 32 + fr, fq * 8);
#define PG8_SA(b, h) (((b) * 2 + (h)) * HTB)
#define PG8_SB(b, h) ((4 + (b) * 2 + (h)) * HTB)
#define PG8_STAGE(bufoff, gbase, voff) do { _Pragma("unroll") for (int _i = 0; _i < 2; ++_i) \
        __builtin_amdgcn_global_load_lds((const unsigned*)((const char*)(gbase) + (voff)[_i]), (LAS unsigned*)(lds + (bufoff) + ldsw + _i * 8192), 16, 0, 0); } while (0)
#define PG8_LDA(dst, b, h) do { _Pragma("unroll") for (int m = 0; m < 4; ++m) _Pragma("unroll") for (int k = 0; k < 2; ++k) dst[m][k] = *(const LAS bf16x8*)(lds + PG8_SA(b, h) + aoff + m * 2048 + k * 1024); } while (0)
#define PG8_LDB(dst, b, h) do { _Pragma("unroll") for (int n = 0; n < 2; ++n) _Pragma("unroll") for (int k = 0; k < 2; ++k) dst[n][k] = *(const LAS bf16x8*)(lds + PG8_SB(b, h) + boff + n * 2048 + k * 1024); } while (0)
#define PG8_MMA(ai, bj, At, Bt) do { __builtin_amdgcn_s_setprio(1); _Pragma("unroll") for (int m = 0; m < 4; ++m) _Pragma("unroll") for (int n = 0; n < 2; ++n) _Pragma("unroll") for (int k = 0; k < 2; ++k) \
        acc[ai][bj][m][n] = __builtin_amdgcn_mfma_f32_16x16x32_bf16(Bt[n][k], At[m][k], acc[ai][bj][m][n], 0, 0, 0); __builtin_amdgcn_s_setprio(0); } while (0)
#define PG8_WAIT_V(n) asm volatile("s_waitcnt vmcnt(" #n ")" ::: "memory")
#define PG8_WAIT_L(n) asm volatile("s_waitcnt lgkmcnt(" #n ")" ::: "memory")
#define PG8_BAR __builtin_amdgcn_s_barrier()
#define PG8_SCHED __builtin_amdgcn_sched_barrier(0)
    Unit cur, nxt; int ui = 0;
    if (!S.next(0, cur)) return;
    f32x4 acc[2][2][4][2];
#pragma unroll
    for (int a = 0; a < 2; ++a)
#pragma unroll
        for (int b = 0; b < 2; ++b)
#pragma unroll
            for (int m = 0; m < 4; ++m)
#pragma unroll
                for (int n = 0; n < 2; ++n) acc[a][b][m][n] = (f32x4){0.f, 0.f, 0.f, 0.f};
    bf16x8 At[4][2], B0[2][2], B1[2][2];
    {
        const char* a0 = P.a(cur, 0); const char* b0 = P.b(cur, 0); const char* a1 = P.a(cur, 1); const char* b1 = P.b(cur, 1);
        PG8_STAGE(PG8_SB(0, 0), b0, voffB); PG8_STAGE(PG8_SB(0, 1), b0 + hstep, voffB); PG8_STAGE(PG8_SA(0, 0), a0, voffA); PG8_STAGE(PG8_SA(0, 1), a0 + hstep, voffA);
        if (wr == 1) PG8_BAR;
        PG8_WAIT_V(2); PG8_BAR;
        PG8_STAGE(PG8_SB(1, 0), b1, voffB); PG8_STAGE(PG8_SA(1, 0), a1, voffA); PG8_STAGE(PG8_SB(1, 1), b1 + hstep, voffB);
        PG8_WAIT_V(6); PG8_BAR;
    }
    for (;;) {
        const bool has_next = S.next(ui + 1, nxt);
        const Unit nu = has_next ? nxt : cur;
        const int nt = P.nt(cur);
        for (int t = 0; t < nt; t += 2) {
            const bool last = (t == nt - 2);
            const char* a1 = P.a(cur, t + 1);
            const char* a2 = last ? P.a(nu, 0) : P.a(cur, t + 2); const char* b2 = last ? P.b(nu, 0) : P.b(cur, t + 2);
            const char* a3 = last ? P.a(nu, 1) : P.a(cur, t + 3); const char* b3 = last ? P.b(nu, 1) : P.b(cur, t + 3);
            PG8_LDB(B0, 0, 0); PG8_LDB(B1, 0, 1); PG8_SCHED; PG8_LDA(At, 0, 0); PG8_STAGE(PG8_SA(1, 1), a1 + hstep, voffA);
            PG8_WAIT_V(8); PG8_WAIT_L(0); PG8_BAR; PG8_MMA(0, 0, At, B0); PG8_MMA(0, 1, At, B1); PG8_BAR; PG8_SCHED;
            PG8_LDA(At, 0, 1); PG8_STAGE(PG8_SB(0, 0), b2, voffB); PG8_STAGE(PG8_SB(0, 1), b2 + hstep, voffB); PG8_STAGE(PG8_SA(0, 0), a2, voffA);
            PG8_WAIT_V(8); PG8_WAIT_L(0); PG8_BAR; PG8_MMA(1, 0, At, B0); PG8_MMA(1, 1, At, B1); PG8_BAR; PG8_SCHED;
            PG8_LDB(B0, 1, 0); PG8_LDB(B1, 1, 1); PG8_SCHED; PG8_LDA(At, 1, 0); PG8_STAGE(PG8_SA(0, 1), a2 + hstep, voffA);
            PG8_WAIT_V(8); PG8_WAIT_L(0); PG8_BAR; PG8_MMA(0, 0, At, B0); PG8_MMA(0, 1, At, B1); PG8_BAR; PG8_SCHED;
            PG8_LDA(At, 1, 1); PG8_STAGE(PG8_SB(1, 0), b3, voffB); PG8_STAGE(PG8_SB(1, 1), b3 + hstep, voffB); PG8_STAGE(PG8_SA(1, 0), a3, voffA);
            PG8_WAIT_V(8); PG8_WAIT_L(0); PG8_BAR; PG8_MMA(1, 0, At, B0); PG8_MMA(1, 1, At, B1); PG8_BAR; PG8_SCHED;
        }
        if constexpr (ALIGN_EPI) { if (wr == 0) PG8_BAR; }
        if constexpr (!Epi::AFTER_DRAIN) { E(acc, cur, wr, wc, fr, fq); }
        if (!has_next) break;
#pragma unroll
        for (int a = 0; a < 2; ++a)
#pragma unroll
            for (int b = 0; b < 2; ++b)
#pragma unroll
                for (int m = 0; m < 4; ++m)
#pragma unroll
                    for (int n = 0; n < 2; ++n) acc[a][b][m][n] = (f32x4){0.f, 0.f, 0.f, 0.f};
        cur = nxt; ++ui;
        if constexpr (ALIGN_EPI) { if (wr == 1) PG8_BAR; }
    }
    PG8_WAIT_V(0);
    if constexpr (!ALIGN_EPI) { if (wr == 0) PG8_BAR; }
    PG8_BAR;
    if constexpr (Epi::AFTER_DRAIN) { E.fused(acc, cur, wr, wc, fr, fq, lds, wid, lane); }
#undef PG8_SA
#undef PG8_SB
#undef PG8_STAGE
#undef PG8_LDA
#undef PG8_LDB
#undef PG8_MMA
#undef PG8_WAIT_V
#undef PG8_WAIT_L
#undef PG8_BAR
#undef PG8_SCHED
}
}
typedef float f32x4 __attribute__((ext_vector_type(4)));
typedef unsigned u32x4 __attribute__((ext_vector_type(4)));
typedef unsigned u32x2 __attribute__((ext_vector_type(2)));

struct ProbProj {
    const bf16_t *XH, *XL, *W1T, *W1L;
    __device__ __forceinline__ int nt(const pg8::Unit& u) const { return u.kind ? 48 : 16; }
    __device__ __forceinline__ const char* a(const pg8::Unit& u, int t) const {
        const bf16_t* base = (u.kind && t >= 16 && t < 32) ? XL : XH;
        return (const char*)(base + (size_t)u.pm * 256 * pg8::KP) + (size_t)(t & 15) * 128; }
    __device__ __forceinline__ const char* b(const pg8::Unit& u, int t) const {
        const bf16_t* base = (u.kind && t >= 32) ? (W1L + (size_t)(u.pn - 14) * 256 * pg8::KP) : (W1T + (size_t)u.pn * 256 * pg8::KP);
        return (const char*)base + (size_t)(t & 15) * 128; }
};
struct SchedProj {
    int G, c;
    __device__ __forceinline__ bool next(int i, pg8::Unit& u) const {
        if (G == 256) {
            const int role = c & 3; u.pm = c >> 2;
            if (role < 2) { if (i >= 3) return false; if (i == 0) { u.pn = 14 + role; u.kind = 1; } else { u.pn = role * 2 + (i - 1); u.kind = 0; } }
            else { if (i >= 5) return false; u.pn = 4 + (role - 2) * 5 + i; u.kind = 0; }
            return true;
        }
        const long L = (long)i * G + c; if (L >= 64 * 16) return false;
        const int pn = 15 - (int)(L / 64); u.pm = (int)(L % 64); u.pn = pn; u.kind = pn >= 14 ? 1 : 0; return true;
    }
};
__device__ __forceinline__ void split_store8(const f32x4& v0, const f32x4& v1, bf16_t* ph, bf16_t* pl) {
    u32x4 h; h.x = pk2(v0[0], v0[1]); h.y = pk2(v0[2], v0[3]); h.z = pk2(v1[0], v1[1]); h.w = pk2(v1[2], v1[3]);
    f32x4 l0, l1;
    l0[0] = v0[0] - __builtin_bit_cast(float, h.x << 16); l0[1] = v0[1] - __builtin_bit_cast(float, h.x & 0xffff0000u);
    l0[2] = v0[2] - __builtin_bit_cast(float, h.y << 16); l0[3] = v0[3] - __builtin_bit_cast(float, h.y & 0xffff0000u);
    l1[0] = v1[0] - __builtin_bit_cast(float, h.z << 16); l1[1] = v1[1] - __builtin_bit_cast(float, h.z & 0xffff0000u);
    l1[2] = v1[2] - __builtin_bit_cast(float, h.w << 16); l1[3] = v1[3] - __builtin_bit_cast(float, h.w & 0xffff0000u);
    u32x4 l; l.x = pk2(l0[0], l0[1]); l.y = pk2(l0[2], l0[3]); l.z = pk2(l1[0], l1[1]); l.w = pk2(l1[2], l1[3]);
    *(u32x4*)ph = h; *(u32x4*)pl = l;
}
struct EpiProj {
    static constexpr bool PERM = true, AFTER_DRAIN = false;
    unsigned char* ws;
    __device__ __forceinline__ void operator()(const f32x4 (&acc)[2][2][4][2], const pg8::Unit& u, int wr, int wc, int fr, int fq) const {
        const int pn = u.pn;
        const float* rstd = (const float*)(ws + WS_RSTD); const float* rope = (const float*)(ws + WS_ROPE);
        const bool rope_tile = (pn < 4) || (pn >= 14);
        const bool rope_wave = rope_tile && ((wc & 1) == 0);
        int mode, ld, coloff; unsigned char* base; float sc = 1.f;
        if (pn < 2)       { mode = 0; base = ws + WS_Q;   ld = 512;  coloff = pn * 256; sc = C2; }
        else if (pn < 4)  { mode = 0; base = ws + WS_K;   ld = 512;  coloff = (pn - 2) * 256; }
        else if (pn < 6)  { mode = 0; base = ws + WS_V;   ld = 512;  coloff = (pn - 4) * 256; }
        else if (pn < 8)  { mode = 1; base = ws + WS_MIX; ld = 1024; coloff = (pn - 6) * 256; }
        else if (pn == 8) { mode = 0; base = ws + WS_GQ;  ld = 256;  coloff = 0; }
        else if (pn == 9) { mode = 0; base = ws + WS_GK;  ld = 256;  coloff = 0; }
        else if (pn < 12) { mode = 0; base = ws + WS_GV;  ld = 512;  coloff = (pn - 10) * 256; }
        else if (pn < 14) { mode = 1; base = ws + WS_MIX; ld = 1024; coloff = 512 + (pn - 12) * 256; }
        else if (pn == 14){ mode = 2; base = ws + WS_IQH; ld = 256;  coloff = 0; }
        else              { mode = 3; base = ws + WS_IKH; ld = 64;   coloff = 0; }
        const int row0 = u.pm * 256 + wr * 64 + fr;
#pragma unroll
        for (int ai = 0; ai < 2; ++ai)
#pragma unroll
            for (int m = 0; m < 4; ++m) {
                const int row = row0 + ai * 128 + m * 16;
                const float r = rstd[row];
                f32x4 c_lo = {1.f, 1.f, 1.f, 1.f}, c_hi = c_lo, s_lo = {0.f, 0.f, 0.f, 0.f}, s_hi = s_lo;
                if (rope_wave) { const f32x4* rp = (const f32x4*)(rope + (size_t)row * 16); c_lo = rp[0]; c_hi = rp[1]; s_lo = rp[2]; s_hi = rp[3]; }
#pragma unroll
                for (int bj = 0; bj < 2; ++bj) {
                    f32x4 v0 = acc[ai][bj][m][0] * r, v1 = acc[ai][bj][m][1] * r;
                    if (rope_wave && (pn != 15 || (bj == 0 && wc == 0))) {
                        f32x4 p0, p1;
#pragma unroll
                        for (int j = 0; j < 4; ++j) { p0[j] = __shfl_xor(v0[j], 16); p1[j] = __shfl_xor(v1[j], 16); }
                        if (fq == 0) { v0 = v0 * c_lo - p0 * s_lo; v1 = v1 * c_hi - p1 * s_hi; }
                        else if (fq == 1) { v0 = v0 * c_lo + p0 * s_lo; v1 = v1 * c_hi + p1 * s_hi; }
                    }
                    const int c0 = bj * 128 + wc * 32 + 8 * fq;
                    if (mode == 0 || mode == 1) {
                        if (mode == 1) {
#pragma unroll
                            for (int j = 0; j < 4; ++j) { v0[j] = silu(v0[j]); v1[j] = silu(v1[j]); }
                        } else { v0 = v0 * sc; v1 = v1 * sc; }
                        u32x4 w; w.x = pk2(v0[0], v0[1]); w.y = pk2(v0[2], v0[3]); w.z = pk2(v1[0], v1[1]); w.w = pk2(v1[2], v1[3]);
                        *(u32x4*)((bf16_t*)base + (size_t)row * ld + coloff + c0) = w;
                    } else if (mode == 2) {
                        split_store8(v0, v1, (bf16_t*)(ws + WS_IQH) + (size_t)row * 256 + c0, (bf16_t*)(ws + WS_IQL) + (size_t)row * 256 + c0);
                    } else {
                        if (c0 < 64) split_store8(v0, v1, (bf16_t*)(ws + WS_IKH) + (size_t)row * 64 + c0, (bf16_t*)(ws + WS_IKL) + (size_t)row * 64 + c0);
                        else if (c0 == 64) { *(f32x4*)((float*)(ws + WS_IW) + (size_t)row * 4) = v0 * (0.5f * 0.125f); }
                        else if (c0 == 72) { float* p = (float*)(ws + WS_GLR) + (size_t)row * 16; *(f32x4*)p = v0; *(f32x4*)(p + 4) = v1; }
                        else if (c0 == 80) { float* p = (float*)(ws + WS_GLR) + (size_t)row * 16 + 8; *(f32x4*)p = v0; *(f32x4*)(p + 4) = v1; }
                    }
                }
            }
    }
};

template <bool MAPPED>
__device__ __forceinline__ void p0_transpose_item(const float* W, int Nsrc, const float* ksc, bf16_t* WT, bf16_t* WL, LAS float* scr, int item, int nblk, int lane) {
    const int kb = item / nblk, nb = item % nblk, k0 = 64 * kb, n0 = 32 * nb;
    const int srcc = MAPPED ? cmap(n0 + (lane & 31)) : (n0 + (lane & 31));
#pragma unroll 8
    for (int i = 0; i < 32; ++i) { const int kk = 2 * i + (lane >> 5);
        float v = W[(size_t)(k0 + kk) * Nsrc + (srcc < 0 ? 0 : srcc)]; if (MAPPED) v *= ksc[k0 + kk];
        scr[kk * 33 + (lane & 31)] = (srcc < 0) ? 0.f : v; }
    asm volatile("s_waitcnt lgkmcnt(0)" ::: "memory");
    const int c = lane & 7;
#pragma unroll
    for (int j = 0; j < 4; ++j) { const int n = (lane >> 3) + 8 * j; const LAS float* s = scr + (8 * c) * 33 + n;
        float v[8];
#pragma unroll
        for (int q = 0; q < 8; ++q) v[q] = s[q * 33];
        u32x4 o; o.x = pk2(v[0], v[1]); o.y = pk2(v[2], v[3]); o.z = pk2(v[4], v[5]); o.w = pk2(v[6], v[7]);
        *(u32x4*)(WT + (size_t)(n0 + n) * 1024 + k0 + 8 * c) = o;
        if (MAPPED && n0 >= 3584) {
            float l[8];
#pragma unroll
            for (int q = 0; q < 8; ++q) l[q] = v[q] - bf2f(f2bf(v[q]));
            u32x4 ol; ol.x = pk2(l[0], l[1]); ol.y = pk2(l[2], l[3]); ol.z = pk2(l[4], l[5]); ol.w = pk2(l[6], l[7]);
            *(u32x4*)(WL + (size_t)(n0 - 3584 + n) * 1024 + k0 + 8 * c) = ol;
        }
    }
    asm volatile("s_waitcnt lgkmcnt(0)" ::: "memory");
}
__device__ __forceinline__ void p0_row(const float* x, const int* pos, unsigned char* ws, int row, int lane) {
    const f32x4* xr = (const f32x4*)(x + (size_t)row * DM) + lane;
    f32x4 v[4]; float s = 0.f;
#pragma unroll
    for (int j = 0; j < 4; ++j) { v[j] = xr[64 * j]; s += (v[j][0] * v[j][0] + v[j][1] * v[j][1]) + (v[j][2] * v[j][2] + v[j][3] * v[j][3]); }
    s = wave_sum(s);
    u32x2* oh = (u32x2*)((bf16_t*)(ws + WS_XH) + (size_t)row * DM) + lane;
    u32x2* ol = (u32x2*)((bf16_t*)(ws + WS_XL) + (size_t)row * DM) + lane;
#pragma unroll
    for (int j = 0; j < 4; ++j) {
        u32x2 h; h.x = pk2(v[j][0], v[j][1]); h.y = pk2(v[j][2], v[j][3]);
        f32x4 l; l[0] = v[j][0] - __builtin_bit_cast(float, h.x << 16); l[1] = v[j][1] - __builtin_bit_cast(float, h.x & 0xffff0000u);
        l[2] = v[j][2] - __builtin_bit_cast(float, h.y << 16); l[3] = v[j][3] - __builtin_bit_cast(float, h.y & 0xffff0000u);
        u32x2 lo; lo.x = pk2(l[0], l[1]); lo.y = pk2(l[2], l[3]);
        oh[64 * j] = h; ol[64 * j] = lo;
    }
    if (lane == 0) ((float*)(ws + WS_RSTD))[row] = 1.0f / sqrtf(s * (1.0f / DM) + NORM_EPS);
    if (lane < 8) {
        const float inv = (float)pow(500000.0, -(double)lane / 8.0);
        const float ang = (float)pos[row] * inv;
        float* rope = (float*)(ws + WS_ROPE);
        rope[row * 16 + lane] = (float)cos((double)ang);
        rope[row * 16 + 8 + lane] = (float)sin((double)ang);
    }
}
struct ProbOut {
    const bf16_t *A, *Bt;
    __device__ __forceinline__ int nt(const pg8::Unit&) const { return 16; }
    __device__ __forceinline__ const char* a(const pg8::Unit& u, int t) const { return (const char*)(A + (size_t)u.pm * 256 * pg8::KP) + (size_t)(t & 15) * 128; }
    __device__ __forceinline__ const char* b(const pg8::Unit& u, int t) const { return (const char*)(Bt + (size_t)u.pn * 256 * pg8::KP) + (size_t)(t & 15) * 128; }
};
struct SchedOut {
    int G, c;
    __device__ __forceinline__ bool next(int i, pg8::Unit& u) const { const long L = (long)i * G + c; if (L >= 256) return false; u.pm = (int)(L >> 2); u.pn = (int)(L & 3); u.kind = 0; return true; }
};
struct EpiY {
    static constexpr bool PERM = false, AFTER_DRAIN = false;
    float* Y;
    __device__ __forceinline__ void operator()(const f32x4 (&acc)[2][2][4][2], const pg8::Unit& u, int wr, int wc, int fr, int fq) const {
        const int row0 = u.pm * 256 + wr * 64 + fr, col0 = u.pn * 256 + wc * 32 + 4 * fq;
#pragma unroll
        for (int ai = 0; ai < 2; ++ai)
#pragma unroll
            for (int m = 0; m < 4; ++m) { float* rowp = Y + (size_t)(row0 + ai * 128 + m * 16) * DM + col0;
#pragma unroll
                for (int bj = 0; bj < 2; ++bj)
#pragma unroll
                    for (int n = 0; n < 2; ++n) *(f32x4*)(rowp + bj * 128 + n * 16) = acc[ai][bj][m][n]; }
    }
};
__device__ __forceinline__ void p6_row(const float* x, const float* Y, const float* pw, float* out, int row, int lane) {
    const f32x4* yr = (const f32x4*)(Y + (size_t)row * DM) + lane;
    f32x4 v[4]; float s = 0.f;
#pragma unroll
    for (int j = 0; j < 4; ++j) { v[j] = yr[64 * j]; s += (v[j][0] * v[j][0] + v[j][1] * v[j][1]) + (v[j][2] * v[j][2] + v[j][3] * v[j][3]); }
    s = wave_sum(s);
    const float r = 1.0f / sqrtf(s * (1.0f / DM) + NORM_EPS);
#pragma unroll
    for (int j = 0; j < 4; ++j) {
        const f32x4 xv = ((const f32x4*)(x + (size_t)row * DM) + lane)[64 * j], w = ((const f32x4*)pw + lane)[64 * j];
        ((f32x4*)(out + (size_t)row * DM) + lane)[64 * j] = xv + v[j] * r * w;
    }
}
#include <hip/hip_bf16.h>
#include <cmath>
namespace attn_body {
using bf16=__hip_bfloat16;
using bf16x8=__attribute__((ext_vector_type(8)))short;
using s16x4=__attribute__((ext_vector_type(4)))short;
using f32x16=__attribute__((ext_vector_type(16)))float;
using u32x4=__attribute__((ext_vector_type(4)))unsigned;
constexpr int BATCH=4,NHEAD=8,SEQ=4096,D=64,DM=NHEAD*D,OPITCH=1024;
constexpr int NW=8,QBLK=32,QB=QBLK*NW,KVBLK=64,NQB=SEQ/QB;
constexpr int ATTN_PITCH=DM, ATTN_UNIT_ROWS=QB;
__device__ __forceinline__ int crow(int r,int hi){return (r&3)+8*(r>>2)+4*hi;}
#define SBAR() __builtin_amdgcn_sched_barrier(0)
__device__ __forceinline__ void cmask(f32x16&p0,f32x16&p1,int jb,int qrel,int hi){
  const float NEG=-INFINITY; int kb=64*jb+4*hi;
  #pragma unroll
  for(int r=0;r<16;++r){int kv=kb+(r&3)+8*(r>>2); if(kv>qrel)p0[r]=NEG; if(kv+32>qrel)p1[r]=NEG;}
}

constexpr int NSLOT=3, SLOTB=8192;
constexpr int LDS_K=0, LDS_V=NSLOT*SLOTB, LDS_WS=2*NSLOT*SLOTB, LDS_OST=LDS_WS+NW*64*4, LDS_MSK=LDS_OST+NW*4096, LDS_BYTES=LDS_MSK+NW*512;
constexpr float C2=0.125f*1.4426950408889634f;
__device__ __forceinline__ void glds16(const void*gsrc,unsigned lds_dst){unsigned keep;
  asm volatile("s_mov_b32 %0, m0\n\ts_mov_b32 m0, %2\n\ts_nop 0\n\tglobal_load_lds_dwordx4 %1, off\n\ts_mov_b32 m0, %0":"=&s"(keep):"v"(gsrc),"s"(lds_dst):"memory");}
__device__ __forceinline__ void glds4(const void*gsrc,unsigned lds_dst){unsigned keep;
  asm volatile("s_mov_b32 %0, m0\n\ts_mov_b32 m0, %2\n\ts_nop 0\n\tglobal_load_lds_dword %1, off\n\ts_mov_b32 m0, %0":"=&s"(keep):"v"(gsrc),"s"(lds_dst):"memory");}
__device__ __forceinline__ float max3f(float a,float b,float c){float r;asm("v_max3_f32 %0, %1, %2, %3":"=v"(r):"v"(a),"v"(b),"v"(c));return r;}
__device__ __forceinline__ float max2f(float a,float b){float r;asm("v_max_f32_e32 %0, %1, %2":"=v"(r):"v"(a),"v"(b));return r;}
__device__ __forceinline__ float fadd_s(float a,float b){float r;asm("v_add_f32_e32 %0, %1, %2":"=v"(r):"v"(a),"v"(b));return r;}
__device__ __forceinline__ float fsub_s(float a,float b){float r;asm("v_sub_f32_e32 %0, %1, %2":"=v"(r):"v"(a),"v"(b));return r;}
typedef float f32x2_t __attribute__((ext_vector_type(2))); typedef __bf16 bf16x2_t __attribute__((ext_vector_type(2)));
__device__ __forceinline__ unsigned cvtpk_s(float lo,float hi){f32x2_t v={lo,hi};bf16x2_t b=__builtin_convertvector(v,bf16x2_t);return __builtin_bit_cast(unsigned,b);}
#define WAIT_BAR(N) asm volatile("s_waitcnt vmcnt(" #N ") lgkmcnt(0)\n\ts_barrier":::"memory")

__device__ __forceinline__ void qkt(f32x16&p0,f32x16&p1,const char*Kslot,const bf16x8*qr,const f32x16&negm,int r32,int hi){
  const char*kb=Kslot+hi*1024+r32*16;
  #pragma unroll
  for(int d0=0;d0<4;++d0){
    const bf16x8 b0=*reinterpret_cast<const bf16x8*>(kb+d0*2048);
    const bf16x8 b1=*reinterpret_cast<const bf16x8*>(kb+d0*2048+512);
    if(d0==0){p0=__builtin_amdgcn_mfma_f32_32x32x16_bf16(b0,qr[0],negm,0,0,0);p1=__builtin_amdgcn_mfma_f32_32x32x16_bf16(b1,qr[0],negm,0,0,0);}
    else{p0=__builtin_amdgcn_mfma_f32_32x32x16_bf16(b0,qr[d0],p0,0,0,0);p1=__builtin_amdgcn_mfma_f32_32x32x16_bf16(b1,qr[d0],p1,0,0,0);}}
}
typedef __attribute__((address_space(3))) const char* lds_cptr;
typedef short v4i16_t __attribute__((ext_vector_type(4)));
__device__ __forceinline__ void kload8(bf16x8*kf,lds_cptr kp){
  kf[0]=*(const __attribute__((address_space(3))) bf16x8*)(kp);      kf[1]=*(const __attribute__((address_space(3))) bf16x8*)(kp+512);
  kf[2]=*(const __attribute__((address_space(3))) bf16x8*)(kp+2048); kf[3]=*(const __attribute__((address_space(3))) bf16x8*)(kp+2560);
  kf[4]=*(const __attribute__((address_space(3))) bf16x8*)(kp+4096); kf[5]=*(const __attribute__((address_space(3))) bf16x8*)(kp+4608);
  kf[6]=*(const __attribute__((address_space(3))) bf16x8*)(kp+6144); kf[7]=*(const __attribute__((address_space(3))) bf16x8*)(kp+6656);
}
__device__ __forceinline__ void kload2(bf16x8*kf,lds_cptr kp,int j){ kf[2*j]=*(const __attribute__((address_space(3))) bf16x8*)(kp+j*2048); kf[2*j+1]=*(const __attribute__((address_space(3))) bf16x8*)(kp+j*2048+512); }
__device__ __forceinline__ s16x4 vtr(lds_cptr p){ return __builtin_bit_cast(s16x4,__builtin_amdgcn_ds_read_tr16_b64_v4i16((__attribute__((address_space(3))) v4i16_t*)p)); }
__device__ __forceinline__ float rowmax(const f32x16&p0,const f32x16&p1){
  float a=max3f(p0[0],p0[1],p1[0]),b=max3f(p0[2],p0[3],p1[1]);a=max3f(a,p1[2],p1[3]);
  #pragma unroll
  for(int r=4;r<16;r+=4){a=max3f(a,p0[r],p0[r+1]);b=max3f(b,p0[r+2],p0[r+3]);a=max3f(a,p1[r],p1[r+1]);b=max3f(b,p1[r+2],p1[r+3]);}
  const float m=max2f(a,b);
  auto rr=__builtin_amdgcn_permlane32_swap(__float_as_uint(m),__float_as_uint(m),false,false);
  return max2f(__uint_as_float(rr[0]),__uint_as_float(rr[1]));
}
__device__ __forceinline__ void pv(f32x16*o,int vb,bf16x8 pa0,bf16x8 pa1,bf16x8 pa2,bf16x8 pa3){
  #pragma unroll
  for(int d0=0;d0<2;++d0){s16x4 lo[4],hi[4];
    #pragma unroll
    for(int ks=0;ks<4;++ks){
      asm volatile("ds_read_b64_tr_b16 %0,%1 offset:%c2":"=&v"(lo[ks]):"v"(vb),"i"(d0*4096+ks*1024):"memory");
      asm volatile("ds_read_b64_tr_b16 %0,%1 offset:%c2":"=&v"(hi[ks]):"v"(vb),"i"(d0*4096+ks*1024+512):"memory");}
    asm volatile("s_waitcnt lgkmcnt(0)":::"memory");SBAR();
    #define PK(k) (bf16x8){lo[k][0],lo[k][1],lo[k][2],lo[k][3],hi[k][0],hi[k][1],hi[k][2],hi[k][3]}
    o[d0]=__builtin_amdgcn_mfma_f32_32x32x16_bf16(pa0,PK(0),o[d0],0,0,0);
    o[d0]=__builtin_amdgcn_mfma_f32_32x32x16_bf16(pa1,PK(1),o[d0],0,0,0);
    o[d0]=__builtin_amdgcn_mfma_f32_32x32x16_bf16(pa2,PK(2),o[d0],0,0,0);
    o[d0]=__builtin_amdgcn_mfma_f32_32x32x16_bf16(pa3,PK(3),o[d0],0,0,0);
    #undef PK
  }
}

#ifndef ATTN_STORE16
#define ATTN_STORE16(p,v) (*(u32x4*)(p)=(v))
#endif
template<int THRL> __device__ __forceinline__ void attn_unit(int b,int h,int qb,const bf16*Q,const bf16*__restrict__ K,const bf16*__restrict__ V,const unsigned*__restrict__ MASK32,bf16*O,char*shm){
  const int tid=threadIdx.x,lane=tid&63,r32=lane&31,hi=lane>>5; const int wid=__builtin_amdgcn_readfirstlane(tid>>6);
  const long rowbase=(long)b*SEQ; const int q0=qb*QB;
  const bf16*Qw=Q+(rowbase+q0+wid*QBLK)*DM+h*D;
  const bf16*Kh=K+rowbase*DM+h*D,*Vh=V+rowbase*DM+h*D;
  const unsigned lds0=(unsigned)(uintptr_t)shm;
  float*wsf=(float*)(shm+LDS_WS)+wid*64;
  const bf16*ksrc=Kh+(long)lane*DM+wid*8;
  const bf16*vsrc=Vh+(long)(16*(wid&3)+(lane>>2))*DM+(wid>>2)*32+(lane&3)*8;
  const unsigned kdst=lds0+LDS_K+wid*1024, vdst=lds0+LDS_V+wid*1024;
  #define DMA_K(t,slot) glds16(ksrc+(long)(t)*KVBLK*DM,(unsigned)__builtin_amdgcn_readfirstlane(kdst+(slot)))
  #define DMA_V(t,slot) glds16(vsrc+(long)(t)*KVBLK*DM,(unsigned)__builtin_amdgcn_readfirstlane(vdst+(slot)))
  const unsigned*msrc=MASK32+(size_t)(rowbase+q0+wid*QBLK+(lane>>1))*128+(lane&1);
  const unsigned mdst=lds0+LDS_MSK+wid*512;
  #define DMA_M(t) glds4(msrc+2*(t),(unsigned)__builtin_amdgcn_readfirstlane(mdst+(((t)&1)<<8)))
  typedef __attribute__((address_space(3))) const unsigned long long* lds_u64p;
  #define MSK(v,W,b) __uint_as_float(__float_as_uint(v)&(unsigned)__builtin_amdgcn_sbfe((int)(W),(b),1))
  #define BP(B) (((B)&3)+8*((B)>>2))
  const int vb0=(int)(lds0+LDS_V)+((lane>>4)&1)*32+(lane&3)*8+(4*hi+((lane&15)>>2))*64;
  const char*Kbase=shm+LDS_K; bf16x8 kf[8];
  const lds_cptr shm3=(lds_cptr)shm; const lds_cptr kp0=shm3+LDS_K+hi*1024+r32*16; const lds_cptr vp0=shm3+LDS_V+((lane>>4)&1)*32+(lane&3)*8+(4*hi+((lane&15)>>2))*64;
  const lds_cptr mp0=shm3+LDS_MSK+wid*512+r32*8;
  const int NT=(q0+QB)/KVBLK;
  DMA_M(0);DMA_M(1);DMA_K(0,0);DMA_V(0,0);DMA_K(1,SLOTB);
  bf16x8 qr[4];
  #pragma unroll
  for(int d0=0;d0<4;++d0)qr[d0]=*reinterpret_cast<const bf16x8*>(&Qw[(long)r32*DM+d0*16+hi*8]);
  float mhat=0.f,l_reg=0.f;f32x16 o[2];o[0]=f32x16{};o[1]=f32x16{};f32x16 negm=f32x16{};asm volatile("":"+v"(negm));
  const int qrel=wid*QBLK+r32;
  #define CMASK(P0,P1,t) do{}while(0)
  bool resc=false;
  #define START(P0,P1) do{ const float rm=rowmax(P0,P1); resc=false; \
    { const float dl=rm; mhat=fadd_s(mhat,dl); \
      _Pragma("unroll") for(int r=0;r<16;++r){P0[r]=fsub_s(P0[r],dl);P1[r]=fsub_s(P1[r],dl);} \
      _Pragma("unroll") for(int r=0;r<16;++r)negm[r]=-mhat; asm volatile("":"+v"(negm)); } \
    _Pragma("unroll") for(int r=0;r<16;++r)P0[r]=__builtin_amdgcn_exp2f(P0[r]); }while(0)
  #define RESC() do{ if(resc){ asm volatile("s_waitcnt lgkmcnt(0)":::"memory"); \
      _Pragma("unroll") for(int d_=0;d_<2;++d_) _Pragma("unroll") for(int r=0;r<16;++r)o[d_][r]*=wsf[crow(r,hi)]; } }while(0)
  f32x16 pA0,pA1,pB0,pB1;
  int sl_prev=0,sl_cur=0,sl_next=SLOTB;
  #define ROT() do{sl_prev=sl_cur;sl_cur=sl_next;sl_next=(sl_next==(NSLOT-1)*SLOTB)?0:sl_next+SLOTB;}while(0)
  DMA_K(2,2*SLOTB);
  WAIT_BAR(3);
  qkt(pA0,pA1,Kbase,qr,negm,r32,hi);asm volatile("s_nop 15\n\ts_nop 7":"+v"(pA0),"+v"(pA1));
  START(pA0,pA1);
  _Pragma("unroll") for(int r=0;r<16;++r)pA1[r]=__builtin_amdgcn_exp2f(pA1[r]);
  { const unsigned long long mw_=*(lds_u64p)(mp0); const unsigned mwl_=(unsigned)mw_>>(4*hi), mwh_=(unsigned)(mw_>>32)>>(4*hi);
    _Pragma("unroll") for(int r=0;r<16;++r){pA0[r]=MSK(pA0[r],mwl_,BP(r));pA1[r]=MSK(pA1[r],mwh_,BP(r));} }
  WAIT_BAR(0);
  DMA_K(3,0);DMA_V(1,SLOTB);
  ROT();
  kload8(kf,kp0+sl_cur);
  WAIT_BAR(2);
  s16x4 vlo[8],vhi[8]; u32x4 pw0,pw1,pw2,pw3;
  #define PKW(P,B) cvtpk_s(P[B],P[B+1])
  #define PAF(k) __builtin_bit_cast(bf16x8,pw##k)
  #define VFR(i) (bf16x8){vlo[i][0],vlo[i][1],vlo[i][2],vlo[i][3],vhi[i][0],vhi[i][1],vhi[i][2],vhi[i][3]}
  #define PIN(x) asm volatile("":"+v"(x))
  #define MX3(a,b,c) __builtin_fmaxf(__builtin_fmaxf((a),(b)),(c))
  #define GAPA(MF,A0,A1,A2,A3,W0,W1,PW) do{ MF; sacc+=A0; sacc+=A1; sacc+=A2; sacc+=A3; PIN(sacc); W0; W1; PIN(PW); SBAR(); }while(0)
  #define EX(v) __builtin_amdgcn_exp2f(v)
  #define GAPB(MF,X,W,B) do{ MF; X[B]=MSK(EX(X[B]),W,BP(B)); X[B+1]=MSK(EX(X[B+1]),W,BP(B+1)); X[B+2]=MSK(EX(X[B+2]),W,BP(B+2)); X[B+3]=MSK(EX(X[B+3]),W,BP(B+3)); PIN(X); SBAR(); }while(0)
  #define VRD(i) do{ vlo[i]=vtr(vp_+(((i)>>2)*4096+((i)&3)*1024)); vhi[i]=vtr(vp_+(((i)>>2)*4096+((i)&3)*1024+512)); }while(0)
  #define KRD(G,j) do{ if(G){ kload2(kf,kp0+sl_next,j); SBAR(); } }while(0)
  #define STEP(C0,C1,P0,P1,t,GK,GV,GL) do{ SBAR(); \
    if(GV){DMA_M((t)+1);} \
    const unsigned long long mw_=*(lds_u64p)(mp0+(((t)&1)<<8)); const unsigned mwl_=(unsigned)mw_>>(4*hi), mwh_=(unsigned)(mw_>>32)>>(4*hi); \
    const lds_cptr vp_=vp0+sl_prev; \
    VRD(0); SBAR(); float sacc=(P0[0]+P0[1]); \
    GAPA(C0=__builtin_amdgcn_mfma_f32_32x32x16_bf16(kf[0],qr[0],negm,0,0,0), P0[2],P0[3],P0[4],P0[5],     pw0[0]=PKW(P0,0), pw0[1]=PKW(P0,2), pw0); \
    VRD(4); SBAR(); GAPA(C1=__builtin_amdgcn_mfma_f32_32x32x16_bf16(kf[1],qr[0],negm,0,0,0), P0[6],P0[7],P0[8],P0[9],     pw0[2]=PKW(P0,4), pw0[3]=PKW(P0,6), pw0); \
    VRD(1); SBAR(); GAPA(C0=__builtin_amdgcn_mfma_f32_32x32x16_bf16(kf[2],qr[1],C0,0,0,0),   P0[10],P0[11],P0[12],P0[13], pw1[0]=PKW(P0,8), pw1[1]=PKW(P0,10), pw1); \
    VRD(5); SBAR(); GAPA(C1=__builtin_amdgcn_mfma_f32_32x32x16_bf16(kf[3],qr[1],C1,0,0,0),   P0[14],P0[15],P1[0],P1[1],   pw1[2]=PKW(P0,12),pw1[3]=PKW(P0,14), pw1); \
    VRD(2); SBAR(); GAPA(C0=__builtin_amdgcn_mfma_f32_32x32x16_bf16(kf[4],qr[2],C0,0,0,0),   P1[2],P1[3],P1[4],P1[5],     pw2[0]=PKW(P1,0), pw2[1]=PKW(P1,2), pw2); \
    VRD(6); SBAR(); GAPA(C1=__builtin_amdgcn_mfma_f32_32x32x16_bf16(kf[5],qr[2],C1,0,0,0),   P1[6],P1[7],P1[8],P1[9],     pw2[2]=PKW(P1,4), pw2[3]=PKW(P1,6), pw2); \
    VRD(3); SBAR(); GAPA(C0=__builtin_amdgcn_mfma_f32_32x32x16_bf16(kf[6],qr[3],C0,0,0,0),   P1[10],P1[11],P1[12],P1[13], pw3[0]=PKW(P1,8), pw3[1]=PKW(P1,10), pw3); \
    VRD(7); SBAR(); GAPA(C1=__builtin_amdgcn_mfma_f32_32x32x16_bf16(kf[7],qr[3],C1,0,0,0),   P1[14],P1[15],0.f,0.f,       pw3[2]=PKW(P1,12),pw3[3]=PKW(P1,14), pw3); \
    l_reg+=sacc; \
    if(GK){DMA_K((t)+3,sl_cur);} if(GV){DMA_V((t)+1,sl_next);} \
    CMASK(C0,C1,t); \
    { float a=MX3(C0[0],C0[1],C1[0]),b=MX3(C0[2],C0[3],C1[1]); a=MX3(a,C1[2],C1[3]); \
      _Pragma("unroll") for(int r=4;r<16;r+=4){a=MX3(a,C0[r],C0[r+1]);b=MX3(b,C0[r+2],C0[r+3]);a=MX3(a,C1[r],C1[r+1]);b=MX3(b,C1[r+2],C1[r+3]);} \
      float rm=__builtin_fmaxf(a,b); { auto rr=__builtin_amdgcn_permlane32_swap(__float_as_uint(rm),__float_as_uint(rm),false,false); rm=__builtin_fmaxf(__uint_as_float(rr[0]),__uint_as_float(rr[1])); } \
      resc=false; \
      if(__builtin_expect(__any(rm>(float)THRL),0)){ const float dl=__builtin_fmaxf(rm,0.f); mhat+=dl; \
        _Pragma("unroll") for(int r=0;r<16;++r){C0[r]-=dl;C1[r]-=dl;} \
        _Pragma("unroll") for(int r=0;r<16;++r)negm[r]=-mhat; asm volatile("":"+v"(negm)); \
        const float f=__builtin_amdgcn_exp2f(-dl); l_reg*=f; if(hi==0)wsf[r32]=f; resc=true; } } \
    SBAR(); \
    GAPB(o[0]=__builtin_amdgcn_mfma_f32_32x32x16_bf16(PAF(0),VFR(0),o[0],0,0,0), C0,mwl_,0); \
    GAPB(o[1]=__builtin_amdgcn_mfma_f32_32x32x16_bf16(PAF(0),VFR(4),o[1],0,0,0), C0,mwl_,4); \
    KRD(GL,0); GAPB(o[0]=__builtin_amdgcn_mfma_f32_32x32x16_bf16(PAF(1),VFR(1),o[0],0,0,0), C0,mwl_,8); \
    KRD(GL,1); GAPB(o[1]=__builtin_amdgcn_mfma_f32_32x32x16_bf16(PAF(1),VFR(5),o[1],0,0,0), C0,mwl_,12); \
    KRD(GL,2); GAPB(o[0]=__builtin_amdgcn_mfma_f32_32x32x16_bf16(PAF(2),VFR(2),o[0],0,0,0), C1,mwh_,0); \
    KRD(GL,3); GAPB(o[1]=__builtin_amdgcn_mfma_f32_32x32x16_bf16(PAF(2),VFR(6),o[1],0,0,0), C1,mwh_,4); \
    GAPB(o[0]=__builtin_amdgcn_mfma_f32_32x32x16_bf16(PAF(3),VFR(3),o[0],0,0,0), C1,mwh_,8); \
    GAPB(o[1]=__builtin_amdgcn_mfma_f32_32x32x16_bf16(PAF(3),VFR(7),o[1],0,0,0), C1,mwh_,12); \
    }while(0)
  int t=1;
  #undef CMASK
  #define CMASK(P0,P1,t) do{}while(0)
  for(;t+5<NT;t+=2){
    STEP(pB0,pB1,pA0,pA1,t,true,true,true);     WAIT_BAR(2); RESC(); ROT();
    STEP(pA0,pA1,pB0,pB1,t+1,true,true,true);   WAIT_BAR(2); RESC(); ROT();
  }
  #undef CMASK
  #define CMASK(P0,P1,t) do{}while(0)
  #define ENDW(tt) do{ if((tt)+3<NT){WAIT_BAR(2);} else if((tt)+2<NT){WAIT_BAR(1);} else {WAIT_BAR(0);} }while(0)
  for(;t+1<NT;t+=2){
    STEP(pB0,pB1,pA0,pA1,t,(t+3<NT),(t+1<NT),(t+1<NT));       ENDW(t);   RESC(); ROT();
    STEP(pA0,pA1,pB0,pB1,t+1,(t+4<NT),(t+2<NT),(t+2<NT));     ENDW(t+1); RESC(); ROT();
  }
  STEP(pB0,pB1,pA0,pA1,NT-1,false,false,false); RESC();
  { float sacc=pB0[0]+pB0[1]; _Pragma("unroll") for(int r=2;r<16;++r)sacc+=pB0[r]; _Pragma("unroll") for(int r=0;r<16;++r)sacc+=pB1[r]; l_reg+=sacc;
    pw0=(u32x4){PKW(pB0,0),PKW(pB0,2),PKW(pB0,4),PKW(pB0,6)};pw1=(u32x4){PKW(pB0,8),PKW(pB0,10),PKW(pB0,12),PKW(pB0,14)};pw2=(u32x4){PKW(pB1,0),PKW(pB1,2),PKW(pB1,4),PKW(pB1,6)};pw3=(u32x4){PKW(pB1,8),PKW(pB1,10),PKW(pB1,12),PKW(pB1,14)};
    SBAR(); pv(o,vb0+sl_cur,PAF(0),PAF(1),PAF(2),PAF(3)); }
  #undef PKW
  #undef PAF
  #undef VFR
  #undef PIN
  #undef MX3
  #undef GAPA
  #undef GAPB
  #undef EX
  #undef VRD
  #undef KRD
  #undef STEP
  #undef ENDW
  {auto rr=__builtin_amdgcn_permlane32_swap(__float_as_uint(l_reg),__float_as_uint(l_reg),false,false);l_reg=__uint_as_float(rr[0])+__uint_as_float(rr[1]);}
  if(hi==0)wsf[32+r32]=l_reg;asm volatile("s_waitcnt lgkmcnt(0)":::"memory");
  float rli[16];
  #pragma unroll
  for(int r=0;r<16;++r)rli[r]=__builtin_amdgcn_rcpf(wsf[32+crow(r,hi)]);
  bf16*Ow=O+(rowbase+q0+wid*QBLK)*OPITCH+h*D;
  { bf16*stg=(bf16*)(shm+LDS_OST)+wid*2048;
    #pragma unroll
    for(int r=0;r<16;++r){const int orow=crow(r,hi);
      #pragma unroll
      for(int d0=0;d0<2;++d0)stg[orow*64+d0*32+r32]=__float2bfloat16(o[d0][r]*rli[r]);}
    asm volatile("s_waitcnt lgkmcnt(0)":::"memory");
    #pragma unroll
    for(int i=0;i<4;++i){const int row=i*8+(lane>>3),ch=lane&7; const u32x4 v=*(const u32x4*)(stg+row*64+ch*8); bf16*dst=Ow+(long)row*OPITCH+ch*8; const u32x4 g=*(const u32x4*)dst; u32x4 w;
      _Pragma("unroll") for(int e=0;e<4;++e){ const float a0=__uint_as_float(v[e]<<16),a1=__uint_as_float(v[e]&0xffff0000u),g0=__uint_as_float(g[e]<<16),g1=__uint_as_float(g[e]&0xffff0000u); w[e]=cvtpk_s(a0*g0,a1*g1); }
      *(u32x4*)dst=w;} }
  asm volatile("s_waitcnt lgkmcnt(0)\n\ts_barrier":::"memory");
  #undef DMA_K
  #undef DMA_V
  #undef DMA_M
  #undef MSK
  #undef BP
  #undef CMASK
  #undef START
  #undef RESC
  #undef ROT
}
constexpr int ATTN_LDS_BYTES=LDS_BYTES;
struct AttnTensors { const bf16* Q; const bf16* K; const bf16* V; const unsigned* MASK32; bf16* O; };
struct AttnUnit { int bh; int qb; };
struct StaticOrder {
  int vcu,G;
  __device__ __forceinline__ StaticOrder(int grid,int v):vcu(v),G(grid){}
  __device__ __forceinline__ bool next(int i,AttnUnit&u)const{
    if(G==256){ if(i>=2)return false; const int s=vcu&7; u.bh=vcu>>3; u.qb=(i==0)?15-s:s; return true; }
    const long L=(long)i*G+vcu; if(L>=BATCH*NHEAD*NQB)return false; u.qb=NQB-1-(int)(L/(BATCH*NHEAD)); u.bh=(int)(L%(BATCH*NHEAD)); return true; }
  __device__ __forceinline__ void a_ready(const AttnUnit&)const{}
  __device__ __forceinline__ void done(const AttnUnit&)const{}
};
template<class Sched,int THRL=8> __device__ __forceinline__ void attn_phase(char*lds,const AttnTensors&T,const Sched&S){
  AttnUnit u;
  for(int i=0;S.next(i,u);++i){ S.a_ready(u); attn_unit<THRL>(u.bh/NHEAD,u.bh%NHEAD,u.qb,T.Q,T.K,T.V,T.MASK32,T.O,lds); S.done(u); }
}
#undef SBAR
#undef WAIT_BAR
}
namespace sel {
typedef short bf16x8 __attribute__((ext_vector_type(8)));
typedef float f32x16 __attribute__((ext_vector_type(16)));
constexpr int QF_OFF = 0;
constexpr int HIST_OFF = 32768;
constexpr int NUNITS = BATCH * (SEQ / 32);
__device__ __forceinline__ unsigned mono(float f) { const unsigned u = __builtin_bit_cast(unsigned, f); return (u & 0x80000000u) ? ~u : (u | 0x80000000u); }
__device__ __forceinline__ void unit_of(int u, int& b, int& j) { j = (SEQ / 32 - 1) - (u >> 2); b = u & 3; }
__device__ __forceinline__ size_t scratch_bytes(int v) { return (size_t)4096 * (size_t)((SEQ / 32) - (v >> 2)); }

__device__ __forceinline__ void unit(int b, int j, unsigned char* ws, float* sc, LAS unsigned char* lds) {
    const int tid = threadIdx.x, lane = tid & 63, wid = __builtin_amdgcn_readfirstlane(tid >> 6), r32 = lane & 31, hi = lane >> 5;
    const int q0 = j * 32, row0 = b * SEQ + q0, nkt = j + 1;
    const bf16_t* IQH = (const bf16_t*)(ws + WS_IQH); const bf16_t* IQL = (const bf16_t*)(ws + WS_IQL);
    const bf16_t* IKH = (const bf16_t*)(ws + WS_IKH); const bf16_t* IKL = (const bf16_t*)(ws + WS_IKL);
#pragma unroll
    for (int i = 0; i < 2; ++i) {
        const int f = tid + 512 * i, h = f >> 8, s = (f >> 6) & 3, l = f & 63, r = l & 31, half = l >> 5;
        const size_t src = (size_t)(row0 + r) * 256 + h * 64 + 16 * s + 8 * half;
        const u32x4 vh = *(const u32x4*)(IQH + src), vl = *(const u32x4*)(IQL + src);
        *(LAS u32x4*)(lds + QF_OFF + ((h * 4 + s) * 2 + 0) * 1024 + l * 16) = vh;
        *(LAS u32x4*)(lds + QF_OFF + ((h * 4 + s) * 2 + 1) * 1024 + l * 16) = vl;
    }
    const f32x4 w = *(const f32x4*)((const float*)(ws + WS_IW) + (size_t)(row0 + r32) * 4);
    __syncthreads();
#ifndef SEL_REP_SCORE
#define SEL_REP_SCORE 1
#endif
#ifndef SEL_REP_SELECT
#define SEL_REP_SELECT 1
#endif
    for (int rep_ = 0; rep_ < SEL_REP_SCORE; ++rep_)
    for (int kt = wid; kt < nkt; kt += 8) {
        const size_t krow = (size_t)(b * SEQ + kt * 32 + r32) * 64 + 8 * hi;
        bf16x8 kh[4], kl[4];
#pragma unroll
        for (int s = 0; s < 4; ++s) { kh[s] = *(const bf16x8*)(IKH + krow + 16 * s); kl[s] = *(const bf16x8*)(IKL + krow + 16 * s); }
        f32x16 score;
#pragma unroll
        for (int i = 0; i < 16; ++i) score[i] = 0.f;
        int qoff = lane * 16; asm volatile("" : "+v"(qoff));
#pragma unroll
        for (int h = 0; h < 4; ++h) {
            f32x16 acc;
#pragma unroll
            for (int i = 0; i < 16; ++i) acc[i] = 0.f;
#pragma unroll
            for (int s = 0; s < 4; ++s) {
                const bf16x8 qh = *(const LAS bf16x8*)(lds + QF_OFF + ((h * 4 + s) * 2 + 0) * 1024 + qoff);
                const bf16x8 ql = *(const LAS bf16x8*)(lds + QF_OFF + ((h * 4 + s) * 2 + 1) * 1024 + qoff);
                acc = __builtin_amdgcn_mfma_f32_32x32x16_bf16(kh[s], qh, acc, 0, 0, 0);
                acc = __builtin_amdgcn_mfma_f32_32x32x16_bf16(kh[s], ql, acc, 0, 0, 0);
                acc = __builtin_amdgcn_mfma_f32_32x32x16_bf16(kl[s], qh, acc, 0, 0, 0);
            }
            const float wh = w[h];
#pragma unroll
            for (int i = 0; i < 16; ++i) score[i] += wh * fmaxf(acc[i], 0.f);
        }
        float* dst = sc + ((size_t)(kt * 32 + r32) * 32 + 4 * hi);
#pragma unroll
        for (int g = 0; g < 4; ++g) *(f32x4*)(dst + 8 * g) = (f32x4){score[4 * g], score[4 * g + 1], score[4 * g + 2], score[4 * g + 3]};
    }
    asm volatile("s_waitcnt vmcnt(0)" ::: "memory");
    __syncthreads();
    LAS unsigned* hist = (LAS unsigned*)(lds + HIST_OFF + wid * 8192);
    float pre[64];
#define SEL_LOAD_ROW(QQ, NJ) do { const float* urow_ = sc + (size_t)(QQ) * 32 + hi * 1024 + r32; \
        _Pragma("unroll") for (int g_ = 0; g_ < 8; ++g_) { if (g_ * 8 < (NJ)) { _Pragma("unroll") for (int i_ = 0; i_ < 8; ++i_) pre[g_ * 8 + i_] = __builtin_nontemporal_load(urow_ + (size_t)(g_ * 8 + i_) * 2048); } } } while (0)
    for (int rep_ = 0; rep_ < SEL_REP_SELECT; ++rep_) {
    SEL_LOAD_ROW(wid * 4, ((q0 + wid * 4 + 1) + 63) >> 6);
#pragma unroll 1
    for (int qi = 0; qi < 4; ++qi) {
        const int qq = wid * 4 + qi, t = q0 + qq, n = t + 1, nj = (n + 63) >> 6;
        unsigned key[64];
#pragma unroll
        for (int g = 0; g < 8; ++g) {
            if (g * 8 < nj) {
#pragma unroll
                for (int i = 0; i < 8; ++i) { const int jj = g * 8 + i; key[jj] = (lane < n - 64 * jj) ? mono(pre[jj]) : 0u; }
            } else {
#pragma unroll
                for (int i = 0; i < 8; ++i) key[g * 8 + i] = 0u;
            }
        }
        if (qi < 3) SEL_LOAD_ROW(qq + 1, (n + 1 + 63) >> 6);
        unsigned thr = 1u; bool ties = false; int need = 0;
        if (n > TOPK) {
            unsigned prefix = 0u, kneed = TOPK, cfin = 0u;
#pragma unroll 1
            for (int p = 0; p < 3; ++p) {
                const int NBL = (p == 2) ? 4 : 5, NB = 1 << NBL;
                const int shift = (p == 0) ? 21 : (p == 1) ? 10 : 0, pshift = (p == 0) ? 31 : (p == 1) ? 21 : 10;
                const unsigned dmask = (p == 2) ? 1023u : 2047u;
#pragma unroll
                for (int i = 0; i < 8; ++i) *(LAS u32x4*)(hist + (i * 64 + lane) * 4) = (u32x4){0u, 0u, 0u, 0u};
#pragma unroll
                for (int g = 0; g < 8; ++g) {
                    if (g * 8 < nj) {
#pragma unroll
                        for (int i = 0; i < 8; ++i) {
                            const unsigned k = key[g * 8 + i];
                            const bool part = (p == 0) ? (k != 0u) : ((k >> pshift) == prefix);
                            const unsigned dg = (k >> shift) & dmask;
                            const unsigned bi = dg & (unsigned)(NB - 1);
                            if (part) __hip_atomic_fetch_add(hist + ((bi << 6) | (((dg >> NBL) + bi) & 63u)), 1u, __ATOMIC_RELAXED, __HIP_MEMORY_SCOPE_WORKGROUP);
                        }
                    }
                }
                asm volatile("s_waitcnt lgkmcnt(0)" ::: "memory");
                unsigned tot = 0u;
#pragma unroll
                for (int i = 0; i < 32; ++i) { if (i < NB) tot += hist[i * 64 + ((lane + i) & 63)]; }
                unsigned suf = tot;
#pragma unroll
                for (int o = 1; o < 64; o <<= 1) { const unsigned v = __shfl_down(suf, o); if (lane + o < 64) suf += v; }
                const unsigned above = suf - tot;
                const unsigned long long fm = __ballot(above < kneed && kneed <= above + tot);
                const int L = (int)__builtin_ctzll(fm | (1ull << 63));
                kneed -= (unsigned)__builtin_amdgcn_readlane((int)above, L);
                const unsigned cj = (lane < NB) ? hist[lane * 64 + ((L + lane) & 63)] : 0u;
                unsigned suf2 = cj;
#pragma unroll
                for (int o = 1; o < 32; o <<= 1) { const unsigned v = __shfl_down(suf2, o); if (lane + o < 64) suf2 += v; }
                const unsigned above2 = suf2 - cj;
                const unsigned long long fm2 = __ballot(above2 < kneed && kneed <= above2 + cj);
                const int J = (int)__builtin_ctzll(fm2 | (1ull << 63));
                kneed -= (unsigned)__builtin_amdgcn_readlane((int)above2, J);
                cfin = (unsigned)__builtin_amdgcn_readlane((int)cj, J);
                prefix = (prefix << (p == 2 ? 10 : 11)) | (unsigned)(NB * L + J);
                asm volatile("s_waitcnt lgkmcnt(0)" ::: "memory");
            }
            thr = prefix; need = (int)kneed; ties = (cfin != kneed);
        }
        int mylo = 0, myhi = 0;
        if (!ties) {
#pragma unroll
            for (int g = 0; g < 8; ++g) {
                if (g * 8 < nj) {
#pragma unroll
                    for (int i = 0; i < 8; ++i) {
                        const unsigned long long bits = __ballot(key[g * 8 + i] >= thr);
                        asm volatile("s_nop 1\n\tv_writelane_b32 %0, %2, %4\n\tv_writelane_b32 %1, %3, %4" : "+v"(mylo), "+v"(myhi) : "s"((unsigned)bits), "s"((unsigned)(bits >> 32)), "n"(g * 8 + i));
                    }
                }
            }
        } else {
            int eqcnt = 0;
            const unsigned long long lt = (1ull << lane) - 1ull;
#pragma unroll
            for (int g = 0; g < 8; ++g) {
                if (g * 8 < nj) {
#pragma unroll
                    for (int i = 0; i < 8; ++i) {
                        const unsigned k = key[g * 8 + i];
                        const bool eq = (k == thr);
                        const unsigned long long meq = __ballot(eq);
                        const int rank = eqcnt + (int)__popcll(meq & lt);
                        const unsigned long long bits = __ballot(k > thr || (eq && rank < need));
                        eqcnt += (int)__popcll(meq);
                        asm volatile("s_nop 1\n\tv_writelane_b32 %0, %2, %4\n\tv_writelane_b32 %1, %3, %4" : "+v"(mylo), "+v"(myhi) : "s"((unsigned)bits), "s"((unsigned)(bits >> 32)), "n"(g * 8 + i));
                    }
                }
            }
        }
        ((unsigned long long*)(ws + WS_MASK))[(size_t)(row0 + qq) * 64 + lane] = ((unsigned long long)(unsigned)myhi << 32) | (unsigned long long)(unsigned)mylo;
    }
    }
#undef SEL_LOAD_ROW
    __syncthreads();
}

__device__ __forceinline__ void phase(unsigned char* ws, unsigned char* scbase, LAS unsigned char* lds, int G, int v) {
    const int GE = G < 256 ? G : 256;
    if (v >= GE) return;
    size_t off = 0;
    for (int i = 0; i < v; ++i) off += scratch_bytes(i);
    float* sc = (float*)(scbase + off);
    for (int r = 0;; ++r) {
        const int u = (r & 1) ? ((r + 1) * GE - 1 - v) : (r * GE + v);
        if (u >= NUNITS) break;
        int b, j; unit_of(u, b, j);
        unit(b, j, ws, sc, lds);
    }
}
}
namespace gla {
typedef short bf16x8 __attribute__((ext_vector_type(8)));
typedef float f32x16 __attribute__((ext_vector_type(16)));
constexpr int NUNITS = BATCH * 4 * (SEQ / 64);
constexpr int LP = 72;
constexpr int L_GLR = 0, L_WUP = 4096, L_GT = 8192, L_RED = 10240, L_A = 12288, L_B = L_A + 64 * LP * 2, L_V = L_B + 64 * LP * 2, L_A2 = L_V + 128 * LP * 2, L_END = L_A2 + 64 * LP * 2;
__device__ __forceinline__ int crow(int r, int hi) { return (r & 3) + 8 * (r >> 2) + 4 * hi; }

__device__ __forceinline__ void cum_gates(const float* GLR, const float* wup, const float* bias, int tok0, int h, LAS unsigned char* lds, float (&bv)[8], float& blast) {
    const int tid = threadIdx.x, d = tid & 63, tg = tid >> 6;
    LAS float* sg = (LAS float*)(lds + L_GLR); LAS float* sw = (LAS float*)(lds + L_WUP); LAS float* gt = (LAS float*)(lds + L_GT);
#pragma unroll
    for (int i = 0; i < 2; ++i) { const int e = tid + 512 * i; sg[e] = GLR[(size_t)tok0 * 16 + e]; sw[e] = wup[(e >> 6) * 256 + h * 64 + (e & 63)]; }
    __syncthreads();
    float wu[16];
#pragma unroll
    for (int r = 0; r < 16; ++r) wu[r] = sw[r * 64 + d];
    const float bi = bias[h * 64 + d];
    float run = 0.f;
#pragma unroll
    for (int i = 0; i < 8; ++i) {
        const int t = tg * 8 + i;
        float z = bi;
#pragma unroll
        for (int r = 0; r < 16; ++r) z = fmaf(sg[t * 16 + r], wu[r], z);
        const float ls = fminf(z, 0.f) - log1pf(expf(-fabsf(z)));
        run += ls * (1.0f / 16.0f);
        bv[i] = run;
    }
    gt[tg * 64 + d] = run;
    __syncthreads();
    float pre = 0.f, tot = 0.f;
#pragma unroll
    for (int g = 0; g < 8; ++g) { const float v = gt[g * 64 + d]; tot += v; if (g < tg) pre += v; }
#pragma unroll
    for (int i = 0; i < 8; ++i) bv[i] += pre;
    blast = tot;
}
__device__ __forceinline__ void stage_vT(const bf16_t* GV, int tok0, int h, LAS unsigned char* lds) {
    const int tid = threadIdx.x, e = tid & 127, tq = tid >> 7;
    unsigned pk[8];
#pragma unroll
    for (int i = 0; i < 8; ++i) {
        const unsigned lo = GV[(size_t)(tok0 + tq * 16 + 2 * i) * 512 + h * 128 + e], hi = GV[(size_t)(tok0 + tq * 16 + 2 * i + 1) * 512 + h * 128 + e];
        pk[i] = lo | (hi << 16);
    }
    LAS u32x4* dst = (LAS u32x4*)(lds + L_V + (e * LP + tq * 16) * 2);
    dst[0] = (u32x4){pk[0], pk[1], pk[2], pk[3]}; dst[1] = (u32x4){pk[4], pk[5], pk[6], pk[7]};
}

__device__ __forceinline__ void g1_unit(int u, const MkPtrs& P, LAS unsigned char* lds) {
    const int tid = threadIdx.x, lane = tid & 63, wid = __builtin_amdgcn_readfirstlane(tid >> 6), r32 = lane & 31, hi = lane >> 5;
    const int bh = u >> 6, c = u & 63, b = bh >> 2, h = bh & 3, tok0 = b * SEQ + c * 64, d = tid & 63, tg = tid >> 6;
    float bv[8], blast;
    cum_gates(P.GLR, P.wup, P.bias, tok0, h, lds, bv, blast);
    {
        float kl[8];
#pragma unroll
        for (int i = 0; i < 8; ++i) kl[i] = bf2f(P.GK[(size_t)(tok0 + tg * 8 + i) * 256 + h * 64 + d]) * expf(blast - bv[i]);
        *(LAS u32x4*)(lds + L_A + (d * LP + tg * 8) * 2) = (u32x4){pk2(kl[0], kl[1]), pk2(kl[2], kl[3]), pk2(kl[4], kl[5]), pk2(kl[6], kl[7])};
    }
    stage_vT(P.GV, tok0, h, lds);
    if (tid < 64) P.DV[(size_t)u * 64 + tid] = expf(blast);
    __syncthreads();
    {
        const int wd = wid & 1, we = wid >> 1;
        f32x16 acc;
#pragma unroll
        for (int i = 0; i < 16; ++i) acc[i] = 0.f;
#pragma unroll
        for (int s = 0; s < 4; ++s) {
            const bf16x8 af = *(const LAS bf16x8*)(lds + L_A + ((wd * 32 + r32) * LP + 16 * s + 8 * hi) * 2);
            const bf16x8 bf = *(const LAS bf16x8*)(lds + L_V + ((we * 32 + r32) * LP + 16 * s + 8 * hi) * 2);
            acc = __builtin_amdgcn_mfma_f32_32x32x16_bf16(af, bf, acc, 0, 0, 0);
        }
        bf16_t* dst = P.UT + ((size_t)u * 128 + we * 32 + r32) * 64 + wd * 32 + 4 * hi;
#pragma unroll
        for (int g = 0; g < 4; ++g) *(u32x2*)(dst + 8 * g) = (u32x2){pk2(acc[4 * g], acc[4 * g + 1]), pk2(acc[4 * g + 2], acc[4 * g + 3])};
    }
    __syncthreads();
}
__device__ __forceinline__ void g2_item(int item, const MkPtrs& P, bf16_t* STout) {
    const int tid = threadIdx.x, bh = item >> 4, idx = (item & 15) * 512 + tid, d = idx & 63;
    bf16_t* p = P.UT + (size_t)bh * 64 * 8192 + idx; const float* dvp = P.DV + (size_t)bh * 64 * 64 + d;
    bf16_t* po = STout + (size_t)bh * 64 * 8192 + idx;
    float S = 0.f;
#pragma unroll 1
    for (int c0 = 0; c0 < 64; c0 += 16) {
        float uu[16], dd[16];
#pragma unroll
        for (int i = 0; i < 16; ++i) { uu[i] = bf2f(p[(size_t)(c0 + i) * 8192]); dd[i] = dvp[(c0 + i) * 64]; }
        asm volatile("" ::: "memory");
#pragma unroll
        for (int i = 0; i < 16; ++i) { po[(size_t)(c0 + i) * 8192] = f2bf(S); S = fmaf(dd[i], S, uu[i]); }
    }
}
__device__ __forceinline__ void g3_unit(int u, const MkPtrs& P, bf16_t* MIXo, LAS unsigned char* lds) {
    const int tid = threadIdx.x, lane = tid & 63, wid = __builtin_amdgcn_readfirstlane(tid >> 6), r32 = lane & 31, hi = lane >> 5;
    const int bh = u >> 6, c = u & 63, b = bh >> 2, h = bh & 3, tok0 = b * SEQ + c * 64, d = tid & 63, tg = tid >> 6;
    float bv[8], blast;
    cum_gates(P.GLR, P.wup, P.bias, tok0, h, lds, bv, blast);
    {
        LAS bf16_t* qa = (LAS bf16_t*)(lds + L_A); LAS bf16_t* kb = (LAS bf16_t*)(lds + L_B);
#pragma unroll
        for (int i = 0; i < 8; ++i) {
            const int t = tg * 8 + i; const size_t g = (size_t)(tok0 + t) * 256 + h * 64 + d;
            qa[t * LP + d] = f2bf(bf2f(P.GQ[g]) * 0.125f * expf(bv[i]));
            kb[t * LP + d] = f2bf(bf2f(P.GK[g]) * expf(-bv[i]));
        }
    }
    stage_vT(P.GV, tok0, h, lds);
    __syncthreads();
    if (wid < 4) {
        const int ss = wid & 1, tt = wid >> 1;
        f32x16 acc;
#pragma unroll
        for (int i = 0; i < 16; ++i) acc[i] = 0.f;
        if (ss <= tt) {
#pragma unroll
            for (int s = 0; s < 4; ++s) {
                const bf16x8 af = *(const LAS bf16x8*)(lds + L_B + ((ss * 32 + r32) * LP + 16 * s + 8 * hi) * 2);
                const bf16x8 bf = *(const LAS bf16x8*)(lds + L_A + ((tt * 32 + r32) * LP + 16 * s + 8 * hi) * 2);
                acc = __builtin_amdgcn_mfma_f32_32x32x16_bf16(af, bf, acc, 0, 0, 0);
            }
        }
        const int t = tt * 32 + r32;
#pragma unroll
        for (int g = 0; g < 4; ++g) {
            float x[4];
#pragma unroll
            for (int e = 0; e < 4; ++e) { const int s = ss * 32 + 8 * g + 4 * hi + e; x[e] = (s <= t) ? acc[4 * g + e] : 0.f; }
            *(LAS u32x2*)(lds + L_A2 + (t * LP + ss * 32 + 8 * g + 4 * hi) * 2) = (u32x2){pk2(x[0], x[1]), pk2(x[2], x[3])};
        }
    }
    __syncthreads();
    const int ee = wid >> 1, tt = wid & 1;
    f32x16 o;
#pragma unroll
    for (int i = 0; i < 16; ++i) o[i] = 0.f;
    {
        const bf16_t* st = P.UT + ((size_t)u * 128 + ee * 32 + r32) * 64 + 8 * hi;
#pragma unroll
        for (int s = 0; s < 4; ++s) {
            const bf16x8 af = *(const bf16x8*)(st + 16 * s);
            const bf16x8 bf = *(const LAS bf16x8*)(lds + L_A + ((tt * 32 + r32) * LP + 16 * s + 8 * hi) * 2);
            o = __builtin_amdgcn_mfma_f32_32x32x16_bf16(af, bf, o, 0, 0, 0);
        }
#pragma unroll
        for (int s = 0; s < 4; ++s) {
            const bf16x8 af = *(const LAS bf16x8*)(lds + L_V + ((ee * 32 + r32) * LP + 16 * s + 8 * hi) * 2);
            const bf16x8 bf = *(const LAS bf16x8*)(lds + L_A2 + ((tt * 32 + r32) * LP + 16 * s + 8 * hi) * 2);
            o = __builtin_amdgcn_mfma_f32_32x32x16_bf16(af, bf, o, 0, 0, 0);
        }
    }
    float ssq = 0.f;
#pragma unroll
    for (int i = 0; i < 16; ++i) ssq = fmaf(o[i], o[i], ssq);
    ssq += __shfl_xor(ssq, 32);
    LAS float* red = (LAS float*)(lds + L_RED);
    const int t = tt * 32 + r32;
    if (hi == 0) red[ee * 64 + t] = ssq;
    __syncthreads();
    const float tot = (red[t] + red[64 + t]) + (red[128 + t] + red[192 + t]);
    const float rs = 1.0f / sqrtf(tot * (1.0f / 128.0f) + NORM_EPS);
    bf16_t* mrow = MIXo + (size_t)(tok0 + t) * 1024 + 512 + h * 128 + ee * 32 + 4 * hi;
    const float* gw = P.gnw + ee * 32 + 4 * hi;
#pragma unroll
    for (int g = 0; g < 4; ++g) {
        const u32x2 gg = *(const u32x2*)(mrow + 8 * g);
        const f32x4 w4 = *(const f32x4*)(gw + 8 * g);
        const float y0 = o[4 * g] * rs * w4[0] * __builtin_bit_cast(float, gg.x << 16), y1 = o[4 * g + 1] * rs * w4[1] * __builtin_bit_cast(float, gg.x & 0xffff0000u);
        const float y2 = o[4 * g + 2] * rs * w4[2] * __builtin_bit_cast(float, gg.y << 16), y3 = o[4 * g + 3] * rs * w4[3] * __builtin_bit_cast(float, gg.y & 0xffff0000u);
        *(u32x2*)(mrow + 8 * g) = (u32x2){pk2(y0, y1), pk2(y2, y3)};
    }
    __syncthreads();
}
}
constexpr int MK_LDS = 147456;
constexpr int N_PHASES = 9;
struct MkArgs { const float* x; const int* pos; const float* w_in; const float* wup; const float* bgate; const float* gnw; const float* w_out; const float* prew; const float* postw;
                float* out; unsigned char* ws; int ph_lo, ph_hi; };
__global__ void __launch_bounds__(512, 2) mk_fwd(MkArgs a) {
    extern __shared__ __attribute__((aligned(16))) unsigned char lds_raw[];
    LAS unsigned char* lds = (LAS unsigned char*)lds_raw;
    cg::grid_group grid = cg::this_grid();
    const int tid = threadIdx.x, lane = tid & 63, wave = __builtin_amdgcn_readfirstlane(tid >> 6);
    const int G = gridDim.x, bx = blockIdx.x;
    const int vcu = (G % 8 == 0) ? (bx % 8) * (G / 8) + bx / 8 : bx;
    unsigned char* ws = a.ws;
    const MkPtrs PT{(const float*)(ws + WS_GLR), a.wup, a.bgate, a.gnw, (const bf16_t*)(ws + WS_GQ), (const bf16_t*)(ws + WS_GK), (const bf16_t*)(ws + WS_GV),
                    (bf16_t*)(ws + WS_UT), (float*)(ws + WS_DV), (bf16_t*)(ws + WS_MIX)};
#define IN(k) (a.ph_lo <= (k) && (k) < a.ph_hi)
    volatile LAS unsigned* bst = (volatile LAS unsigned*)(lds + MK_LDS - 16);
    if (tid < 4) bst[tid] = 0u;
    __syncthreads();
    XcdBarrier xbar = xcd_barrier_post((unsigned*)(ws + WS_CTL) + CW_BAR, bst);
    if (a.ph_hi > 1000) grid.sync();
#ifndef MK_REPS
#define MK_REPS {1, 1, 1, 1, 1, 1, 1, 1, 1}
#endif
#ifndef MK_XSYNC
#define MK_XSYNC 0
#endif
    constexpr int REPS[N_PHASES] = MK_REPS;
    MkPtrs PTD = PT; PTD.UT = (bf16_t*)(ws + WS_DUMMY); PTD.MIX = (bf16_t*)(ws + WS_DUMMY);
#define SEAM(k) do { if (IN(k) && IN((k) + 1)) { xcd_barrier(xbar); for (int xs_ = 0; xs_ < MK_XSYNC; ++xs_) xcd_barrier(xbar); } } while (0)
    if (IN(0)) for (int rep = 0; rep < REPS[0]; ++rep) {
        LAS float* scr = (LAS float*)(lds + wave * 16384);
        const int gw = vcu * 8 + wave, NGW = G * 8;
        constexpr int I_W1 = 16 * (NF / 32), I_W2 = 16 * (DM / 32);
        for (int it = gw; it < I_W1 + I_W2; it += NGW) {
            if (it < I_W1) p0_transpose_item<true>(a.w_in, NPROJ, a.prew, (bf16_t*)(ws + WS_W1T), (bf16_t*)(ws + WS_W1L), scr, it, NF / 32, lane);
            else p0_transpose_item<false>(a.w_out, DM, nullptr, (bf16_t*)(ws + WS_W2T), nullptr, scr, it - I_W1, DM / 32, lane);
        }
        for (int row = gw; row < M; row += NGW) p0_row(a.x, a.pos, ws, row, lane);
    }
    SEAM(0);
    if (IN(1)) for (int rep = 0; rep < REPS[1]; ++rep) {
        ProbProj P{(const bf16_t*)(ws + WS_XH), (const bf16_t*)(ws + WS_XL), (const bf16_t*)(ws + WS_W1T), (const bf16_t*)(ws + WS_W1L)};
        SchedProj S{G, vcu};
        EpiProj E{ws};
        pg8::gemm_phase<EpiProj, SchedProj, ProbProj, true>(lds, P, S, E);
    }
    SEAM(1);
    if (IN(2)) for (int rep = 0; rep < REPS[2]; ++rep) { for (int u = vcu; u < gla::NUNITS; u += G) gla::g1_unit(u, PT, lds); }
    SEAM(2);
    if (IN(3)) for (int rep = 0; rep < REPS[3]; ++rep) { for (int it = vcu; it < 256; it += G) gla::g2_item(it, PT, rep ? PTD.UT : PT.UT); }
    SEAM(3);
    if (IN(4)) for (int rep = 0; rep < REPS[4]; ++rep) { for (int u = vcu; u < gla::NUNITS; u += G) gla::g3_unit(u, PT, rep ? PTD.MIX : PT.MIX, lds); }
    SEAM(4);
    if (IN(5)) for (int rep = 0; rep < REPS[5]; ++rep) sel::phase(ws, ws + WS_SC, lds, G, vcu);
    SEAM(5);
    if (IN(6)) for (int rep = 0; rep < REPS[6]; ++rep) {
        const attn_body::AttnTensors AT{(const attn_body::bf16*)(ws + WS_Q), (const attn_body::bf16*)(ws + WS_K), (const attn_body::bf16*)(ws + WS_V), (const unsigned*)(ws + WS_MASK), (attn_body::bf16*)(ws + (rep ? WS_DUMMY : WS_MIX))};
        const attn_body::StaticOrder S(G, vcu);
        attn_body::attn_phase<attn_body::StaticOrder>((char*)lds_raw, AT, S);
    }
    SEAM(6);
    if (IN(7)) for (int rep = 0; rep < REPS[7]; ++rep) {
        ProbOut P{(const bf16_t*)(ws + WS_MIX), (const bf16_t*)(ws + WS_W2T)};
        SchedOut S{G, vcu};
        EpiY E{(float*)(ws + WS_TMP)};
        pg8::gemm_phase<EpiY, SchedOut, ProbOut, false>(lds, P, S, E);
    }
    SEAM(7);
    if (IN(8)) for (int rep = 0; rep < REPS[8]; ++rep) {
        const int gw = vcu * 8 + wave, NGW = G * 8;
        for (int row = gw; row < M; row += NGW) p6_row(a.x, (const float*)(ws + WS_TMP), a.postw, a.out, row, lane);
    }
#undef IN
#undef SEAM
}

#ifndef MK_CUTS
#define MK_CUTS {0, 9}
#endif
extern "C" void kernel_launch(void* const* d_in, const int* in_sizes, int n_in, void* d_out, int out_size, void* d_ws, size_t ws_size, hipStream_t stream) {
    const float* x = (const float*)d_in[0]; const int* pos = (const int*)d_in[1]; const float* w_in = (const float*)d_in[2];
    const float* wup = (const float*)d_in[3]; const float* bgate = (const float*)d_in[4]; const float* gnw = (const float*)d_in[5];
    const float* w_out = (const float*)d_in[6]; const float* prew = (const float*)d_in[7]; const float* postw = (const float*)d_in[8];
    unsigned char* ws = (unsigned char*)d_ws; float* out = (float*)d_out;
    static int grid_blocks = 0;
    if (!grid_blocks) {
        int dev = 0, cus = 0, per_cu = 0;
        (void)hipGetDevice(&dev);
        (void)hipDeviceGetAttribute(&cus, hipDeviceAttributeMultiprocessorCount, dev);
        (void)hipFuncSetAttribute((const void*)mk_fwd, hipFuncAttributeMaxDynamicSharedMemorySize, MK_LDS);
        (void)hipOccupancyMaxActiveBlocksPerMultiprocessor(&per_cu, (const void*)mk_fwd, 512, MK_LDS);
        if (per_cu < 1) per_cu = 1;
        grid_blocks = cus * per_cu;
    }
    auto launch = [&](int lo, int hi) {
        MkArgs a{}; a.x = x; a.pos = pos; a.w_in = w_in; a.wup = wup; a.bgate = bgate; a.gnw = gnw; a.w_out = w_out; a.prew = prew; a.postw = postw;
        a.out = out; a.ws = ws; a.ph_lo = lo; a.ph_hi = hi;
        void* args[] = {&a};
        hipError_t e = hipLaunchCooperativeKernel((const void*)mk_fwd, dim3(grid_blocks), dim3(512), args, MK_LDS, stream);
        if (e != hipSuccess) fprintf(stderr, "cooperative launch [%d,%d) failed: %s (grid %d)\n", lo, hi, hipGetErrorString(e), grid_blocks);
    };
    (void)hipMemsetAsync(ws + WS_CTL, 0, CTL_ZERO_BYTES, stream);
    const int cuts[] = MK_CUTS;
    for (int i = 0; i + 1 < (int)(sizeof(cuts) / sizeof(cuts[0])); ++i) launch(cuts[i], cuts[i + 1]);
}
```

```cpp
#include <hip/hip_runtime.h>
#include <hip/hip_cooperative_groups.h>
#include <stdint.h>
#include <cstdio>
namespace cg = cooperative_groups;

constexpr int BATCH = 4, SEQ = 4096, M = BATCH * SEQ, DM = 1024, NPROJ = 3924;
constexpr int OFF_AQ = 0, OFF_AK = 512, OFF_AV = 1024, OFF_IQ = 1536, OFF_IK = 1792, OFF_IW = 1856, OFF_AG = 1860,
              OFF_GQ = 2372, OFF_GK = 2628, OFF_GV = 2884, OFF_GLR = 3396, OFF_GG = 3412;
constexpr int TOPK = 256;
constexpr float NORM_EPS = 1e-6f;
constexpr float C2 = 0.125f * 1.4426950408889634f;
constexpr int NF = 4096;

constexpr size_t MiB = 1u << 20;
constexpr size_t WS_CTL = 0, WS_RSTD = 1 * MiB, WS_ROPE = 2 * MiB, WS_W2T = 3 * MiB, WS_Q = 6 * MiB, WS_K = 22 * MiB, WS_V = 38 * MiB, WS_MIX = 54 * MiB,
                 WS_GQ = 86 * MiB, WS_GK = 94 * MiB, WS_GV = 102 * MiB, WS_IQH = 118 * MiB, WS_IQL = 126 * MiB, WS_IKH = 134 * MiB, WS_IKL = 136 * MiB, WS_IW = 138 * MiB, WS_GLR = 139 * MiB,
                 WS_MASK = 140 * MiB, WS_XH = 148 * MiB, WS_XL = 180 * MiB, WS_W1T = 212 * MiB, WS_W1L = 220 * MiB, WS_TMP = 148 * MiB, WS_SC = 148 * MiB, WS_UT = 148 * MiB, WS_DV = 166 * MiB, WS_DUMMY = 180 * MiB;

constexpr int CW_BAR = 4096;
constexpr size_t CTL_ZERO_BYTES = 65536;
typedef unsigned short bf16_t;
#define LAS __attribute__((address_space(3)))
__device__ __forceinline__ unsigned f2bf_u(float f) { unsigned u = __builtin_bit_cast(unsigned, f); return (u + 0x7fffu + ((u >> 16) & 1u)) >> 16; }
__device__ __forceinline__ bf16_t f2bf(float f) { return (bf16_t)f2bf_u(f); }
__device__ __forceinline__ float bf2f(bf16_t b) { return __builtin_bit_cast(float, (unsigned)b << 16); }
__device__ __forceinline__ unsigned pk2(float lo, float hi) { return f2bf_u(lo) | (f2bf_u(hi) << 16); }
__device__ __forceinline__ float wave_sum(float v) {
#pragma unroll
    for (int o = 1; o < 64; o <<= 1) v += __shfl_xor(v, o);
    return v;
}
__device__ __forceinline__ float silu(float x) { return x / (1.f + __expf(-x)); }
__device__ __forceinline__ int cmap(int n) {
    if (n < 512) return OFF_AQ + n;
    if (n < 1024) return OFF_AK + (n - 512);
    if (n < 1536) return OFF_AV + (n - 1024);
    if (n < 2048) return OFF_AG + (n - 1536);
    if (n < 2304) return OFF_GQ + (n - 2048);
    if (n < 2560) return OFF_GK + (n - 2304);
    if (n < 3072) return OFF_GV + (n - 2560);
    if (n < 3584) return OFF_GG + (n - 3072);
    if (n < 3840) return OFF_IQ + (n - 3584);
    const int l = n - 3840;
    if (l < 64) return OFF_IK + l;
    if (l < 68) return OFF_IW + (l - 64);
    if (l >= 72 && l < 88) return OFF_GLR + (l - 72);
    return -1;
}

struct MkPtrs { const float* GLR; const float* wup; const float* bias; const float* gnw; const bf16_t* GQ; const bf16_t* GK; const bf16_t* GV; bf16_t* UT; float* DV; bf16_t* MIX; };
#define XB_TMO      128
#define XB_XCNT(j)  (256  + 64 * (j))
#define XB_XSUB(j)  (1280 + 64 * (j))
#define XB_XGEN(j)  (2304 + 64 * (j))
#define XB_TOP      3328
#define XB_TOPGEN   3392
#define XCD_BAR_WORDS 3456
#define XB_SPIN_CAP (1u << 18)

__device__ __forceinline__ unsigned xb_ld(unsigned* p)              { return __hip_atomic_load(p, __ATOMIC_RELAXED, __HIP_MEMORY_SCOPE_AGENT); }
__device__ __forceinline__ unsigned xb_add(unsigned* p, unsigned v) { return __hip_atomic_fetch_add(p, v, __ATOMIC_RELAXED, __HIP_MEMORY_SCOPE_AGENT); }
__device__ __forceinline__ unsigned xb_xcc_id() { return (unsigned)__builtin_amdgcn_s_getreg((3 << 11) | 20) & 0xFu; }
#define XB_SPIN(cond, bar) do { unsigned _sp = 0; while (cond) { __builtin_amdgcn_s_sleep(1); \
    if ((++_sp & 255u) == 0u) { if (xb_ld(&(bar)[XB_TMO])) break; if (_sp > XB_SPIN_CAP) { atomicAdd(&(bar)[XB_TMO], 1u); break; } } } } while (0)

struct XcdBarrier {
    unsigned* bar; unsigned x;
    volatile LAS unsigned* st;
};

__device__ __forceinline__ XcdBarrier xcd_barrier_post(unsigned* bar, volatile LAS unsigned* st) {
    XcdBarrier b; b.bar = bar; b.x = xb_xcc_id(); b.st = st;
    if (threadIdx.x == 0) (void)xb_add(&bar[XB_XCNT(b.x)], 1u);
    return b;
}
__device__ __forceinline__ void xcd_barrier_complete(unsigned* bar, unsigned x, unsigned& nloc, unsigned& nx) {
    const unsigned G = gridDim.x * gridDim.y * gridDim.z;
    unsigned sum, cnt, mine, sp = 0u;
    for (;;) {
        sum = 0u; cnt = 0u; mine = 0u;
#pragma unroll
        for (unsigned j = 0; j < 16; ++j) { const unsigned c = xb_ld(&bar[XB_XCNT(j)]); sum += c; cnt += (c > 0u) ? 1u : 0u; mine = (j == x) ? c : mine; }
        if (sum == G) break;
        __builtin_amdgcn_s_sleep(1);
        if ((++sp & 255u) == 0u) { if (xb_ld(&bar[XB_TMO])) break; if (sp > XB_SPIN_CAP) { atomicAdd(&bar[XB_TMO], 1u); break; } }
    }
    nloc = mine > 0u ? mine : 1u; nx = cnt > 0u ? cnt : 1u;
}

__device__ __forceinline__ void xcd_barrier(const XcdBarrier& b) {
    asm volatile("s_waitcnt vmcnt(0)" ::: "memory");
    __syncthreads();
    if (threadIdx.x == 0) {
        unsigned* bar = b.bar;
        __builtin_amdgcn_s_waitcnt(0);
        unsigned nloc = b.st[0], nx = b.st[1];
        if (nloc == 0u) { xcd_barrier_complete(bar, b.x, nloc, nx); b.st[0] = nloc; b.st[1] = nx; }
        const unsigned old = xb_add(&bar[XB_XSUB(b.x)], 1u);
        const unsigned gen = old / nloc;
        if (old + 1u == (gen + 1u) * nloc) {
            __builtin_amdgcn_fence(__ATOMIC_RELEASE, "agent");
            asm volatile("s_waitcnt vmcnt(0)" ::: "memory");
            const unsigned og = xb_add(&bar[XB_TOP], 1u);
            const unsigned tg = og / nx;
            if (og + 1u == (tg + 1u) * nx) xb_add(&bar[XB_TOPGEN], 1u);
            else XB_SPIN(xb_ld(&bar[XB_TOPGEN]) == tg, bar);
            __builtin_amdgcn_fence(__ATOMIC_ACQUIRE, "agent");
            xb_add(&bar[XB_XGEN(b.x)], 1u);
            asm volatile("s_waitcnt vmcnt(0)" ::: "memory");
        } else {
            XB_SPIN(xb_ld(&bar[XB_XGEN(b.x)]) == gen, bar);
            __builtin_amdgcn_fence(__ATOMIC_ACQUIRE, "agent");
            asm volatile("s_waitcnt vmcnt(0)" ::: "memory");
        }
    }
    __syncthreads();
}
namespace pg8 {
typedef short bf16x8 __attribute__((ext_vector_type(8)));
typedef float f32x4 __attribute__((ext_vector_type(4)));
typedef unsigned u32x4 __attribute__((ext_vector_type(4)));
constexpr int BM = 256, BK = 64, HALF = 128, HTB = HALF * BK * 2, STAGE_BYTES = 8 * HTB, KP = 1024  ;
__host__ __device__ __forceinline__ int lds_byte(int r, int c) { const int st = (r >> 4) * 2 + (c >> 5), rr = r & 15, cc = c & 31, ob = rr * 64 + cc * 2; return st * 1024 + (ob ^ (((ob >> 9) & 1) << 5)); }
__host__ __device__ __forceinline__ void stage_rc(int b, int& R, int& C) { const int st = b / 1024, sb = b % 1024, swz = sb ^ (((sb >> 9) & 1) << 5); R = (st >> 1) * 16 + swz / 64; C = (st & 1) * 32 + (swz % 64) / 2; }
__host__ __device__ __forceinline__ int perm32(int rho) { const int n = rho >> 4, i = rho & 15; return 8 * (i >> 2) + 4 * n + (i & 3); }
struct Unit { int pm, pn, kind; };

template <class Epi, class Sched, class Prob, bool ALIGN_EPI>
__device__ __forceinline__ void gemm_phase(LAS unsigned char* lds, const Prob& P, const Sched& S, const Epi& E) {
    const int tid = threadIdx.x, wid = __builtin_amdgcn_readfirstlane(tid >> 6), lane = tid & 63, wr = wid >> 2, wc = wid & 3, fr = lane & 15, fq = lane >> 4;
    unsigned voffA[2], voffB[2];
#pragma unroll
    for (int i = 0; i < 2; ++i) { int R, C; stage_rc(tid * 16 + i * 8192, R, C); const int Rb = Epi::PERM ? ((R & ~31) + perm32(R & 31)) : R;
        voffA[i] = (unsigned)(R * KP + C) * 2u; voffB[i] = (unsigned)(Rb * KP + C) * 2u; }
    const size_t hstep = (size_t)HALF * KP * 2;
    const unsigned ldsw = (unsigned)wid * 1024u;
    const int aoff = lds_byte(wr * 64 + fr, fq * 8), boff = lds_byte(wc * 32 + fr, fq * 8);
#define PG8_SA(b, h) (((b) * 2 + (h)) * HTB)
#define PG8_SB(b, h) ((4 + (b) * 2 + (h)) * HTB)
#define PG8_STAGE(bufoff, gbase, voff) do { _Pragma("unroll") for (int _i = 0; _i < 2; ++_i) \
        __builtin_amdgcn_global_load_lds((const unsigned*)((const char*)(gbase) + (voff)[_i]), (LAS unsigned*)(lds + (bufoff) + ldsw + _i * 8192), 16, 0, 0); } while (0)
#define PG8_LDA(dst, b, h) do { _Pragma("unroll") for (int m = 0; m < 4; ++m) _Pragma("unroll") for (int k = 0; k < 2; ++k) dst[m][k] = *(const LAS bf16x8*)(lds + PG8_SA(b, h) + aoff + m * 2048 + k * 1024); } while (0)
#define PG8_LDB(dst, b, h) do { _Pragma("unroll") for (int n = 0; n < 2; ++n) _Pragma("unroll") for (int k = 0; k < 2; ++k) dst[n][k] = *(const LAS bf16x8*)(lds + PG8_SB(b, h) + boff + n * 2048 + k * 1024); } while (0)
#define PG8_MMA(ai, bj, At, Bt) do { __builtin_amdgcn_s_setprio(1); _Pragma("unroll") for (int m = 0; m < 4; ++m) _Pragma("unroll") for (int n = 0; n < 2; ++n) _Pragma("unroll") for (int k = 0; k < 2; ++k) \
        acc[ai][bj][m][n] = __builtin_amdgcn_mfma_f32_16x16x32_bf16(Bt[n][k], At[m][k], acc[ai][bj][m][n], 0, 0, 0); __builtin_amdgcn_s_setprio(0); } while (0)
#define PG8_WAIT_V(n) asm volatile("s_waitcnt vmcnt(" #n ")" ::: "memory")
#define PG8_WAIT_L(n) asm volatile("s_waitcnt lgkmcnt(" #n ")" ::: "memory")
#define PG8_BAR __builtin_amdgcn_s_barrier()
#define PG8_SCHED __builtin_amdgcn_sched_barrier(0)
    Unit cur, nxt; int ui = 0;
    if (!S.next(0, cur)) return;
    f32x4 acc[2][2][4][2];
#pragma unroll
    for (int a = 0; a < 2; ++a)
#pragma unroll
        for (int b = 0; b < 2; ++b)
#pragma unroll
            for (int m = 0; m < 4; ++m)
#pragma unroll
                for (int n = 0; n < 2; ++n) acc[a][b][m][n] = (f32x4){0.f, 0.f, 0.f, 0.f};
    bf16x8 At[4][2], B0[2][2], B1[2][2];
    {
        const char* a0 = P.a(cur, 0); const char* b0 = P.b(cur, 0); const char* a1 = P.a(cur, 1); const char* b1 = P.b(cur, 1);
        PG8_STAGE(PG8_SB(0, 0), b0, voffB); PG8_STAGE(PG8_SB(0, 1), b0 + hstep, voffB); PG8_STAGE(PG8_SA(0, 0), a0, voffA); PG8_STAGE(PG8_SA(0, 1), a0 + hstep, voffA);
        if (wr == 1) PG8_BAR;
        PG8_WAIT_V(2); PG8_BAR;
        PG8_STAGE(PG8_SB(1, 0), b1, voffB); PG8_STAGE(PG8_SA(1, 0), a1, voffA); PG8_STAGE(PG8_SB(1, 1), b1 + hstep, voffB);
        PG8_WAIT_V(6); PG8_BAR;
    }
    for (;;) {
        const bool has_next = S.next(ui + 1, nxt);
        const Unit nu = has_next ? nxt : cur;
        const int nt = P.nt(cur);
        for (int t = 0; t < nt; t += 2) {
            const bool last = (t == nt - 2);
            const char* a1 = P.a(cur, t + 1);
            const char* a2 = last ? P.a(nu, 0) : P.a(cur, t + 2); const char* b2 = last ? P.b(nu, 0) : P.b(cur, t + 2);
            const char* a3 = last ? P.a(nu, 1) : P.a(cur, t + 3); const char* b3 = last ? P.b(nu, 1) : P.b(cur, t + 3);
            PG8_LDB(B0, 0, 0); PG8_LDB(B1, 0, 1); PG8_SCHED; PG8_LDA(At, 0, 0); PG8_STAGE(PG8_SA(1, 1), a1 + hstep, voffA);
            PG8_WAIT_V(8); PG8_WAIT_L(0); PG8_BAR; PG8_MMA(0, 0, At, B0); PG8_MMA(0, 1, At, B1); PG8_BAR; PG8_SCHED;
            PG8_LDA(At, 0, 1); PG8_STAGE(PG8_SB(0, 0), b2, voffB); PG8_STAGE(PG8_SB(0, 1), b2 + hstep, voffB); PG8_STAGE(PG8_SA(0, 0), a2, voffA);
            PG8_WAIT_V(8); PG8_WAIT_L(0); PG8_BAR; PG8_MMA(1, 0, At, B0); PG8_MMA(1, 1, At, B1); PG8_BAR; PG8_SCHED;
            PG8_LDB(B0, 1, 0); PG8_LDB(B1, 1, 1); PG8_SCHED; PG8_LDA(At, 1, 0); PG8_STAGE(PG8_SA(0, 1), a2 + hstep, voffA);
            PG8_WAIT_V(8); PG8_WAIT_L(0); PG8_BAR; PG8_MMA(0, 0, At, B0); PG8_MMA(0, 1, At, B1); PG8_BAR; PG8_SCHED;
            PG8_LDA(At, 1, 1); PG8_STAGE(PG8_SB(1, 0), b3, voffB); PG8_STAGE(PG8_SB(1, 1), b3 + hstep, voffB); PG8_STAGE(PG8_SA(1, 0), a3, voffA);
            PG8_WAIT_V(8); PG8_WAIT_L(0); PG8_BAR; PG8_MMA(1, 0, At, B0); PG8_MMA(1, 1, At, B1); PG8_BAR; PG8_SCHED;
        }
        if constexpr (ALIGN_EPI) { if (wr == 0) PG8_BAR; }
        if constexpr (!Epi::AFTER_DRAIN) { E(acc, cur, wr, wc, fr, fq); }
        if (!has_next) break;
#pragma unroll
        for (int a = 0; a < 2; ++a)
#pragma unroll
            for (int b = 0; b < 2; ++b)
#pragma unroll
                for (int m = 0; m < 4; ++m)
#pragma unroll
                    for (int n = 0; n < 2; ++n) acc[a][b][m][n] = (f32x4){0.f, 0.f, 0.f, 0.f};
        cur = nxt; ++ui;
        if constexpr (ALIGN_EPI) { if (wr == 1) PG8_BAR; }
    }
    PG8_WAIT_V(0);
    if constexpr (!ALIGN_EPI) { if (wr == 0) PG8_BAR; }
    PG8_BAR;
    if constexpr (Epi::AFTER_DRAIN) { E.fused(acc, cur, wr, wc, fr, fq, lds, wid, lane); }
#undef PG8_SA
#undef PG8_SB
#undef PG8_STAGE
#undef PG8_LDA
#undef PG8_LDB
#undef PG8_MMA
#undef PG8_WAIT_V
#undef PG8_WAIT_L
#undef PG8_BAR
#undef PG8_SCHED
}
}
typedef float f32x4 __attribute__((ext_vector_type(4)));
typedef unsigned u32x4 __attribute__((ext_vector_type(4)));
typedef unsigned u32x2 __attribute__((ext_vector_type(2)));

struct ProbProj {
    const bf16_t *XH, *XL, *W1T, *W1L;
    __device__ __forceinline__ int nt(const pg8::Unit& u) const { return u.kind ? 48 : 16; }
    __device__ __forceinline__ const char* a(const pg8::Unit& u, int t) const {
        const bf16_t* base = (u.kind && t >= 16 && t < 32) ? XL : XH;
        return (const char*)(base + (size_t)u.pm * 256 * pg8::KP) + (size_t)(t & 15) * 128; }
    __device__ __forceinline__ const char* b(const pg8::Unit& u, int t) const {
        const bf16_t* base = (u.kind && t >= 32) ? (W1L + (size_t)(u.pn - 14) * 256 * pg8::KP) : (W1T + (size_t)u.pn * 256 * pg8::KP);
        return (const char*)base + (size_t)(t & 15) * 128; }
};
struct SchedProj {
    int G, c;
    __device__ __forceinline__ bool next(int i, pg8::Unit& u) const {
        if (G == 256) {
            const int role = c & 3; u.pm = c >> 2;
            if (role < 2) { if (i >= 3) return false; if (i == 0) { u.pn = 14 + role; u.kind = 1; } else { u.pn = role * 2 + (i - 1); u.kind = 0; } }
            else { if (i >= 5) return false; u.pn = 4 + (role - 2) * 5 + i; u.kind = 0; }
            return true;
        }
        const long L = (long)i * G + c; if (L >= 64 * 16) return false;
        const int pn = 15 - (int)(L / 64); u.pm = (int)(L % 64); u.pn = pn; u.kind = pn >= 14 ? 1 : 0; return true;
    }
};
__device__ __forceinline__ void split_store8(const f32x4& v0, const f32x4& v1, bf16_t* ph, bf16_t* pl) {
    u32x4 h; h.x = pk2(v0[0], v0[1]); h.y = pk2(v0[2], v0[3]); h.z = pk2(v1[0], v1[1]); h.w = pk2(v1[2], v1[3]);
    f32x4 l0, l1;
    l0[0] = v0[0] - __builtin_bit_cast(float, h.x << 16); l0[1] = v0[1] - __builtin_bit_cast(float, h.x & 0xffff0000u);
    l0[2] = v0[2] - __builtin_bit_cast(float, h.y << 16); l0[3] = v0[3] - __builtin_bit_cast(float, h.y & 0xffff0000u);
    l1[0] = v1[0] - __builtin_bit_cast(float, h.z << 16); l1[1] = v1[1] - __builtin_bit_cast(float, h.z & 0xffff0000u);
    l1[2] = v1[2] - __builtin_bit_cast(float, h.w << 16); l1[3] = v1[3] - __builtin_bit_cast(float, h.w & 0xffff0000u);
    u32x4 l; l.x = pk2(l0[0], l0[1]); l.y = pk2(l0[2], l0[3]); l.z = pk2(l1[0], l1[1]); l.w = pk2(l1[2], l1[3]);
    *(u32x4*)ph = h; *(u32x4*)pl = l;
}
struct EpiProj {
    static constexpr bool PERM = true, AFTER_DRAIN = false;
    unsigned char* ws;
    __device__ __forceinline__ void operator()(const f32x4 (&acc)[2][2][4][2], const pg8::Unit& u, int wr, int wc, int fr, int fq) const {
        const int pn = u.pn;
        const float* rstd = (const float*)(ws + WS_RSTD); const float* rope = (const float*)(ws + WS_ROPE);
        const bool rope_tile = (pn < 4) || (pn >= 14);
        const bool rope_wave = rope_tile && ((wc & 1) == 0);
        int mode, ld, coloff; unsigned char* base; float sc = 1.f;
        if (pn < 2)       { mode = 0; base = ws + WS_Q;   ld = 512;  coloff = pn * 256; sc = C2; }
        else if (pn < 4)  { mode = 0; base = ws + WS_K;   ld = 512;  coloff = (pn - 2) * 256; }
        else if (pn < 6)  { mode = 0; base = ws + WS_V;   ld = 512;  coloff = (pn - 4) * 256; }
        else if (pn < 8)  { mode = 1; base = ws + WS_MIX; ld = 1024; coloff = (pn - 6) * 256; }
        else if (pn == 8) { mode = 0; base = ws + WS_GQ;  ld = 256;  coloff = 0; }
        else if (pn == 9) { mode = 0; base = ws + WS_GK;  ld = 256;  coloff = 0; }
        else if (pn < 12) { mode = 0; base = ws + WS_GV;  ld = 512;  coloff = (pn - 10) * 256; }
        else if (pn < 14) { mode = 1; base = ws + WS_MIX; ld = 1024; coloff = 512 + (pn - 12) * 256; }
        else if (pn == 14){ mode = 2; base = ws + WS_IQH; ld = 256;  coloff = 0; }
        else              { mode = 3; base = ws + WS_IKH; ld = 64;   coloff = 0; }
        const int row0 = u.pm * 256 + wr * 64 + fr;
#pragma unroll
        for (int ai = 0; ai < 2; ++ai)
#pragma unroll
            for (int m = 0; m < 4; ++m) {
                const int row = row0 + ai * 128 + m * 16;
                const float r = rstd[row];
                f32x4 c_lo = {1.f, 1.f, 1.f, 1.f}, c_hi = c_lo, s_lo = {0.f, 0.f, 0.f, 0.f}, s_hi = s_lo;
                if (rope_wave) { const f32x4* rp = (const f32x4*)(rope + (size_t)row * 16); c_lo = rp[0]; c_hi = rp[1]; s_lo = rp[2]; s_hi = rp[3]; }
#pragma unroll
                for (int bj = 0; bj < 2; ++bj) {
                    f32x4 v0 = acc[ai][bj][m][0] * r, v1 = acc[ai][bj][m][1] * r;
                    if (rope_wave && (pn != 15 || (bj == 0 && wc == 0))) {
                        f32x4 p0, p1;
#pragma unroll
                        for (int j = 0; j < 4; ++j) { p0[j] = __shfl_xor(v0[j], 16); p1[j] = __shfl_xor(v1[j], 16); }
                        if (fq == 0) { v0 = v0 * c_lo - p0 * s_lo; v1 = v1 * c_hi - p1 * s_hi; }
                        else if (fq == 1) { v0 = v0 * c_lo + p0 * s_lo; v1 = v1 * c_hi + p1 * s_hi; }
                    }
                    const int c0 = bj * 128 + wc * 32 + 8 * fq;
                    if (mode == 0 || mode == 1) {
                        if (mode == 1) {
#pragma unroll
                            for (int j = 0; j < 4; ++j) { v0[j] = silu(v0[j]); v1[j] = silu(v1[j]); }
                        } else { v0 = v0 * sc; v1 = v1 * sc; }
                        u32x4 w; w.x = pk2(v0[0], v0[1]); w.y = pk2(v0[2], v0[3]); w.z = pk2(v1[0], v1[1]); w.w = pk2(v1[2], v1[3]);
                        *(u32x4*)((bf16_t*)base + (size_t)row * ld + coloff + c0) = w;
                    } else if (mode == 2) {
                        split_store8(v0, v1, (bf16_t*)(ws + WS_IQH) + (size_t)row * 256 + c0, (bf16_t*)(ws + WS_IQL) + (size_t)row * 256 + c0);
                    } else {
                        if (c0 < 64) split_store8(v0, v1, (bf16_t*)(ws + WS_IKH) + (size_t)row * 64 + c0, (bf16_t*)(ws + WS_IKL) + (size_t)row * 64 + c0);
                        else if (c0 == 64) { *(f32x4*)((float*)(ws + WS_IW) + (size_t)row * 4) = v0 * (0.5f * 0.125f); }
                        else if (c0 == 72) { float* p = (float*)(ws + WS_GLR) + (size_t)row * 16; *(f32x4*)p = v0; *(f32x4*)(p + 4) = v1; }
                        else if (c0 == 80) { float* p = (float*)(ws + WS_GLR) + (size_t)row * 16 + 8; *(f32x4*)p = v0; *(f32x4*)(p + 4) = v1; }
                    }
                }
            }
    }
};

template <bool MAPPED>
__device__ __forceinline__ void p0_transpose_item(const float* W, int Nsrc, const float* ksc, bf16_t* WT, bf16_t* WL, LAS float* scr, int item, int nblk, int lane) {
    const int kb = item / nblk, nb = item % nblk, k0 = 64 * kb, n0 = 32 * nb;
    const int srcc = MAPPED ? cmap(n0 + (lane & 31)) : (n0 + (lane & 31));
#pragma unroll 8
    for (int i = 0; i < 32; ++i) { const int kk = 2 * i + (lane >> 5);
        float v = W[(size_t)(k0 + kk) * Nsrc + (srcc < 0 ? 0 : srcc)]; if (MAPPED) v *= ksc[k0 + kk];
        scr[kk * 33 + (lane & 31)] = (srcc < 0) ? 0.f : v; }
    asm volatile("s_waitcnt lgkmcnt(0)" ::: "memory");
    const int c = lane & 7;
#pragma unroll
    for (int j = 0; j < 4; ++j) { const int n = (lane >> 3) + 8 * j; const LAS float* s = scr + (8 * c) * 33 + n;
        float v[8];
#pragma unroll
        for (int q = 0; q < 8; ++q) v[q] = s[q * 33];
        u32x4 o; o.x = pk2(v[0], v[1]); o.y = pk2(v[2], v[3]); o.z = pk2(v[4], v[5]); o.w = pk2(v[6], v[7]);
        *(u32x4*)(WT + (size_t)(n0 + n) * 1024 + k0 + 8 * c) = o;
        if (MAPPED && n0 >= 3584) {
            float l[8];
#pragma unroll
            for (int q = 0; q < 8; ++q) l[q] = v[q] - bf2f(f2bf(v[q]));
            u32x4 ol; ol.x = pk2(l[0], l[1]); ol.y = pk2(l[2], l[3]); ol.z = pk2(l[4], l[5]); ol.w = pk2(l[6], l[7]);
            *(u32x4*)(WL + (size_t)(n0 - 3584 + n) * 1024 + k0 + 8 * c) = ol;
        }
    }
    asm volatile("s_waitcnt lgkmcnt(0)" ::: "memory");
}
__device__ __forceinline__ void p0_row(const float* x, const int* pos, unsigned char* ws, int row, int lane) {
    const f32x4* xr = (const f32x4*)(x + (size_t)row * DM) + lane;
    f32x4 v[4]; float s = 0.f;
#pragma unroll
    for (int j = 0; j < 4; ++j) { v[j] = xr[64 * j]; s += (v[j][0] * v[j][0] + v[j][1] * v[j][1]) + (v[j][2] * v[j][2] + v[j][3] * v[j][3]); }
    s = wave_sum(s);
    u32x2* oh = (u32x2*)((bf16_t*)(ws + WS_XH) + (size_t)row * DM) + lane;
    u32x2* ol = (u32x2*)((bf16_t*)(ws + WS_XL) + (size_t)row * DM) + lane;
#pragma unroll
    for (int j = 0; j < 4; ++j) {
        u32x2 h; h.x = pk2(v[j][0], v[j][1]); h.y = pk2(v[j][2], v[j][3]);
        f32x4 l; l[0] = v[j][0] - __builtin_bit_cast(float, h.x << 16); l[1] = v[j][1] - __builtin_bit_cast(float, h.x & 0xffff0000u);
        l[2] = v[j][2] - __builtin_bit_cast(float, h.y << 16); l[3] = v[j][3] - __builtin_bit_cast(float, h.y & 0xffff0000u);
        u32x2 lo; lo.x = pk2(l[0], l[1]); lo.y = pk2(l[2], l[3]);
        oh[64 * j] = h; ol[64 * j] = lo;
    }
    if (lane == 0) ((float*)(ws + WS_RSTD))[row] = 1.0f / sqrtf(s * (1.0f / DM) + NORM_EPS);
    if (lane < 8) {
        const float inv = (float)pow(500000.0, -(double)lane / 8.0);
        const float ang = (float)pos[row] * inv;
        float* rope = (float*)(ws + WS_ROPE);
        rope[row * 16 + lane] = (float)cos((double)ang);
        rope[row * 16 + 8 + lane] = (float)sin((double)ang);
    }
}
struct ProbOut {
    const bf16_t *A, *Bt;
    __device__ __forceinline__ int nt(const pg8::Unit&) const { return 16; }
    __device__ __forceinline__ const char* a(const pg8::Unit& u, int t) const { return (const char*)(A + (size_t)u.pm * 256 * pg8::KP) + (size_t)(t & 15) * 128; }
    __device__ __forceinline__ const char* b(const pg8::Unit& u, int t) const { return (const char*)(Bt + (size_t)u.pn * 256 * pg8::KP) + (size_t)(t & 15) * 128; }
};
struct SchedOut {
    int G, c;
    __device__ __forceinline__ bool next(int i, pg8::Unit& u) const { const long L = (long)i * G + c; if (L >= 256) return false; u.pm = (int)(L >> 2); u.pn = (int)(L & 3); u.kind = 0; return true; }
};
struct EpiY {
    static constexpr bool PERM = false, AFTER_DRAIN = false;
    float* Y;
    __device__ __forceinline__ void operator()(const f32x4 (&acc)[2][2][4][2], const pg8::Unit& u, int wr, int wc, int fr, int fq) const {
        const int row0 = u.pm * 256 + wr * 64 + fr, col0 = u.pn * 256 + wc * 32 + 4 * fq;
#pragma unroll
        for (int ai = 0; ai < 2; ++ai)
#pragma unroll
            for (int m = 0; m < 4; ++m) { float* rowp = Y + (size_t)(row0 + ai * 128 + m * 16) * DM + col0;
#pragma unroll
                for (int bj = 0; bj < 2; ++bj)
#pragma unroll
                    for (int n = 0; n < 2; ++n) *(f32x4*)(rowp + bj * 128 + n * 16) = acc[ai][bj][m][n]; }
    }
};
__device__ __forceinline__ void p6_row(const float* x, const float* Y, const float* pw, float* out, int row, int lane) {
    const f32x4* yr = (const f32x4*)(Y + (size_t)row * DM) + lane;
    f32x4 v[4]; float s = 0.f;
#pragma unroll
    for (int j = 0; j < 4; ++j) { v[j] = yr[64 * j]; s += (v[j][0] * v[j][0] + v[j][1] * v[j][1]) + (v[j][2] * v[j][2] + v[j][3] * v[j][3]); }
    s = wave_sum(s);
    const float r = 1.0f / sqrtf(s * (1.0f / DM) + NORM_EPS);
#pragma unroll
    for (int j = 0; j < 4; ++j) {
        const f32x4 xv = ((const f32x4*)(x + (size_t)row * DM) + lane)[64 * j], w = ((const f32x4*)pw + lane)[64 * j];
        ((f32x4*)(out + (size_t)row * DM) + lane)[64 * j] = xv + v[j] * r * w;
    }
}
#include <hip/hip_bf16.h>
#include <cmath>
namespace attn_body {
using bf16=__hip_bfloat16;
using bf16x8=__attribute__((ext_vector_type(8)))short;
using s16x4=__attribute__((ext_vector_type(4)))short;
using f32x16=__attribute__((ext_vector_type(16)))float;
using u32x4=__attribute__((ext_vector_type(4)))unsigned;
constexpr int BATCH=4,NHEAD=8,SEQ=4096,D=64,DM=NHEAD*D,OPITCH=1024;
constexpr int NW=8,QBLK=32,QB=QBLK*NW,KVBLK=64,NQB=SEQ/QB;
constexpr int ATTN_PITCH=DM, ATTN_UNIT_ROWS=QB;
__device__ __forceinline__ int crow(int r,int hi){return (r&3)+8*(r>>2)+4*hi;}
#define SBAR() __builtin_amdgcn_sched_barrier(0)
__device__ __forceinline__ void cmask(f32x16&p0,f32x16&p1,int jb,int qrel,int hi){
  const float NEG=-INFINITY; int kb=64*jb+4*hi;
  #pragma unroll
  for(int r=0;r<16;++r){int kv=kb+(r&3)+8*(r>>2); if(kv>qrel)p0[r]=NEG; if(kv+32>qrel)p1[r]=NEG;}
}

constexpr int NSLOT=3, SLOTB=8192;
constexpr int LDS_K=0, LDS_V=NSLOT*SLOTB, LDS_WS=2*NSLOT*SLOTB, LDS_OST=LDS_WS+NW*64*4, LDS_MSK=LDS_OST+NW*4096, LDS_BYTES=LDS_MSK+NW*512;
constexpr float C2=0.125f*1.4426950408889634f;
__device__ __forceinline__ void glds16(const void*gsrc,unsigned lds_dst){unsigned keep;
  asm volatile("s_mov_b32 %0, m0\n\ts_mov_b32 m0, %2\n\ts_nop 0\n\tglobal_load_lds_dwordx4 %1, off\n\ts_mov_b32 m0, %0":"=&s"(keep):"v"(gsrc),"s"(lds_dst):"memory");}
__device__ __forceinline__ void glds4(const void*gsrc,unsigned lds_dst){unsigned keep;
  asm volatile("s_mov_b32 %0, m0\n\ts_mov_b32 m0, %2\n\ts_nop 0\n\tglobal_load_lds_dword %1, off\n\ts_mov_b32 m0, %0":"=&s"(keep):"v"(gsrc),"s"(lds_dst):"memory");}
__device__ __forceinline__ float max3f(float a,float b,float c){float r;asm("v_max3_f32 %0, %1, %2, %3":"=v"(r):"v"(a),"v"(b),"v"(c));return r;}
__device__ __forceinline__ float max2f(float a,float b){float r;asm("v_max_f32_e32 %0, %1, %2":"=v"(r):"v"(a),"v"(b));return r;}
__device__ __forceinline__ float fadd_s(float a,float b){float r;asm("v_add_f32_e32 %0, %1, %2":"=v"(r):"v"(a),"v"(b));return r;}
__device__ __forceinline__ float fsub_s(float a,float b){float r;asm("v_sub_f32_e32 %0, %1, %2":"=v"(r):"v"(a),"v"(b));return r;}
typedef float f32x2_t __attribute__((ext_vector_type(2))); typedef __bf16 bf16x2_t __attribute__((ext_vector_type(2)));
__device__ __forceinline__ unsigned cvtpk_s(float lo,float hi){f32x2_t v={lo,hi};bf16x2_t b=__builtin_convertvector(v,bf16x2_t);return __builtin_bit_cast(unsigned,b);}
#define WAIT_BAR(N) asm volatile("s_waitcnt vmcnt(" #N ") lgkmcnt(0)\n\ts_barrier":::"memory")

__device__ __forceinline__ void qkt(f32x16&p0,f32x16&p1,const char*Kslot,const bf16x8*qr,const f32x16&negm,int r32,int hi){
  const char*kb=Kslot+hi*1024+r32*16;
  #pragma unroll
  for(int d0=0;d0<4;++d0){
    const bf16x8 b0=*reinterpret_cast<const bf16x8*>(kb+d0*2048);
    const bf16x8 b1=*reinterpret_cast<const bf16x8*>(kb+d0*2048+512);
    if(d0==0){p0=__builtin_amdgcn_mfma_f32_32x32x16_bf16(b0,qr[0],negm,0,0,0);p1=__builtin_amdgcn_mfma_f32_32x32x16_bf16(b1,qr[0],negm,0,0,0);}
    else{p0=__builtin_amdgcn_mfma_f32_32x32x16_bf16(b0,qr[d0],p0,0,0,0);p1=__builtin_amdgcn_mfma_f32_32x32x16_bf16(b1,qr[d0],p1,0,0,0);}}
}
typedef __attribute__((address_space(3))) const char* lds_cptr;
typedef short v4i16_t __attribute__((ext_vector_type(4)));
__device__ __forceinline__ void kload8(bf16x8*kf,lds_cptr kp){
  kf[0]=*(const __attribute__((address_space(3))) bf16x8*)(kp);      kf[1]=*(const __attribute__((address_space(3))) bf16x8*)(kp+512);
  kf[2]=*(const __attribute__((address_space(3))) bf16x8*)(kp+2048); kf[3]=*(const __attribute__((address_space(3))) bf16x8*)(kp+2560);
  kf[4]=*(const __attribute__((address_space(3))) bf16x8*)(kp+4096); kf[5]=*(const __attribute__((address_space(3))) bf16x8*)(kp+4608);
  kf[6]=*(const __attribute__((address_space(3))) bf16x8*)(kp+6144); kf[7]=*(const __attribute__((address_space(3))) bf16x8*)(kp+6656);
}
__device__ __forceinline__ void kload2(bf16x8*kf,lds_cptr kp,int j){ kf[2*j]=*(const __attribute__((address_space(3))) bf16x8*)(kp+j*2048); kf[2*j+1]=*(const __attribute__((address_space(3))) bf16x8*)(kp+j*2048+512); }
__device__ __forceinline__ s16x4 vtr(lds_cptr p){ return __builtin_bit_cast(s16x4,__builtin_amdgcn_ds_read_tr16_b64_v4i16((__attribute__((address_space(3))) v4i16_t*)p)); }
__device__ __forceinline__ float rowmax(const f32x16&p0,const f32x16&p1){
  float a=max3f(p0[0],p0[1],p1[0]),b=max3f(p0[2],p0[3],p1[1]);a=max3f(a,p1[2],p1[3]);
  #pragma unroll
  for(int r=4;r<16;r+=4){a=max3f(a,p0[r],p0[r+1]);b=max3f(b,p0[r+2],p0[r+3]);a=max3f(a,p1[r],p1[r+1]);b=max3f(b,p1[r+2],p1[r+3]);}
  const float m=max2f(a,b);
  auto rr=__builtin_amdgcn_permlane32_swap(__float_as_uint(m),__float_as_uint(m),false,false);
  return max2f(__uint_as_float(rr[0]),__uint_as_float(rr[1]));
}
__device__ __forceinline__ void pv(f32x16*o,int vb,bf16x8 pa0,bf16x8 pa1,bf16x8 pa2,bf16x8 pa3){
  #pragma unroll
  for(int d0=0;d0<2;++d0){s16x4 lo[4],hi[4];
    #pragma unroll
    for(int ks=0;ks<4;++ks){
      asm volatile("ds_read_b64_tr_b16 %0,%1 offset:%c2":"=&v"(lo[ks]):"v"(vb),"i"(d0*4096+ks*1024):"memory");
      asm volatile("ds_read_b64_tr_b16 %0,%1 offset:%c2":"=&v"(hi[ks]):"v"(vb),"i"(d0*4096+ks*1024+512):"memory");}
    asm volatile("s_waitcnt lgkmcnt(0)":::"memory");SBAR();
    #define PK(k) (bf16x8){lo[k][0],lo[k][1],lo[k][2],lo[k][3],hi[k][0],hi[k][1],hi[k][2],hi[k][3]}
    o[d0]=__builtin_amdgcn_mfma_f32_32x32x16_bf16(pa0,PK(0),o[d0],0,0,0);
    o[d0]=__builtin_amdgcn_mfma_f32_32x32x16_bf16(pa1,PK(1),o[d0],0,0,0);
    o[d0]=__builtin_amdgcn_mfma_f32_32x32x16_bf16(pa2,PK(2),o[d0],0,0,0);
    o[d0]=__builtin_amdgcn_mfma_f32_32x32x16_bf16(pa3,PK(3),o[d0],0,0,0);
    #undef PK
  }
}

#ifndef ATTN_STORE16
#define ATTN_STORE16(p,v) (*(u32x4*)(p)=(v))
#endif
template<int THRL> __device__ __forceinline__ void attn_unit(int b,int h,int qb,const bf16*Q,const bf16*__restrict__ K,const bf16*__restrict__ V,const unsigned*__restrict__ MASK32,bf16*O,char*shm){
  const int tid=threadIdx.x,lane=tid&63,r32=lane&31,hi=lane>>5; const int wid=__builtin_amdgcn_readfirstlane(tid>>6);
  const long rowbase=(long)b*SEQ; const int q0=qb*QB;
  const bf16*Qw=Q+(rowbase+q0+wid*QBLK)*DM+h*D;
  const bf16*Kh=K+rowbase*DM+h*D,*Vh=V+rowbase*DM+h*D;
  const unsigned lds0=(unsigned)(uintptr_t)shm;
  float*wsf=(float*)(shm+LDS_WS)+wid*64;
  const bf16*ksrc=Kh+(long)lane*DM+wid*8;
  const bf16*vsrc=Vh+(long)(16*(wid&3)+(lane>>2))*DM+(wid>>2)*32+(lane&3)*8;
  const unsigned kdst=lds0+LDS_K+wid*1024, vdst=lds0+LDS_V+wid*1024;
  #define DMA_K(t,slot) glds16(ksrc+(long)(t)*KVBLK*DM,(unsigned)__builtin_amdgcn_readfirstlane(kdst+(slot)))
  #define DMA_V(t,slot) glds16(vsrc+(long)(t)*KVBLK*DM,(unsigned)__builtin_amdgcn_readfirstlane(vdst+(slot)))
  const unsigned*msrc=MASK32+(size_t)(rowbase+q0+wid*QBLK+(lane>>1))*128+(lane&1);
  const unsigned mdst=lds0+LDS_MSK+wid*512;
  #define DMA_M(t) glds4(msrc+2*(t),(unsigned)__builtin_amdgcn_readfirstlane(mdst+(((t)&1)<<8)))
  typedef __attribute__((address_space(3))) const unsigned long long* lds_u64p;
  #define MSK(v,W,b) __uint_as_float(__float_as_uint(v)&(unsigned)__builtin_amdgcn_sbfe((int)(W),(b),1))
  #define BP(B) (((B)&3)+8*((B)>>2))
  const int vb0=(int)(lds0+LDS_V)+((lane>>4)&1)*32+(lane&3)*8+(4*hi+((lane&15)>>2))*64;
  const char*Kbase=shm+LDS_K; bf16x8 kf[8];
  const lds_cptr shm3=(lds_cptr)shm; const lds_cptr kp0=shm3+LDS_K+hi*1024+r32*16; const lds_cptr vp0=shm3+LDS_V+((lane>>4)&1)*32+(lane&3)*8+(4*hi+((lane&15)>>2))*64;
  const lds_cptr mp0=shm3+LDS_MSK+wid*512+r32*8;
  const int NT=(q0+QB)/KVBLK;
  DMA_M(0);DMA_M(1);DMA_K(0,0);DMA_V(0,0);DMA_K(1,SLOTB);
  bf16x8 qr[4];
  #pragma unroll
  for(int d0=0;d0<4;++d0)qr[d0]=*reinterpret_cast<const bf16x8*>(&Qw[(long)r32*DM+d0*16+hi*8]);
  float mhat=0.f,l_reg=0.f;f32x16 o[2];o[0]=f32x16{};o[1]=f32x16{};f32x16 negm=f32x16{};asm volatile("":"+v"(negm));
  const int qrel=wid*QBLK+r32;
  #define CMASK(P0,P1,t) do{}while(0)
  bool resc=false;
  #define START(P0,P1) do{ const float rm=rowmax(P0,P1); resc=false; \
    { const float dl=rm; mhat=fadd_s(mhat,dl); \
      _Pragma("unroll") for(int r=0;r<16;++r){P0[r]=fsub_s(P0[r],dl);P1[r]=fsub_s(P1[r],dl);} \
      _Pragma("unroll") for(int r=0;r<16;++r)negm[r]=-mhat; asm volatile("":"+v"(negm)); } \
    _Pragma("unroll") for(int r=0;r<16;++r)P0[r]=__builtin_amdgcn_exp2f(P0[r]); }while(0)
  #define RESC() do{ if(resc){ asm volatile("s_waitcnt lgkmcnt(0)":::"memory"); \
      _Pragma("unroll") for(int d_=0;d_<2;++d_) _Pragma("unroll") for(int r=0;r<16;++r)o[d_][r]*=wsf[crow(r,hi)]; } }while(0)
  f32x16 pA0,pA1,pB0,pB1;
  int sl_prev=0,sl_cur=0,sl_next=SLOTB;
  #define ROT() do{sl_prev=sl_cur;sl_cur=sl_next;sl_next=(sl_next==(NSLOT-1)*SLOTB)?0:sl_next+SLOTB;}while(0)
  DMA_K(2,2*SLOTB);
  WAIT_BAR(3);
  qkt(pA0,pA1,Kbase,qr,negm,r32,hi);asm volatile("s_nop 15\n\ts_nop 7":"+v"(pA0),"+v"(pA1));
  START(pA0,pA1);
  _Pragma("unroll") for(int r=0;r<16;++r)pA1[r]=__builtin_amdgcn_exp2f(pA1[r]);
  { const unsigned long long mw_=*(lds_u64p)(mp0); const unsigned mwl_=(unsigned)mw_>>(4*hi), mwh_=(unsigned)(mw_>>32)>>(4*hi);
    _Pragma("unroll") for(int r=0;r<16;++r){pA0[r]=MSK(pA0[r],mwl_,BP(r));pA1[r]=MSK(pA1[r],mwh_,BP(r));} }
  WAIT_BAR(0);
  DMA_K(3,0);DMA_V(1,SLOTB);
  ROT();
  kload8(kf,kp0+sl_cur);
  WAIT_BAR(2);
  s16x4 vlo[8],vhi[8]; u32x4 pw0,pw1,pw2,pw3;
  #define PKW(P,B) cvtpk_s(P[B],P[B+1])
  #define PAF(k) __builtin_bit_cast(bf16x8,pw##k)
  #define VFR(i) (bf16x8){vlo[i][0],vlo[i][1],vlo[i][2],vlo[i][3],vhi[i][0],vhi[i][1],vhi[i][2],vhi[i][3]}
  #define PIN(x) asm volatile("":"+v"(x))
  #define MX3(a,b,c) __builtin_fmaxf(__builtin_fmaxf((a),(b)),(c))
  #define GAPA(MF,A0,A1,A2,A3,W0,W1,PW) do{ MF; sacc+=A0; sacc+=A1; sacc+=A2; sacc+=A3; PIN(sacc); W0; W1; PIN(PW); SBAR(); }while(0)
  #define EX(v) __builtin_amdgcn_exp2f(v)
  #define GAPB(MF,X,W,B) do{ MF; X[B]=MSK(EX(X[B]),W,BP(B)); X[B+1]=MSK(EX(X[B+1]),W,BP(B+1)); X[B+2]=MSK(EX(X[B+2]),W,BP(B+2)); X[B+3]=MSK(EX(X[B+3]),W,BP(B+3)); PIN(X); SBAR(); }while(0)
  #define VRD(i) do{ vlo[i]=vtr(vp_+(((i)>>2)*4096+((i)&3)*1024)); vhi[i]=vtr(vp_+(((i)>>2)*4096+((i)&3)*1024+512)); }while(0)
  #define KRD(G,j) do{ if(G){ kload2(kf,kp0+sl_next,j); SBAR(); } }while(0)
  #define STEP(C0,C1,P0,P1,t,GK,GV,GL) do{ SBAR(); \
    if(GV){DMA_M((t)+1);} \
    const unsigned long long mw_=*(lds_u64p)(mp0+(((t)&1)<<8)); const unsigned mwl_=(unsigned)mw_>>(4*hi), mwh_=(unsigned)(mw_>>32)>>(4*hi); \
    const lds_cptr vp_=vp0+sl_prev; \
    VRD(0); SBAR(); float sacc=(P0[0]+P0[1]); \
    GAPA(C0=__builtin_amdgcn_mfma_f32_32x32x16_bf16(kf[0],qr[0],negm,0,0,0), P0[2],P0[3],P0[4],P0[5],     pw0[0]=PKW(P0,0), pw0[1]=PKW(P0,2), pw0); \
    VRD(4); SBAR(); GAPA(C1=__builtin_amdgcn_mfma_f32_32x32x16_bf16(kf[1],qr[0],negm,0,0,0), P0[6],P0[7],P0[8],P0[9],     pw0[2]=PKW(P0,4), pw0[3]=PKW(P0,6), pw0); \
    VRD(1); SBAR(); GAPA(C0=__builtin_amdgcn_mfma_f32_32x32x16_bf16(kf[2],qr[1],C0,0,0,0),   P0[10],P0[11],P0[12],P0[13], pw1[0]=PKW(P0,8), pw1[1]=PKW(P0,10), pw1); \
    VRD(5); SBAR(); GAPA(C1=__builtin_amdgcn_mfma_f32_32x32x16_bf16(kf[3],qr[1],C1,0,0,0),   P0[14],P0[15],P1[0],P1[1],   pw1[2]=PKW(P0,12),pw1[3]=PKW(P0,14), pw1); \
    VRD(2); SBAR(); GAPA(C0=__builtin_amdgcn_mfma_f32_32x32x16_bf16(kf[4],qr[2],C0,0,0,0),   P1[2],P1[3],P1[4],P1[5],     pw2[0]=PKW(P1,0), pw2[1]=PKW(P1,2), pw2); \
    VRD(6); SBAR(); GAPA(C1=__builtin_amdgcn_mfma_f32_32x32x16_bf16(kf[5],qr[2],C1,0,0,0),   P1[6],P1[7],P1[8],P1[9],     pw2[2]=PKW(P1,4), pw2[3]=PKW(P1,6), pw2); \
    VRD(3); SBAR(); GAPA(C0=__builtin_amdgcn_mfma_f32_32x32x16_bf16(kf[6],qr[3],C0,0,0,0),   P1[10],P1[11],P1[12],P1[13], pw3[0]=PKW(P1,8), pw3[1]=PKW(P1,10), pw3); \
    VRD(7); SBAR(); GAPA(C1=__builtin_amdgcn_mfma_f32_32x32x16_bf16(kf[7],qr[3],C1,0,0,0),   P1[14],P1[15],0.f,0.f,       pw3[2]=PKW(P1,12),pw3[3]=PKW(P1,14), pw3); \
    l_reg+=sacc; \
    if(GK){DMA_K((t)+3,sl_cur);} if(GV){DMA_V((t)+1,sl_next);} \
    CMASK(C0,C1,t); \
    { float a=MX3(C0[0],C0[1],C1[0]),b=MX3(C0[2],C0[3],C1[1]); a=MX3(a,C1[2],C1[3]); \
      _Pragma("unroll") for(int r=4;r<16;r+=4){a=MX3(a,C0[r],C0[r+1]);b=MX3(b,C0[r+2],C0[r+3]);a=MX3(a,C1[r],C1[r+1]);b=MX3(b,C1[r+2],C1[r+3]);} \
      float rm=__builtin_fmaxf(a,b); { auto rr=__builtin_amdgcn_permlane32_swap(__float_as_uint(rm),__float_as_uint(rm),false,false); rm=__builtin_fmaxf(__uint_as_float(rr[0]),__uint_as_float(rr[1])); } \
      resc=false; \
      if(__builtin_expect(__any(rm>(float)THRL),0)){ const float dl=__builtin_fmaxf(rm,0.f); mhat+=dl; \
        _Pragma("unroll") for(int r=0;r<16;++r){C0[r]-=dl;C1[r]-=dl;} \
        _Pragma("unroll") for(int r=0;r<16;++r)negm[r]=-mhat; asm volatile("":"+v"(negm)); \
        const float f=__builtin_amdgcn_exp2f(-dl); l_reg*=f; if(hi==0)wsf[r32]=f; resc=true; } } \
    SBAR(); \
    GAPB(o[0]=__builtin_amdgcn_mfma_f32_32x32x16_bf16(PAF(0),VFR(0),o[0],0,0,0), C0,mwl_,0); \
    GAPB(o[1]=__builtin_amdgcn_mfma_f32_32x32x16_bf16(PAF(0),VFR(4),o[1],0,0,0), C0,mwl_,4); \
    KRD(GL,0); GAPB(o[0]=__builtin_amdgcn_mfma_f32_32x32x16_bf16(PAF(1),VFR(1),o[0],0,0,0), C0,mwl_,8); \
    KRD(GL,1); GAPB(o[1]=__builtin_amdgcn_mfma_f32_32x32x16_bf16(PAF(1),VFR(5),o[1],0,0,0), C0,mwl_,12); \
    KRD(GL,2); GAPB(o[0]=__builtin_amdgcn_mfma_f32_32x32x16_bf16(PAF(2),VFR(2),o[0],0,0,0), C1,mwh_,0); \
    KRD(GL,3); GAPB(o[1]=__builtin_amdgcn_mfma_f32_32x32x16_bf16(PAF(2),VFR(6),o[1],0,0,0), C1,mwh_,4); \
    GAPB(o[0]=__builtin_amdgcn_mfma_f32_32x32x16_bf16(PAF(3),VFR(3),o[0],0,0,0), C1,mwh_,8); \
    GAPB(o[1]=__builtin_amdgcn_mfma_f32_32x32x16_bf16(PAF(3),VFR(7),o[1],0,0,0), C1,mwh_,12); \
    }while(0)
  int t=1;
  #undef CMASK
  #define CMASK(P0,P1,t) do{}while(0)
  for(;t+5<NT;t+=2){
    STEP(pB0,pB1,pA0,pA1,t,true,true,true);     WAIT_BAR(2); RESC(); ROT();
    STEP(pA0,pA1,pB0,pB1,t+1,true,true,true);   WAIT_BAR(2); RESC(); ROT();
  }
  #undef CMASK
  #define CMASK(P0,P1,t) do{}while(0)
  #define ENDW(tt) do{ if((tt)+3<NT){WAIT_BAR(2);} else if((tt)+2<NT){WAIT_BAR(1);} else {WAIT_BAR(0);} }while(0)
  for(;t+1<NT;t+=2){
    STEP(pB0,pB1,pA0,pA1,t,(t+3<NT),(t+1<NT),(t+1<NT));       ENDW(t);   RESC(); ROT();
    STEP(pA0,pA1,pB0,pB1,t+1,(t+4<NT),(t+2<NT),(t+2<NT));     ENDW(t+1); RESC(); ROT();
  }
  STEP(pB0,pB1,pA0,pA1,NT-1,false,false,false); RESC();
  { float sacc=pB0[0]+pB0[1]; _Pragma("unroll") for(int r=2;r<16;++r)sacc+=pB0[r]; _Pragma("unroll") for(int r=0;r<16;++r)sacc+=pB1[r]; l_reg+=sacc;
    pw0=(u32x4){PKW(pB0,0),PKW(pB0,2),PKW(pB0,4),PKW(pB0,6)};pw1=(u32x4){PKW(pB0,8),PKW(pB0,10),PKW(pB0,12),PKW(pB0,14)};pw2=(u32x4){PKW(pB1,0),PKW(pB1,2),PKW(pB1,4),PKW(pB1,6)};pw3=(u32x4){PKW(pB1,8),PKW(pB1,10),PKW(pB1,12),PKW(pB1,14)};
    SBAR(); pv(o,vb0+sl_cur,PAF(0),PAF(1),PAF(2),PAF(3)); }
  #undef PKW
  #undef PAF
  #undef VFR
  #undef PIN
  #undef MX3
  #undef GAPA
  #undef GAPB
  #undef EX
  #undef VRD
  #undef KRD
  #undef STEP
  #undef ENDW
  {auto rr=__builtin_amdgcn_permlane32_swap(__float_as_uint(l_reg),__float_as_uint(l_reg),false,false);l_reg=__uint_as_float(rr[0])+__uint_as_float(rr[1]);}
  if(hi==0)wsf[32+r32]=l_reg;asm volatile("s_waitcnt lgkmcnt(0)":::"memory");
  float rli[16];
  #pragma unroll
  for(int r=0;r<16;++r)rli[r]=__builtin_amdgcn_rcpf(wsf[32+crow(r,hi)]);
  bf16*Ow=O+(rowbase+q0+wid*QBLK)*OPITCH+h*D;
  { bf16*stg=(bf16*)(shm+LDS_OST)+wid*2048;
    #pragma unroll
    for(int r=0;r<16;++r){const int orow=crow(r,hi);
      #pragma unroll
      for(int d0=0;d0<2;++d0)stg[orow*64+d0*32+r32]=__float2bfloat16(o[d0][r]*rli[r]);}
    asm volatile("s_waitcnt lgkmcnt(0)":::"memory");
    #pragma unroll
    for(int i=0;i<4;++i){const int row=i*8+(lane>>3),ch=lane&7; const u32x4 v=*(const u32x4*)(stg+row*64+ch*8); bf16*dst=Ow+(long)row*OPITCH+ch*8; const u32x4 g=*(const u32x4*)dst; u32x4 w;
      _Pragma("unroll") for(int e=0;e<4;++e){ const float a0=__uint_as_float(v[e]<<16),a1=__uint_as_float(v[e]&0xffff0000u),g0=__uint_as_float(g[e]<<16),g1=__uint_as_float(g[e]&0xffff0000u); w[e]=cvtpk_s(a0*g0,a1*g1); }
      *(u32x4*)dst=w;} }
  asm volatile("s_waitcnt lgkmcnt(0)\n\ts_barrier":::"memory");
  #undef DMA_K
  #undef DMA_V
  #undef DMA_M
  #undef MSK
  #undef BP
  #undef CMASK
  #undef START
  #undef RESC
  #undef ROT
}
constexpr int ATTN_LDS_BYTES=LDS_BYTES;
struct AttnTensors { const bf16* Q; const bf16* K; const bf16* V; const unsigned* MASK32; bf16* O; };
struct AttnUnit { int bh; int qb; };
struct StaticOrder {
  int vcu,G;
  __device__ __forceinline__ StaticOrder(int grid,int v):vcu(v),G(grid){}
  __device__ __forceinline__ bool next(int i,AttnUnit&u)const{
    if(G==256){ if(i>=2)return false; const int s=vcu&7; u.bh=vcu>>3; u.qb=(i==0)?15-s:s; return true; }
    const long L=(long)i*G+vcu; if(L>=BATCH*NHEAD*NQB)return false; u.qb=NQB-1-(int)(L/(BATCH*NHEAD)); u.bh=(int)(L%(BATCH*NHEAD)); return true; }
  __device__ __forceinline__ void a_ready(const AttnUnit&)const{}
  __device__ __forceinline__ void done(const AttnUnit&)const{}
};
template<class Sched,int THRL=8> __device__ __forceinline__ void attn_phase(char*lds,const AttnTensors&T,const Sched&S){
  AttnUnit u;
  for(int i=0;S.next(i,u);++i){ S.a_ready(u); attn_unit<THRL>(u.bh/NHEAD,u.bh%NHEAD,u.qb,T.Q,T.K,T.V,T.MASK32,T.O,lds); S.done(u); }
}
#undef SBAR
#undef WAIT_BAR
}
namespace sel {
typedef short bf16x8 __attribute__((ext_vector_type(8)));
typedef float f32x16 __attribute__((ext_vector_type(16)));
constexpr int QF_OFF = 0;
constexpr int HIST_OFF = 32768;
constexpr int NUNITS = BATCH * (SEQ / 32);
__device__ __forceinline__ unsigned mono(float f) { const unsigned u = __builtin_bit_cast(unsigned, f); return (u & 0x80000000u) ? ~u : (u | 0x80000000u); }
__device__ __forceinline__ void unit_of(int u, int& b, int& j) { j = (SEQ / 32 - 1) - (u >> 2); b = u & 3; }
__device__ __forceinline__ size_t scratch_bytes(int v) { return (size_t)4096 * (size_t)((SEQ / 32) - (v >> 2)); }

__device__ __forceinline__ void unit(int b, int j, unsigned char* ws, float* sc, LAS unsigned char* lds) {
    const int tid = threadIdx.x, lane = tid & 63, wid = __builtin_amdgcn_readfirstlane(tid >> 6), r32 = lane & 31, hi = lane >> 5;
    const int q0 = j * 32, row0 = b * SEQ + q0, nkt = j + 1;
    const bf16_t* IQH = (const bf16_t*)(ws + WS_IQH); const bf16_t* IQL = (const bf16_t*)(ws + WS_IQL);
    const bf16_t* IKH = (const bf16_t*)(ws + WS_IKH); const bf16_t* IKL = (const bf16_t*)(ws + WS_IKL);
#pragma unroll
    for (int i = 0; i < 2; ++i) {
        const int f = tid + 512 * i, h = f >> 8, s = (f >> 6) & 3, l = f & 63, r = l & 31, half = l >> 5;
        const size_t src = (size_t)(row0 + r) * 256 + h * 64 + 16 * s + 8 * half;
        const u32x4 vh = *(const u32x4*)(IQH + src), vl = *(const u32x4*)(IQL + src);
        *(LAS u32x4*)(lds + QF_OFF + ((h * 4 + s) * 2 + 0) * 1024 + l * 16) = vh;
        *(LAS u32x4*)(lds + QF_OFF + ((h * 4 + s) * 2 + 1) * 1024 + l * 16) = vl;
    }
    const f32x4 w = *(const f32x4*)((const float*)(ws + WS_IW) + (size_t)(row0 + r32) * 4);
    __syncthreads();
#ifndef SEL_REP_SCORE
#define SEL_REP_SCORE 1
#endif
#ifndef SEL_REP_SELECT
#define SEL_REP_SELECT 1
#endif
    for (int rep_ = 0; rep_ < SEL_REP_SCORE; ++rep_)
    for (int kt = wid; kt < nkt; kt += 8) {
        const size_t krow = (size_t)(b * SEQ + kt * 32 + r32) * 64 + 8 * hi;
        bf16x8 kh[4], kl[4];
#pragma unroll
        for (int s = 0; s < 4; ++s) { kh[s] = *(const bf16x8*)(IKH + krow + 16 * s); kl[s] = *(const bf16x8*)(IKL + krow + 16 * s); }
        f32x16 score;
#pragma unroll
        for (int i = 0; i < 16; ++i) score[i] = 0.f;
        int qoff = lane * 16; asm volatile("" : "+v"(qoff));
#pragma unroll
        for (int h = 0; h < 4; ++h) {
            f32x16 acc;
#pragma unroll
            for (int i = 0; i < 16; ++i) acc[i] = 0.f;
#pragma unroll
            for (int s = 0; s < 4; ++s) {
                const bf16x8 qh = *(const LAS bf16x8*)(lds + QF_OFF + ((h * 4 + s) * 2 + 0) * 1024 + qoff);
                const bf16x8 ql = *(const LAS bf16x8*)(lds + QF_OFF + ((h * 4 + s) * 2 + 1) * 1024 + qoff);
                acc = __builtin_amdgcn_mfma_f32_32x32x16_bf16(kh[s], qh, acc, 0, 0, 0);
                acc = __builtin_amdgcn_mfma_f32_32x32x16_bf16(kh[s], ql, acc, 0, 0, 0);
                acc = __builtin_amdgcn_mfma_f32_32x32x16_bf16(kl[s], qh, acc, 0, 0, 0);
            }
            const float wh = w[h];
#pragma unroll
            for (int i = 0; i < 16; ++i) score[i] += wh * fmaxf(acc[i], 0.f);
        }
        unsigned* dst = (unsigned*)sc + ((size_t)(kt * 32 + r32) * 32 + 4 * hi);
#pragma unroll
        for (int g = 0; g < 4; ++g) *(u32x4*)(dst + 8 * g) = (u32x4){mono(score[4 * g]), mono(score[4 * g + 1]), mono(score[4 * g + 2]), mono(score[4 * g + 3])};
    }
    asm volatile("s_waitcnt vmcnt(0)" ::: "memory");
    __syncthreads();
    LAS unsigned* hist = (LAS unsigned*)(lds + HIST_OFF + wid * 8192);
    unsigned pre[64];
#define SEL_LOAD_ROW(QQ, NJ) do { const unsigned* urow_ = (const unsigned*)sc + (size_t)(QQ) * 32 + hi * 1024 + r32; \
        _Pragma("unroll") for (int g_ = 0; g_ < 8; ++g_) { if (g_ * 8 < (NJ)) { _Pragma("unroll") for (int i_ = 0; i_ < 8; ++i_) pre[g_ * 8 + i_] = __builtin_nontemporal_load(urow_ + (size_t)(g_ * 8 + i_) * 2048); } } } while (0)
#define SEL_SCAN(NB, BIN) do { unsigned tot_ = 0u; \
        _Pragma("unroll") for (int i_ = 0; i_ < (NB) / 4; ++i_) { const u32x4 h_ = *(const LAS u32x4*)(hist + lane * (NB) + 4 * i_); tot_ += (h_.x + h_.y) + (h_.z + h_.w); } \
        unsigned suf_ = tot_; \
        _Pragma("unroll") for (int o_ = 1; o_ < 64; o_ <<= 1) { const unsigned v_ = __shfl_down(suf_, o_); if (lane + o_ < 64) suf_ += v_; } \
        const unsigned above_ = suf_ - tot_; \
        const unsigned long long fm_ = __ballot(above_ < kneed && kneed <= above_ + tot_); \
        const int L_ = (int)__builtin_ctzll(fm_ | (1ull << 63)); \
        kneed -= (unsigned)__builtin_amdgcn_readlane((int)above_, L_); \
        const unsigned cj_ = (lane < (NB)) ? hist[L_ * (NB) + lane] : 0u; \
        unsigned suf2_ = cj_; \
        _Pragma("unroll") for (int o_ = 1; o_ < 32; o_ <<= 1) { const unsigned v_ = __shfl_down(suf2_, o_); if (lane + o_ < 64) suf2_ += v_; } \
        const unsigned above2_ = suf2_ - cj_; \
        const unsigned long long fm2_ = __ballot(above2_ < kneed && kneed <= above2_ + cj_); \
        const int J_ = (int)__builtin_ctzll(fm2_ | (1ull << 63)); \
        kneed -= (unsigned)__builtin_amdgcn_readlane((int)above2_, J_); \
        cfin = (unsigned)__builtin_amdgcn_readlane((int)cj_, J_); \
        BIN = (unsigned)(L_ * (NB) + J_); } while (0)
#define SEL_ZERO(NW) do { _Pragma("unroll") for (int i_ = 0; i_ < (NW) / 256; ++i_) *(LAS u32x4*)(hist + (i_ * 64 + lane) * 4) = (u32x4){0u, 0u, 0u, 0u}; } while (0)
    for (int rep_ = 0; rep_ < SEL_REP_SELECT; ++rep_) {
    SEL_LOAD_ROW(wid * 4, ((q0 + wid * 4 + 1) + 63) >> 6);
#pragma unroll 1
    for (int qi = 0; qi < 4; ++qi) {
        const int qq = wid * 4 + qi, t = q0 + qq, n = t + 1, nj = (n + 63) >> 6;
        unsigned key[64];
#pragma unroll
        for (int g = 0; g < 8; ++g) {
            if (g * 8 < nj) {
#pragma unroll
                for (int i = 0; i < 8; ++i) { const int jj = g * 8 + i; key[jj] = (lane < n - 64 * jj) ? pre[jj] : 0u; }
            } else {
#pragma unroll
                for (int i = 0; i < 8; ++i) key[g * 8 + i] = 0u;
            }
        }
        if (qi < 3) SEL_LOAD_ROW(qq + 1, (n + 1 + 63) >> 6);
        unsigned thr = 1u; bool ties = false; int need = 0;
        if (n > TOPK) {
            unsigned kneed = TOPK, cfin = 0u, b1, b2, b3;
            SEL_ZERO(2048);
#pragma unroll
            for (int g = 0; g < 8; ++g) {
                if (g * 8 < nj) {
#pragma unroll
                    for (int i = 0; i < 8; ++i) __hip_atomic_fetch_add(hist + (key[g * 8 + i] >> 21), 1u, __ATOMIC_RELAXED, __HIP_MEMORY_SCOPE_WORKGROUP);
                }
            }
            asm volatile("s_waitcnt lgkmcnt(0)" ::: "memory");
            SEL_SCAN(32, b1);
            asm volatile("s_waitcnt lgkmcnt(0)" ::: "memory");
            const unsigned hb1 = b1 << 21;
            SEL_ZERO(2048);
#pragma unroll
            for (int g = 0; g < 8; ++g) {
                if (g * 8 < nj) {
#pragma unroll
                    for (int i = 0; i < 8; ++i) { const unsigned k = key[g * 8 + i];
                        if ((k ^ hb1) < 0x200000u) __hip_atomic_fetch_add(hist + ((k >> 10) & 2047u), 1u, __ATOMIC_RELAXED, __HIP_MEMORY_SCOPE_WORKGROUP); }
                }
            }
            asm volatile("s_waitcnt lgkmcnt(0)" ::: "memory");
            SEL_SCAN(32, b2);
            asm volatile("s_waitcnt lgkmcnt(0)" ::: "memory");
            const unsigned p22 = (b1 << 11) | b2, hp22 = p22 << 10;
            SEL_ZERO(1024);
#pragma unroll
            for (int g = 0; g < 8; ++g) {
                if (g * 8 < nj) {
#pragma unroll
                    for (int i = 0; i < 8; ++i) { const unsigned k = key[g * 8 + i];
                        if ((k ^ hp22) < 1024u) __hip_atomic_fetch_add(hist + (k & 1023u), 1u, __ATOMIC_RELAXED, __HIP_MEMORY_SCOPE_WORKGROUP); }
                }
            }
            asm volatile("s_waitcnt lgkmcnt(0)" ::: "memory");
            SEL_SCAN(16, b3);
            asm volatile("s_waitcnt lgkmcnt(0)" ::: "memory");
            thr = (p22 << 10) | b3; need = (int)kneed; ties = (cfin != kneed);
        }
        int mylo = 0, myhi = 0;
        if (!ties) {
#pragma unroll
            for (int g = 0; g < 8; ++g) {
                if (g * 8 < nj) {
#pragma unroll
                    for (int i = 0; i < 8; ++i) {
                        const unsigned long long bits = __ballot(key[g * 8 + i] >= thr);
                        asm volatile("s_nop 1\n\tv_writelane_b32 %0, %2, %4\n\tv_writelane_b32 %1, %3, %4" : "+v"(mylo), "+v"(myhi) : "s"((unsigned)bits), "s"((unsigned)(bits >> 32)), "n"(g * 8 + i));
                    }
                }
            }
        } else {
            int eqcnt = 0;
            const unsigned long long lt = (1ull << lane) - 1ull;
#pragma unroll
            for (int g = 0; g < 8; ++g) {
                if (g * 8 < nj) {
#pragma unroll
                    for (int i = 0; i < 8; ++i) {
                        const unsigned k = key[g * 8 + i];
                        const bool eq = (k == thr);
                        const unsigned long long meq = __ballot(eq);
                        const int rank = eqcnt + (int)__popcll(meq & lt);
                        const unsigned long long bits = __ballot(k > thr || (eq && rank < need));
                        eqcnt += (int)__popcll(meq);
                        asm volatile("s_nop 1\n\tv_writelane_b32 %0, %2, %4\n\tv_writelane_b32 %1, %3, %4" : "+v"(mylo), "+v"(myhi) : "s"((unsigned)bits), "s"((unsigned)(bits >> 32)), "n"(g * 8 + i));
                    }
                }
            }
        }
        ((unsigned long long*)(ws + WS_MASK))[(size_t)(row0 + qq) * 64 + lane] = ((unsigned long long)(unsigned)myhi << 32) | (unsigned long long)(unsigned)mylo;
    }
    }
#undef SEL_LOAD_ROW
#undef SEL_SCAN
#undef SEL_ZERO
    __syncthreads();
}

__device__ __forceinline__ void phase(unsigned char* ws, unsigned char* scbase, LAS unsigned char* lds, int G, int v) {
    const int GE = G < 256 ? G : 256;
    if (v >= GE) return;
    size_t off = 0;
    for (int i = 0; i < v; ++i) off += scratch_bytes(i);
    float* sc = (float*)(scbase + off);
    for (int r = 0;; ++r) {
        const int u = (r & 1) ? ((r + 1) * GE - 1 - v) : (r * GE + v);
        if (u >= NUNITS) break;
        int b, j; unit_of(u, b, j);
        unit(b, j, ws, sc, lds);
    }
}
}
namespace gla {
typedef short bf16x8 __attribute__((ext_vector_type(8)));
typedef float f32x16 __attribute__((ext_vector_type(16)));
constexpr int NUNITS = BATCH * 4 * (SEQ / 64);
constexpr int LP = 72;
constexpr int L_GLR = 0, L_WUP = 4096, L_GT = 8192, L_RED = 10240, L_A = 12288, L_B = L_A + 64 * LP * 2, L_V = L_B + 64 * LP * 2, L_A2 = L_V + 128 * LP * 2, L_END = L_A2 + 64 * LP * 2;
__device__ __forceinline__ int crow(int r, int hi) { return (r & 3) + 8 * (r >> 2) + 4 * hi; }

__device__ __forceinline__ void cum_gates(const float* GLR, const float* wup, const float* bias, int tok0, int h, LAS unsigned char* lds, float (&bv)[8], float& blast) {
    const int tid = threadIdx.x, d = tid & 63, tg = tid >> 6;
    LAS float* sg = (LAS float*)(lds + L_GLR); LAS float* sw = (LAS float*)(lds + L_WUP); LAS float* gt = (LAS float*)(lds + L_GT);
#pragma unroll
    for (int i = 0; i < 2; ++i) { const int e = tid + 512 * i; sg[e] = GLR[(size_t)tok0 * 16 + e]; sw[e] = wup[(e >> 6) * 256 + h * 64 + (e & 63)]; }
    __syncthreads();
    float wu[16];
#pragma unroll
    for (int r = 0; r < 16; ++r) wu[r] = sw[r * 64 + d];
    const float bi = bias[h * 64 + d];
    float run = 0.f;
#pragma unroll
    for (int i = 0; i < 8; ++i) {
        const int t = tg * 8 + i;
        float z = bi;
#pragma unroll
        for (int r = 0; r < 16; ++r) z = fmaf(sg[t * 16 + r], wu[r], z);
        const float ls = fminf(z, 0.f) - log1pf(expf(-fabsf(z)));
        run += ls * (1.0f / 16.0f);
        bv[i] = run;
    }
    gt[tg * 64 + d] = run;
    __syncthreads();
    float pre = 0.f, tot = 0.f;
#pragma unroll
    for (int g = 0; g < 8; ++g) { const float v = gt[g * 64 + d]; tot += v; if (g < tg) pre += v; }
#pragma unroll
    for (int i = 0; i < 8; ++i) bv[i] += pre;
    blast = tot;
}
__device__ __forceinline__ void stage_vT(const bf16_t* GV, int tok0, int h, LAS unsigned char* lds) {
    const int tid = threadIdx.x, e = tid & 127, tq = tid >> 7;
    unsigned pk[8];
#pragma unroll
    for (int i = 0; i < 8; ++i) {
        const unsigned lo = GV[(size_t)(tok0 + tq * 16 + 2 * i) * 512 + h * 128 + e], hi = GV[(size_t)(tok0 + tq * 16 + 2 * i + 1) * 512 + h * 128 + e];
        pk[i] = lo | (hi << 16);
    }
    LAS u32x4* dst = (LAS u32x4*)(lds + L_V + (e * LP + tq * 16) * 2);
    dst[0] = (u32x4){pk[0], pk[1], pk[2], pk[3]}; dst[1] = (u32x4){pk[4], pk[5], pk[6], pk[7]};
}

__device__ __forceinline__ void g1_unit(int u, const MkPtrs& P, LAS unsigned char* lds) {
    const int tid = threadIdx.x, lane = tid & 63, wid = __builtin_amdgcn_readfirstlane(tid >> 6), r32 = lane & 31, hi = lane >> 5;
    const int bh = u >> 6, c = u & 63, b = bh >> 2, h = bh & 3, tok0 = b * SEQ + c * 64, d = tid & 63, tg = tid >> 6;
    float bv[8], blast;
    cum_gates(P.GLR, P.wup, P.bias, tok0, h, lds, bv, blast);
    {
        float kl[8];
#pragma unroll
        for (int i = 0; i < 8; ++i) kl[i] = bf2f(P.GK[(size_t)(tok0 + tg * 8 + i) * 256 + h * 64 + d]) * expf(blast - bv[i]);
        *(LAS u32x4*)(lds + L_A + (d * LP + tg * 8) * 2) = (u32x4){pk2(kl[0], kl[1]), pk2(kl[2], kl[3]), pk2(kl[4], kl[5]), pk2(kl[6], kl[7])};
    }
    stage_vT(P.GV, tok0, h, lds);
    if (tid < 64) P.DV[(size_t)u * 64 + tid] = expf(blast);
    __syncthreads();
    {
        const int wd = wid & 1, we = wid >> 1;
        f32x16 acc;
#pragma unroll
        for (int i = 0; i < 16; ++i) acc[i] = 0.f;
#pragma unroll
        for (int s = 0; s < 4; ++s) {
            const bf16x8 af = *(const LAS bf16x8*)(lds + L_A + ((wd * 32 + r32) * LP + 16 * s + 8 * hi) * 2);
            const bf16x8 bf = *(const LAS bf16x8*)(lds + L_V + ((we * 32 + r32) * LP + 16 * s + 8 * hi) * 2);
            acc = __builtin_amdgcn_mfma_f32_32x32x16_bf16(af, bf, acc, 0, 0, 0);
        }
        bf16_t* dst = P.UT + ((size_t)u * 128 + we * 32 + r32) * 64 + wd * 32 + 4 * hi;
#pragma unroll
        for (int g = 0; g < 4; ++g) *(u32x2*)(dst + 8 * g) = (u32x2){pk2(acc[4 * g], acc[4 * g + 1]), pk2(acc[4 * g + 2], acc[4 * g + 3])};
    }
    __syncthreads();
}
__device__ __forceinline__ void g2_item(int item, const MkPtrs& P, bf16_t* STout) {
    const int tid = threadIdx.x, bh = item >> 4, idx = (item & 15) * 512 + tid, d = idx & 63;
    bf16_t* p = P.UT + (size_t)bh * 64 * 8192 + idx; const float* dvp = P.DV + (size_t)bh * 64 * 64 + d;
    bf16_t* po = STout + (size_t)bh * 64 * 8192 + idx;
    float S = 0.f;
#pragma unroll 1
    for (int c0 = 0; c0 < 64; c0 += 16) {
        float uu[16], dd[16];
#pragma unroll
        for (int i = 0; i < 16; ++i) { uu[i] = bf2f(p[(size_t)(c0 + i) * 8192]); dd[i] = dvp[(c0 + i) * 64]; }
        asm volatile("" ::: "memory");
#pragma unroll
        for (int i = 0; i < 16; ++i) { po[(size_t)(c0 + i) * 8192] = f2bf(S); S = fmaf(dd[i], S, uu[i]); }
    }
}
__device__ __forceinline__ void g3_unit(int u, const MkPtrs& P, bf16_t* MIXo, LAS unsigned char* lds) {
    const int tid = threadIdx.x, lane = tid & 63, wid = __builtin_amdgcn_readfirstlane(tid >> 6), r32 = lane & 31, hi = lane >> 5;
    const int bh = u >> 6, c = u & 63, b = bh >> 2, h = bh & 3, tok0 = b * SEQ + c * 64, d = tid & 63, tg = tid >> 6;
    float bv[8], blast;
    cum_gates(P.GLR, P.wup, P.bias, tok0, h, lds, bv, blast);
    {
        LAS bf16_t* qa = (LAS bf16_t*)(lds + L_A); LAS bf16_t* kb = (LAS bf16_t*)(lds + L_B);
#pragma unroll
        for (int i = 0; i < 8; ++i) {
            const int t = tg * 8 + i; const size_t g = (size_t)(tok0 + t) * 256 + h * 64 + d;
            qa[t * LP + d] = f2bf(bf2f(P.GQ[g]) * 0.125f * expf(bv[i]));
            kb[t * LP + d] = f2bf(bf2f(P.GK[g]) * expf(-bv[i]));
        }
    }
    stage_vT(P.GV, tok0, h, lds);
    __syncthreads();
    if (wid < 4) {
        const int ss = wid & 1, tt = wid >> 1;
        f32x16 acc;
#pragma unroll
        for (int i = 0; i < 16; ++i) acc[i] = 0.f;
        if (ss <= tt) {
#pragma unroll
            for (int s = 0; s < 4; ++s) {
                const bf16x8 af = *(const LAS bf16x8*)(lds + L_B + ((ss * 32 + r32) * LP + 16 * s + 8 * hi) * 2);
                const bf16x8 bf = *(const LAS bf16x8*)(lds + L_A + ((tt * 32 + r32) * LP + 16 * s + 8 * hi) * 2);
                acc = __builtin_amdgcn_mfma_f32_32x32x16_bf16(af, bf, acc, 0, 0, 0);
            }
        }
        const int t = tt * 32 + r32;
#pragma unroll
        for (int g = 0; g < 4; ++g) {
            float x[4];
#pragma unroll
            for (int e = 0; e < 4; ++e) { const int s = ss * 32 + 8 * g + 4 * hi + e; x[e] = (s <= t) ? acc[4 * g + e] : 0.f; }
            *(LAS u32x2*)(lds + L_A2 + (t * LP + ss * 32 + 8 * g + 4 * hi) * 2) = (u32x2){pk2(x[0], x[1]), pk2(x[2], x[3])};
        }
    }
    __syncthreads();
    const int ee = wid >> 1, tt = wid & 1;
    f32x16 o;
#pragma unroll
    for (int i = 0; i < 16; ++i) o[i] = 0.f;
    {
        const bf16_t* st = P.UT + ((size_t)u * 128 + ee * 32 + r32) * 64 + 8 * hi;
#pragma unroll
        for (int s = 0; s < 4; ++s) {
            const bf16x8 af = *(const bf16x8*)(st + 16 * s);
            const bf16x8 bf = *(const LAS bf16x8*)(lds + L_A + ((tt * 32 + r32) * LP + 16 * s + 8 * hi) * 2);
            o = __builtin_amdgcn_mfma_f32_32x32x16_bf16(af, bf, o, 0, 0, 0);
        }
#pragma unroll
        for (int s = 0; s < 4; ++s) {
            const bf16x8 af = *(const LAS bf16x8*)(lds + L_V + ((ee * 32 + r32) * LP + 16 * s + 8 * hi) * 2);
            const bf16x8 bf = *(const LAS bf16x8*)(lds + L_A2 + ((tt * 32 + r32) * LP + 16 * s + 8 * hi) * 2);
            o = __builtin_amdgcn_mfma_f32_32x32x16_bf16(af, bf, o, 0, 0, 0);
        }
    }
    float ssq = 0.f;
#pragma unroll
    for (int i = 0; i < 16; ++i) ssq = fmaf(o[i], o[i], ssq);
    ssq += __shfl_xor(ssq, 32);
    LAS float* red = (LAS float*)(lds + L_RED);
    const int t = tt * 32 + r32;
    if (hi == 0) red[ee * 64 + t] = ssq;
    __syncthreads();
    const float tot = (red[t] + red[64 + t]) + (red[128 + t] + red[192 + t]);
    const float rs = 1.0f / sqrtf(tot * (1.0f / 128.0f) + NORM_EPS);
    bf16_t* mrow = MIXo + (size_t)(tok0 + t) * 1024 + 512 + h * 128 + ee * 32 + 4 * hi;
    const float* gw = P.gnw + ee * 32 + 4 * hi;
#pragma unroll
    for (int g = 0; g < 4; ++g) {
        const u32x2 gg = *(const u32x2*)(mrow + 8 * g);
        const f32x4 w4 = *(const f32x4*)(gw + 8 * g);
        const float y0 = o[4 * g] * rs * w4[0] * __builtin_bit_cast(float, gg.x << 16), y1 = o[4 * g + 1] * rs * w4[1] * __builtin_bit_cast(float, gg.x & 0xffff0000u);
        const float y2 = o[4 * g + 2] * rs * w4[2] * __builtin_bit_cast(float, gg.y << 16), y3 = o[4 * g + 3] * rs * w4[3] * __builtin_bit_cast(float, gg.y & 0xffff0000u);
        *(u32x2*)(mrow + 8 * g) = (u32x2){pk2(y0, y1), pk2(y2, y3)};
    }
    __syncthreads();
}
}
constexpr int MK_LDS = 147456;
constexpr int N_PHASES = 9;
struct MkArgs { const float* x; const int* pos; const float* w_in; const float* wup; const float* bgate; const float* gnw; const float* w_out; const float* prew; const float* postw;
                float* out; unsigned char* ws; int ph_lo, ph_hi; };
__global__ void __launch_bounds__(512, 2) mk_fwd(MkArgs a) {
    extern __shared__ __attribute__((aligned(16))) unsigned char lds_raw[];
    LAS unsigned char* lds = (LAS unsigned char*)lds_raw;
    cg::grid_group grid = cg::this_grid();
    const int tid = threadIdx.x, lane = tid & 63, wave = __builtin_amdgcn_readfirstlane(tid >> 6);
    const int G = gridDim.x, bx = blockIdx.x;
    const int vcu = (G % 8 == 0) ? (bx % 8) * (G / 8) + bx / 8 : bx;
    unsigned char* ws = a.ws;
    const MkPtrs PT{(const float*)(ws + WS_GLR), a.wup, a.bgate, a.gnw, (const bf16_t*)(ws + WS_GQ), (const bf16_t*)(ws + WS_GK), (const bf16_t*)(ws + WS_GV),
                    (bf16_t*)(ws + WS_UT), (float*)(ws + WS_DV), (bf16_t*)(ws + WS_MIX)};
#define IN(k) (a.ph_lo <= (k) && (k) < a.ph_hi)
    volatile LAS unsigned* bst = (volatile LAS unsigned*)(lds + MK_LDS - 16);
    if (tid < 4) bst[tid] = 0u;
    __syncthreads();
    XcdBarrier xbar = xcd_barrier_post((unsigned*)(ws + WS_CTL) + CW_BAR, bst);
    if (a.ph_hi > 1000) grid.sync();
#ifndef MK_REPS
#define MK_REPS {1, 1, 1, 1, 1, 1, 1, 1, 1}
#endif
#ifndef MK_XSYNC
#define MK_XSYNC 0
#endif
    constexpr int REPS[N_PHASES] = MK_REPS;
    MkPtrs PTD = PT; PTD.UT = (bf16_t*)(ws + WS_DUMMY); PTD.MIX = (bf16_t*)(ws + WS_DUMMY);
#define SEAM(k) do { if (IN(k) && IN((k) + 1)) { xcd_barrier(xbar); for (int xs_ = 0; xs_ < MK_XSYNC; ++xs_) xcd_barrier(xbar); } } while (0)
    if (IN(0)) for (int rep = 0; rep < REPS[0]; ++rep) {
        LAS float* scr = (LAS float*)(lds + wave * 16384);
        const int gw = vcu * 8 + wave, NGW = G * 8;
        constexpr int I_W1 = 16 * (NF / 32), I_W2 = 16 * (DM / 32);
        for (int it = gw; it < I_W1 + I_W2; it += NGW) {
            if (it < I_W1) p0_transpose_item<true>(a.w_in, NPROJ, a.prew, (bf16_t*)(ws + WS_W1T), (bf16_t*)(ws + WS_W1L), scr, it, NF / 32, lane);
            else p0_transpose_item<false>(a.w_out, DM, nullptr, (bf16_t*)(ws + WS_W2T), nullptr, scr, it - I_W1, DM / 32, lane);
        }
        for (int row = gw; row < M; row += NGW) p0_row(a.x, a.pos, ws, row, lane);
    }
    SEAM(0);
    if (IN(1)) for (int rep = 0; rep < REPS[1]; ++rep) {
        ProbProj P{(const bf16_t*)(ws + WS_XH), (const bf16_t*)(ws + WS_XL), (const bf16_t*)(ws + WS_W1T), (const bf16_t*)(ws + WS_W1L)};
        SchedProj S{G, vcu};
        EpiProj E{ws};
        pg8::gemm_phase<EpiProj, SchedProj, ProbProj, true>(lds, P, S, E);
    }
    SEAM(1);
    if (IN(2)) for (int rep = 0; rep < REPS[2]; ++rep) { for (int u = vcu; u < gla::NUNITS; u += G) gla::g1_unit(u, PT, lds); }
    SEAM(2);
    if (IN(3)) for (int rep = 0; rep < REPS[3]; ++rep) { for (int it = vcu; it < 256; it += G) gla::g2_item(it, PT, rep ? PTD.UT : PT.UT); }
    SEAM(3);
    if (IN(4)) for (int rep = 0; rep < REPS[4]; ++rep) { for (int u = vcu; u < gla::NUNITS; u += G) gla::g3_unit(u, PT, rep ? PTD.MIX : PT.MIX, lds); }
    SEAM(4);
    if (IN(5)) for (int rep = 0; rep < REPS[5]; ++rep) sel::phase(ws, ws + WS_SC, lds, G, vcu);
    SEAM(5);
    if (IN(6)) for (int rep = 0; rep < REPS[6]; ++rep) {
        const attn_body::AttnTensors AT{(const attn_body::bf16*)(ws + WS_Q), (const attn_body::bf16*)(ws + WS_K), (const attn_body::bf16*)(ws + WS_V), (const unsigned*)(ws + WS_MASK), (attn_body::bf16*)(ws + (rep ? WS_DUMMY : WS_MIX))};
        const attn_body::StaticOrder S(G, vcu);
        attn_body::attn_phase<attn_body::StaticOrder>((char*)lds_raw, AT, S);
    }
    SEAM(6);
    if (IN(7)) for (int rep = 0; rep < REPS[7]; ++rep) {
        ProbOut P{(const bf16_t*)(ws + WS_MIX), (const bf16_t*)(ws + WS_W2T)};
        SchedOut S{G, vcu};
        EpiY E{(float*)(ws + WS_TMP)};
        pg8::gemm_phase<EpiY, SchedOut, ProbOut, false>(lds, P, S, E);
    }
    SEAM(7);
    if (IN(8)) for (int rep = 0; rep < REPS[8]; ++rep) {
        const int gw = vcu * 8 + wave, NGW = G * 8;
        for (int row = gw; row < M; row += NGW) p6_row(a.x, (const float*)(ws + WS_TMP), a.postw, a.out, row, lane);
    }
#undef IN
#undef SEAM
}

#ifndef MK_CUTS
#define MK_CUTS {0, 9}
#endif
extern "C" void kernel_launch(void* const* d_in, const int* in_sizes, int n_in, void* d_out, int out_size, void* d_ws, size_t ws_size, hipStream_t stream) {
    const float* x = (const float*)d_in[0]; const int* pos = (const int*)d_in[1]; const float* w_in = (const float*)d_in[2];
    const float* wup = (const float*)d_in[3]; const float* bgate = (const float*)d_in[4]; const float* gnw = (const float*)d_in[5];
    const float* w_out = (const float*)d_in[6]; const float* prew = (const float*)d_in[7]; const float* postw = (const float*)d_in[8];
    unsigned char* ws = (unsigned char*)d_ws; float* out = (float*)d_out;
    static int grid_blocks = 0;
    if (!grid_blocks) {
        int dev = 0, cus = 0, per_cu = 0;
        (void)hipGetDevice(&dev);
        (void)hipDeviceGetAttribute(&cus, hipDeviceAttributeMultiprocessorCount, dev);
        (void)hipFuncSetAttribute((const void*)mk_fwd, hipFuncAttributeMaxDynamicSharedMemorySize, MK_LDS);
        (void)hipOccupancyMaxActiveBlocksPerMultiprocessor(&per_cu, (const void*)mk_fwd, 512, MK_LDS);
        if (per_cu < 1) per_cu = 1;
        grid_blocks = cus * per_cu;
    }
    auto launch = [&](int lo, int hi) {
        MkArgs a{}; a.x = x; a.pos = pos; a.w_in = w_in; a.wup = wup; a.bgate = bgate; a.gnw = gnw; a.w_out = w_out; a.prew = prew; a.postw = postw;
        a.out = out; a.ws = ws; a.ph_lo = lo; a.ph_hi = hi;
        void* args[] = {&a};
        hipError_t e = hipLaunchCooperativeKernel((const void*)mk_fwd, dim3(grid_blocks), dim3(512), args, MK_LDS, stream);
        if (e != hipSuccess) fprintf(stderr, "cooperative launch [%d,%d) failed: %s (grid %d)\n", lo, hi, hipGetErrorString(e), grid_blocks);
    };
    (void)hipMemsetAsync(ws + WS_CTL, 0, CTL_ZERO_BYTES, stream);
    const int cuts[] = MK_CUTS;
    for (int i = 0; i + 1 < (int)(sizeof(cuts) / sizeof(cuts[0])); ++i) launch(cuts[i], cuts[i + 1]);
}
```

```cpp
#include <hip/hip_runtime.h>
#include <hip/hip_cooperative_groups.h>
#include <stdint.h>
#include <cstdio>
namespace cg = cooperative_groups;

constexpr int BATCH = 4, SEQ = 4096, M = BATCH * SEQ, DM = 1024, NPROJ = 3924;
constexpr int OFF_AQ = 0, OFF_AK = 512, OFF_AV = 1024, OFF_IQ = 1536, OFF_IK = 1792, OFF_IW = 1856, OFF_AG = 1860,
              OFF_GQ = 2372, OFF_GK = 2628, OFF_GV = 2884, OFF_GLR = 3396, OFF_GG = 3412;
constexpr int TOPK = 256;
constexpr float NORM_EPS = 1e-6f;
constexpr float C2 = 0.125f * 1.4426950408889634f;
constexpr int NF = 4096;

constexpr size_t MiB = 1u << 20;
constexpr size_t WS_CTL = 0, WS_RSTD = 1 * MiB, WS_ROPE = 2 * MiB, WS_W2T = 3 * MiB, WS_Q = 6 * MiB, WS_K = 22 * MiB, WS_V = 38 * MiB, WS_MIX = 54 * MiB,
                 WS_GQ = 86 * MiB, WS_GK = 94 * MiB, WS_GV = 102 * MiB, WS_IQH = 118 * MiB, WS_IQL = 126 * MiB, WS_IKH = 134 * MiB, WS_IKL = 136 * MiB, WS_IW = 138 * MiB, WS_GLR = 139 * MiB,
                 WS_MASK = 140 * MiB, WS_XH = 148 * MiB, WS_XL = 180 * MiB, WS_W1T = 212 * MiB, WS_W1L = 220 * MiB, WS_TMP = 148 * MiB, WS_SC = 148 * MiB, WS_UT = 148 * MiB, WS_DV = 166 * MiB, WS_DUMMY = 180 * MiB;

constexpr int CW_BAR = 4096;
constexpr size_t CTL_ZERO_BYTES = 65536;
typedef unsigned short bf16_t;
#define LAS __attribute__((address_space(3)))
__device__ __forceinline__ unsigned f2bf_u(float f) { unsigned u = __builtin_bit_cast(unsigned, f); return (u + 0x7fffu + ((u >> 16) & 1u)) >> 16; }
__device__ __forceinline__ bf16_t f2bf(float f) { return (bf16_t)f2bf_u(f); }
__device__ __forceinline__ float bf2f(bf16_t b) { return __builtin_bit_cast(float, (unsigned)b << 16); }
__device__ __forceinline__ unsigned pk2(float lo, float hi) { return f2bf_u(lo) | (f2bf_u(hi) << 16); }
__device__ __forceinline__ float wave_sum(float v) {
#pragma unroll
    for (int o = 1; o < 64; o <<= 1) v += __shfl_xor(v, o);
    return v;
}
__device__ __forceinline__ float silu(float x) { return x / (1.f + __expf(-x)); }
__device__ __forceinline__ int cmap(int n) {
    if (n < 512) return OFF_AQ + n;
    if (n < 1024) return OFF_AK + (n - 512);
    if (n < 1536) return OFF_AV + (n - 1024);
    if (n < 2048) return OFF_AG + (n - 1536);
    if (n < 2304) return OFF_GQ + (n - 2048);
    if (n < 2560) return OFF_GK + (n - 2304);
    if (n < 3072) return OFF_GV + (n - 2560);
    if (n < 3584) return OFF_GG + (n - 3072);
    if (n < 3840) return OFF_IQ + (n - 3584);
    const int l = n - 3840;
    if (l < 64) return OFF_IK + l;
    if (l < 68) return OFF_IW + (l - 64);
    if (l >= 72 && l < 88) return OFF_GLR + (l - 72);
    return -1;
}

struct MkPtrs { const float* GLR; const float* wup; const float* bias; const float* gnw; const bf16_t* GQ; const bf16_t* GK; const bf16_t* GV; bf16_t* UT; float* DV; bf16_t* MIX; };
#define XB_TMO      128
#define XB_XCNT(j)  (256  + 64 * (j))
#define XB_XSUB(j)  (1280 + 64 * (j))
#define XB_XGEN(j)  (2304 + 64 * (j))
#define XB_TOP      3328
#define XB_TOPGEN   3392
#define XCD_BAR_WORDS 3456
#define XB_SPIN_CAP (1u << 18)

__device__ __forceinline__ unsigned xb_ld(unsigned* p)              { return __hip_atomic_load(p, __ATOMIC_RELAXED, __HIP_MEMORY_SCOPE_AGENT); }
__device__ __forceinline__ unsigned xb_add(unsigned* p, unsigned v) { return __hip_atomic_fetch_add(p, v, __ATOMIC_RELAXED, __HIP_MEMORY_SCOPE_AGENT); }
__device__ __forceinline__ unsigned xb_xcc_id() { return (unsigned)__builtin_amdgcn_s_getreg((3 << 11) | 20) & 0xFu; }
#define XB_SPIN(cond, bar) do { unsigned _sp = 0; while (cond) { __builtin_amdgcn_s_sleep(1); \
    if ((++_sp & 255u) == 0u) { if (xb_ld(&(bar)[XB_TMO])) break; if (_sp > XB_SPIN_CAP) { atomicAdd(&(bar)[XB_TMO], 1u); break; } } } } while (0)

struct XcdBarrier {
    unsigned* bar; unsigned x;
    volatile LAS unsigned* st;
};

__device__ __forceinline__ XcdBarrier xcd_barrier_post(unsigned* bar, volatile LAS unsigned* st) {
    XcdBarrier b; b.bar = bar; b.x = xb_xcc_id(); b.st = st;
    if (threadIdx.x == 0) (void)xb_add(&bar[XB_XCNT(b.x)], 1u);
    return b;
}
__device__ __forceinline__ void xcd_barrier_complete(unsigned* bar, unsigned x, unsigned& nloc, unsigned& nx) {
    const unsigned G = gridDim.x * gridDim.y * gridDim.z;
    unsigned sum, cnt, mine, sp = 0u;
    for (;;) {
        sum = 0u; cnt = 0u; mine = 0u;
#pragma unroll
        for (unsigned j = 0; j < 16; ++j) { const unsigned c = xb_ld(&bar[XB_XCNT(j)]); sum += c; cnt += (c > 0u) ? 1u : 0u; mine = (j == x) ? c : mine; }
        if (sum == G) break;
        __builtin_amdgcn_s_sleep(1);
        if ((++sp & 255u) == 0u) { if (xb_ld(&bar[XB_TMO])) break; if (sp > XB_SPIN_CAP) { atomicAdd(&bar[XB_TMO], 1u); break; } }
    }
    nloc = mine > 0u ? mine : 1u; nx = cnt > 0u ? cnt : 1u;
}

__device__ __forceinline__ void xcd_barrier(const XcdBarrier& b) {
    asm volatile("s_waitcnt vmcnt(0)" ::: "memory");
    __syncthreads();
    if (threadIdx.x == 0) {
        unsigned* bar = b.bar;
        __builtin_amdgcn_s_waitcnt(0);
        unsigned nloc = b.st[0], nx = b.st[1];
        if (nloc == 0u) { xcd_barrier_complete(bar, b.x, nloc, nx); b.st[0] = nloc; b.st[1] = nx; }
        const unsigned old = xb_add(&bar[XB_XSUB(b.x)], 1u);
        const unsigned gen = old / nloc;
        if (old + 1u == (gen + 1u) * nloc) {
            __builtin_amdgcn_fence(__ATOMIC_RELEASE, "agent");
            asm volatile("s_waitcnt vmcnt(0)" ::: "memory");
            const unsigned og = xb_add(&bar[XB_TOP], 1u);
            const unsigned tg = og / nx;
            if (og + 1u == (tg + 1u) * nx) xb_add(&bar[XB_TOPGEN], 1u);
            else XB_SPIN(xb_ld(&bar[XB_TOPGEN]) == tg, bar);
            __builtin_amdgcn_fence(__ATOMIC_ACQUIRE, "agent");
            xb_add(&bar[XB_XGEN(b.x)], 1u);
            asm volatile("s_waitcnt vmcnt(0)" ::: "memory");
        } else {
            XB_SPIN(xb_ld(&bar[XB_XGEN(b.x)]) == gen, bar);
            __builtin_amdgcn_fence(__ATOMIC_ACQUIRE, "agent");
            asm volatile("s_waitcnt vmcnt(0)" ::: "memory");
        }
    }
    __syncthreads();
}
namespace pg8 {
typedef short bf16x8 __attribute__((ext_vector_type(8)));
typedef float f32x4 __attribute__((ext_vector_type(4)));
typedef unsigned u32x4 __attribute__((ext_vector_type(4)));
constexpr int BM = 256, BK = 64, HALF = 128, HTB = HALF * BK * 2, STAGE_BYTES = 8 * HTB, KP = 1024  ;
__host__ __device__ __forceinline__ int lds_byte(int r, int c) { const int st = (r >> 4) * 2 + (c >> 5), rr = r & 15, cc = c & 31, ob = rr * 64 + cc * 2; return st * 1024 + (ob ^ (((ob >> 9) & 1) << 5)); }
__host__ __device__ __forceinline__ void stage_rc(int b, int& R, int& C) { const int st = b / 1024, sb = b % 1024, swz = sb ^ (((sb >> 9) & 1) << 5); R = (st >> 1) * 16 + swz / 64; C = (st & 1) * 32 + (swz % 64) / 2; }
__host__ __device__ __forceinline__ int perm32(int rho) { const int n = rho >> 4, i = rho & 15; return 8 * (i >> 2) + 4 * n + (i & 3); }
struct Unit { int pm, pn, kind; };

template <class Epi, class Sched, class Prob, bool ALIGN_EPI>
__device__ __forceinline__ void gemm_phase(LAS unsigned char* lds, const Prob& P, const Sched& S, const Epi& E) {
    const int tid = threadIdx.x, wid = __builtin_amdgcn_readfirstlane(tid >> 6), lane = tid & 63, wr = wid >> 2, wc = wid & 3, fr = lane & 15, fq = lane >> 4;
    unsigned voffA[2], voffB[2];
#pragma unroll
    for (int i = 0; i < 2; ++i) { int R, C; stage_rc(tid * 16 + i * 8192, R, C); const int Rb = Epi::PERM ? ((R & ~31) + perm32(R & 31)) : R;
        voffA[i] = (unsigned)(R * KP + C) * 2u; voffB[i] = (unsigned)(Rb * KP + C) * 2u; }
    const size_t hstep = (size_t)HALF * KP * 2;
    const unsigned ldsw = (unsigned)wid * 1024u;
    const int aoff = lds_byte(wr * 64 + fr, fq * 8), boff = lds_byte(wc * 32 + fr, fq * 8);
#define PG8_SA(b, h) (((b) * 2 + (h)) * HTB)
#define PG8_SB(b, h) ((4 + (b) * 2 + (h)) * HTB)
#define PG8_STAGE(bufoff, gbase, voff) do { _Pragma("unroll") for (int _i = 0; _i < 2; ++_i) \
        __builtin_amdgcn_global_load_lds((const unsigned*)((const char*)(gbase) + (voff)[_i]), (LAS unsigned*)(lds + (bufoff) + ldsw + _i * 8192), 16, 0, 0); } while (0)
#define PG8_LDA(dst, b, h) do { _Pragma("unroll") for (int m = 0; m < 4; ++m) _Pragma("unroll") for (int k = 0; k < 2; ++k) dst[m][k] = *(const LAS bf16x8*)(lds + PG8_SA(b, h) + aoff + m * 2048 + k * 1024); } while (0)
#define PG8_LDB(dst, b, h) do { _Pragma("unroll") for (int n = 0; n < 2; ++n) _Pragma("unroll") for (int k = 0; k < 2; ++k) dst[n][k] = *(const LAS bf16x8*)(lds + PG8_SB(b, h) + boff + n * 2048 + k * 1024); } while (0)
#define PG8_MMA(ai, bj, At, Bt) do { __builtin_amdgcn_s_setprio(1); _Pragma("unroll") for (int m = 0; m < 4; ++m) _Pragma("unroll") for (int n = 0; n < 2; ++n) _Pragma("unroll") for (int k = 0; k < 2; ++k) \
        acc[ai][bj][m][n] = __builtin_amdgcn_mfma_f32_16x16x32_bf16(Bt[n][k], At[m][k], acc[ai][bj][m][n], 0, 0, 0); __builtin_amdgcn_s_setprio(0); } while (0)
#define PG8_WAIT_V(n) asm volatile("s_waitcnt vmcnt(" #n ")" ::: "memory")
#define PG8_WAIT_L(n) asm volatile("s_waitcnt lgkmcnt(" #n ")" ::: "memory")
#define PG8_BAR __builtin_amdgcn_s_barrier()
#define PG8_SCHED __builtin_amdgcn_sched_barrier(0)
    Unit cur, nxt; int ui = 0;
    if (!S.next(0, cur)) return;
    f32x4 acc[2][2][4][2];
#pragma unroll
    for (int a = 0; a < 2; ++a)
#pragma unroll
        for (int b = 0; b < 2; ++b)
#pragma unroll
            for (int m = 0; m < 4; ++m)
#pragma unroll
                for (int n = 0; n < 2; ++n) acc[a][b][m][n] = (f32x4){0.f, 0.f, 0.f, 0.f};
    bf16x8 At[4][2], B0[2][2], B1[2][2];
    {
        const char* a0 = P.a(cur, 0); const char* b0 = P.b(cur, 0); const char* a1 = P.a(cur, 1); const char* b1 = P.b(cur, 1);
        PG8_STAGE(PG8_SB(0, 0), b0, voffB); PG8_STAGE(PG8_SB(0, 1), b0 + hstep, voffB); PG8_STAGE(PG8_SA(0, 0), a0, voffA); PG8_STAGE(PG8_SA(0, 1), a0 + hstep, voffA);
        if (wr == 1) PG8_BAR;
        PG8_WAIT_V(2); PG8_BAR;
        PG8_STAGE(PG8_SB(1, 0), b1, voffB); PG8_STAGE(PG8_SA(1, 0), a1, voffA); PG8_STAGE(PG8_SB(1, 1), b1 + hstep, voffB);
        PG8_WAIT_V(6); PG8_BAR;
    }
    for (;;) {
        const bool has_next = S.next(ui + 1, nxt);
        const Unit nu = has_next ? nxt : cur;
        const int nt = P.nt(cur);
        for (int t = 0; t < nt; t += 2) {
            const bool last = (t == nt - 2);
            const char* a1 = P.a(cur, t + 1);
            const char* a2 = last ? P.a(nu, 0) : P.a(cur, t + 2); const char* b2 = last ? P.b(nu, 0) : P.b(cur, t + 2);
            const char* a3 = last ? P.a(nu, 1) : P.a(cur, t + 3); const char* b3 = last ? P.b(nu, 1) : P.b(cur, t + 3);
            PG8_LDB(B0, 0, 0); PG8_LDB(B1, 0, 1); PG8_SCHED; PG8_LDA(At, 0, 0); PG8_STAGE(PG8_SA(1, 1), a1 + hstep, voffA);
            PG8_WAIT_V(8); PG8_WAIT_L(0); PG8_BAR; PG8_MMA(0, 0, At, B0); PG8_MMA(0, 1, At, B1); PG8_BAR; PG8_SCHED;
            PG8_LDA(At, 0, 1); PG8_STAGE(PG8_SB(0, 0), b2, voffB); PG8_STAGE(PG8_SB(0, 1), b2 + hstep, voffB); PG8_STAGE(PG8_SA(0, 0), a2, voffA);
            PG8_WAIT_V(8); PG8_WAIT_L(0); PG8_BAR; PG8_MMA(1, 0, At, B0); PG8_MMA(1, 1, At, B1); PG8_BAR; PG8_SCHED;
            PG8_LDB(B0, 1, 0); PG8_LDB(B1, 1, 1); PG8_SCHED; PG8_LDA(At, 1, 0); PG8_STAGE(PG8_SA(0, 1), a2 + hstep, voffA);
            PG8_WAIT_V(8); PG8_WAIT_L(0); PG8_BAR; PG8_MMA(0, 0, At, B0); PG8_MMA(0, 1, At, B1); PG8_BAR; PG8_SCHED;
            PG8_LDA(At, 1, 1); PG8_STAGE(PG8_SB(1, 0), b3, voffB); PG8_STAGE(PG8_SB(1, 1), b3 + hstep, voffB); PG8_STAGE(PG8_SA(1, 0), a3, voffA);
            PG8_WAIT_V(8); PG8_WAIT_L(0); PG8_BAR; PG8_MMA(1, 0, At, B0); PG8_MMA(1, 1, At, B1); PG8_BAR; PG8_SCHED;
        }
        if constexpr (ALIGN_EPI) { if (wr == 0) PG8_BAR; }
        if constexpr (!Epi::AFTER_DRAIN) { E(acc, cur, wr, wc, fr, fq); }
        if (!has_next) break;
#pragma unroll
        for (int a = 0; a < 2; ++a)
#pragma unroll
            for (int b = 0; b < 2; ++b)
#pragma unroll
                for (int m = 0; m < 4; ++m)
#pragma unroll
                    for (int n = 0; n < 2; ++n) acc[a][b][m][n] = (f32x4){0.f, 0.f, 0.f, 0.f};
        cur = nxt; ++ui;
        if constexpr (ALIGN_EPI) { if (wr == 1) PG8_BAR; }
    }
    PG8_WAIT_V(0);
    if constexpr (!ALIGN_EPI) { if (wr == 0) PG8_BAR; }
    PG8_BAR;
    if constexpr (Epi::AFTER_DRAIN) { E.fused(acc, cur, wr, wc, fr, fq, lds, wid, lane); }
#undef PG8_SA
#undef PG8_SB
#undef PG8_STAGE
#undef PG8_LDA
#undef PG8_LDB
#undef PG8_MMA
#undef PG8_WAIT_V
#undef PG8_WAIT_L
#undef PG8_BAR
#undef PG8_SCHED
}
}
typedef float f32x4 __attribute__((ext_vector_type(4)));
typedef unsigned u32x4 __attribute__((ext_vector_type(4)));
typedef unsigned u32x2 __attribute__((ext_vector_type(2)));

struct ProbProj {
    const bf16_t *XH, *XL, *W1T, *W1L;
    __device__ __forceinline__ int nt(const pg8::Unit& u) const { return u.kind ? 48 : 16; }
    __device__ __forceinline__ const char* a(const pg8::Unit& u, int t) const {
        const bf16_t* base = (u.kind && t >= 16 && t < 32) ? XL : XH;
        return (const char*)(base + (size_t)u.pm * 256 * pg8::KP) + (size_t)(t & 15) * 128; }
    __device__ __forceinline__ const char* b(const pg8::Unit& u, int t) const {
        const bf16_t* base = (u.kind && t >= 32) ? (W1L + (size_t)(u.pn - 14) * 256 * pg8::KP) : (W1T + (size_t)u.pn * 256 * pg8::KP);
        return (const char*)base + (size_t)(t & 15) * 128; }
};
struct SchedProj {
    int G, c;
    __device__ __forceinline__ bool next(int i, pg8::Unit& u) const {
        if (G == 256) {
            const int role = c & 3; u.pm = c >> 2;
            if (role < 2) { if (i >= 3) return false; if (i == 0) { u.pn = 14 + role; u.kind = 1; } else { u.pn = role * 2 + (i - 1); u.kind = 0; } }
            else { if (i >= 5) return false; u.pn = 4 + (role - 2) * 5 + i; u.kind = 0; }
            return true;
        }
        const long L = (long)i * G + c; if (L >= 64 * 16) return false;
        const int pn = 15 - (int)(L / 64); u.pm = (int)(L % 64); u.pn = pn; u.kind = pn >= 14 ? 1 : 0; return true;
    }
};
__device__ __forceinline__ void split_store8(const f32x4& v0, const f32x4& v1, bf16_t* ph, bf16_t* pl) {
    u32x4 h; h.x = pk2(v0[0], v0[1]); h.y = pk2(v0[2], v0[3]); h.z = pk2(v1[0], v1[1]); h.w = pk2(v1[2], v1[3]);
    f32x4 l0, l1;
    l0[0] = v0[0] - __builtin_bit_cast(float, h.x << 16); l0[1] = v0[1] - __builtin_bit_cast(float, h.x & 0xffff0000u);
    l0[2] = v0[2] - __builtin_bit_cast(float, h.y << 16); l0[3] = v0[3] - __builtin_bit_cast(float, h.y & 0xffff0000u);
    l1[0] = v1[0] - __builtin_bit_cast(float, h.z << 16); l1[1] = v1[1] - __builtin_bit_cast(float, h.z & 0xffff0000u);
    l1[2] = v1[2] - __builtin_bit_cast(float, h.w << 16); l1[3] = v1[3] - __builtin_bit_cast(float, h.w & 0xffff0000u);
    u32x4 l; l.x = pk2(l0[0], l0[1]); l.y = pk2(l0[2], l0[3]); l.z = pk2(l1[0], l1[1]); l.w = pk2(l1[2], l1[3]);
    *(u32x4*)ph = h; *(u32x4*)pl = l;
}
struct EpiProj {
    static constexpr bool PERM = true, AFTER_DRAIN = false;
    unsigned char* ws;
    __device__ __forceinline__ void operator()(const f32x4 (&acc)[2][2][4][2], const pg8::Unit& u, int wr, int wc, int fr, int fq) const {
        const int pn = u.pn;
        const float* rstd = (const float*)(ws + WS_RSTD); const float* rope = (const float*)(ws + WS_ROPE);
        const bool rope_tile = (pn < 4) || (pn >= 14);
        const bool rope_wave = rope_tile && ((wc & 1) == 0);
        int mode, ld, coloff; unsigned char* base; float sc = 1.f;
        if (pn < 2)       { mode = 0; base = ws + WS_Q;   ld = 512;  coloff = pn * 256; sc = C2; }
        else if (pn < 4)  { mode = 0; base = ws + WS_K;   ld = 512;  coloff = (pn - 2) * 256; }
        else if (pn < 6)  { mode = 0; base = ws + WS_V;   ld = 512;  coloff = (pn - 4) * 256; }
        else if (pn < 8)  { mode = 1; base = ws + WS_MIX; ld = 1024; coloff = (pn - 6) * 256; }
        else if (pn == 8) { mode = 0; base = ws + WS_GQ;  ld = 256;  coloff = 0; }
        else if (pn == 9) { mode = 0; base = ws + WS_GK;  ld = 256;  coloff = 0; }
        else if (pn < 12) { mode = 0; base = ws + WS_GV;  ld = 512;  coloff = (pn - 10) * 256; }
        else if (pn < 14) { mode = 1; base = ws + WS_MIX; ld = 1024; coloff = 512 + (pn - 12) * 256; }
        else if (pn == 14){ mode = 2; base = ws + WS_IQH; ld = 256;  coloff = 0; }
        else              { mode = 3; base = ws + WS_IKH; ld = 64;   coloff = 0; }
        const int row0 = u.pm * 256 + wr * 64 + fr;
#pragma unroll
        for (int ai = 0; ai < 2; ++ai)
#pragma unroll
            for (int m = 0; m < 4; ++m) {
                const int row = row0 + ai * 128 + m * 16;
                const float r = rstd[row];
                f32x4 c_lo = {1.f, 1.f, 1.f, 1.f}, c_hi = c_lo, s_lo = {0.f, 0.f, 0.f, 0.f}, s_hi = s_lo;
                if (rope_wave) { const f32x4* rp = (const f32x4*)(rope + (size_t)row * 16); c_lo = rp[0]; c_hi = rp[1]; s_lo = rp[2]; s_hi = rp[3]; }
#pragma unroll
                for (int bj = 0; bj < 2; ++bj) {
                    f32x4 v0 = acc[ai][bj][m][0] * r, v1 = acc[ai][bj][m][1] * r;
                    if (rope_wave && (pn != 15 || (bj == 0 && wc == 0))) {
                        f32x4 p0, p1;
#pragma unroll
                        for (int j = 0; j < 4; ++j) { p0[j] = __shfl_xor(v0[j], 16); p1[j] = __shfl_xor(v1[j], 16); }
                        if (fq == 0) { v0 = v0 * c_lo - p0 * s_lo; v1 = v1 * c_hi - p1 * s_hi; }
                        else if (fq == 1) { v0 = v0 * c_lo + p0 * s_lo; v1 = v1 * c_hi + p1 * s_hi; }
                    }
                    const int c0 = bj * 128 + wc * 32 + 8 * fq;
                    if (mode == 0 || mode == 1) {
                        if (mode == 1) {
#pragma unroll
                            for (int j = 0; j < 4; ++j) { v0[j] = silu(v0[j]); v1[j] = silu(v1[j]); }
                        } else { v0 = v0 * sc; v1 = v1 * sc; }
                        u32x4 w; w.x = pk2(v0[0], v0[1]); w.y = pk2(v0[2], v0[3]); w.z = pk2(v1[0], v1[1]); w.w = pk2(v1[2], v1[3]);
                        *(u32x4*)((bf16_t*)base + (size_t)row * ld + coloff + c0) = w;
                    } else if (mode == 2) {
                        split_store8(v0, v1, (bf16_t*)(ws + WS_IQH) + (size_t)row * 256 + c0, (bf16_t*)(ws + WS_IQL) + (size_t)row * 256 + c0);
                    } else {
                        if (c0 < 64) split_store8(v0, v1, (bf16_t*)(ws + WS_IKH) + (size_t)row * 64 + c0, (bf16_t*)(ws + WS_IKL) + (size_t)row * 64 + c0);
                        else if (c0 == 64) { *(f32x4*)((float*)(ws + WS_IW) + (size_t)row * 4) = v0 * (0.5f * 0.125f); }
                        else if (c0 == 72) { float* p = (float*)(ws + WS_GLR) + (size_t)row * 16; *(f32x4*)p = v0; *(f32x4*)(p + 4) = v1; }
                        else if (c0 == 80) { float* p = (float*)(ws + WS_GLR) + (size_t)row * 16 + 8; *(f32x4*)p = v0; *(f32x4*)(p + 4) = v1; }
                    }
                }
            }
    }
};

template <bool MAPPED>
__device__ __forceinline__ void p0_transpose_item(const float* W, int Nsrc, const float* ksc, bf16_t* WT, bf16_t* WL, LAS float* scr, int item, int nblk, int lane) {
    const int kb = item / nblk, nb = item % nblk, k0 = 64 * kb, n0 = 32 * nb;
    const int srcc = MAPPED ? cmap(n0 + (lane & 31)) : (n0 + (lane & 31));
#pragma unroll 8
    for (int i = 0; i < 32; ++i) { const int kk = 2 * i + (lane >> 5);
        float v = W[(size_t)(k0 + kk) * Nsrc + (srcc < 0 ? 0 : srcc)]; if (MAPPED) v *= ksc[k0 + kk];
        scr[kk * 33 + (lane & 31)] = (srcc < 0) ? 0.f : v; }
    asm volatile("s_waitcnt lgkmcnt(0)" ::: "memory");
    const int c = lane & 7;
#pragma unroll
    for (int j = 0; j < 4; ++j) { const int n = (lane >> 3) + 8 * j; const LAS float* s = scr + (8 * c) * 33 + n;
        float v[8];
#pragma unroll
        for (int q = 0; q < 8; ++q) v[q] = s[q * 33];
        u32x4 o; o.x = pk2(v[0], v[1]); o.y = pk2(v[2], v[3]); o.z = pk2(v[4], v[5]); o.w = pk2(v[6], v[7]);
        *(u32x4*)(WT + (size_t)(n0 + n) * 1024 + k0 + 8 * c) = o;
        if (MAPPED && n0 >= 3584) {
            float l[8];
#pragma unroll
            for (int q = 0; q < 8; ++q) l[q] = v[q] - bf2f(f2bf(v[q]));
            u32x4 ol; ol.x = pk2(l[0], l[1]); ol.y = pk2(l[2], l[3]); ol.z = pk2(l[4], l[5]); ol.w = pk2(l[6], l[7]);
            *(u32x4*)(WL + (size_t)(n0 - 3584 + n) * 1024 + k0 + 8 * c) = ol;
        }
    }
    asm volatile("s_waitcnt lgkmcnt(0)" ::: "memory");
}
__device__ __forceinline__ void p0_row(const float* x, const int* pos, unsigned char* ws, int row, int lane) {
    const f32x4* xr = (const f32x4*)(x + (size_t)row * DM) + lane;
    f32x4 v[4]; float s = 0.f;
#pragma unroll
    for (int j = 0; j < 4; ++j) { v[j] = xr[64 * j]; s += (v[j][0] * v[j][0] + v[j][1] * v[j][1]) + (v[j][2] * v[j][2] + v[j][3] * v[j][3]); }
    s = wave_sum(s);
    u32x2* oh = (u32x2*)((bf16_t*)(ws + WS_XH) + (size_t)row * DM) + lane;
    u32x2* ol = (u32x2*)((bf16_t*)(ws + WS_XL) + (size_t)row * DM) + lane;
#pragma unroll
    for (int j = 0; j < 4; ++j) {
        u32x2 h; h.x = pk2(v[j][0], v[j][1]); h.y = pk2(v[j][2], v[j][3]);
        f32x4 l; l[0] = v[j][0] - __builtin_bit_cast(float, h.x << 16); l[1] = v[j][1] - __builtin_bit_cast(float, h.x & 0xffff0000u);
        l[2] = v[j][2] - __builtin_bit_cast(float, h.y << 16); l[3] = v[j][3] - __builtin_bit_cast(float, h.y & 0xffff0000u);
        u32x2 lo; lo.x = pk2(l[0], l[1]); lo.y = pk2(l[2], l[3]);
        oh[64 * j] = h; ol[64 * j] = lo;
    }
    if (lane == 0) ((float*)(ws + WS_RSTD))[row] = 1.0f / sqrtf(s * (1.0f / DM) + NORM_EPS);
    if (lane < 8) {
        const float inv = (float)pow(500000.0, -(double)lane / 8.0);
        const float ang = (float)pos[row] * inv;
        float* rope = (float*)(ws + WS_ROPE);
        rope[row * 16 + lane] = (float)cos((double)ang);
        rope[row * 16 + 8 + lane] = (float)sin((double)ang);
    }
}
struct ProbOut {
    const bf16_t *A, *Bt;
    __device__ __forceinline__ int nt(const pg8::Unit&) const { return 16; }
    __device__ __forceinline__ const char* a(const pg8::Unit& u, int t) const { return (const char*)(A + (size_t)u.pm * 256 * pg8::KP) + (size_t)(t & 15) * 128; }
    __device__ __forceinline__ const char* b(const pg8::Unit& u, int t) const { return (const char*)(Bt + (size_t)u.pn * 256 * pg8::KP) + (size_t)(t & 15) * 128; }
};
struct SchedOut {
    int G, c;
    __device__ __forceinline__ bool next(int i, pg8::Unit& u) const { const long L = (long)i * G + c; if (L >= 256) return false; u.pm = (int)(L >> 2); u.pn = (int)(L & 3); u.kind = 0; return true; }
};
struct EpiY {
    static constexpr bool PERM = false, AFTER_DRAIN = false;
    float* Y;
    __device__ __forceinline__ void operator()(const f32x4 (&acc)[2][2][4][2], const pg8::Unit& u, int wr, int wc, int fr, int fq) const {
        const int row0 = u.pm * 256 + wr * 64 + fr, col0 = u.pn * 256 + wc * 32 + 4 * fq;
#pragma unroll
        for (int ai = 0; ai < 2; ++ai)
#pragma unroll
            for (int m = 0; m < 4; ++m) { float* rowp = Y + (size_t)(row0 + ai * 128 + m * 16) * DM + col0;
#pragma unroll
                for (int bj = 0; bj < 2; ++bj)
#pragma unroll
                    for (int n = 0; n < 2; ++n) *(f32x4*)(rowp + bj * 128 + n * 16) = acc[ai][bj][m][n]; }
    }
};
__device__ __forceinline__ void p6_row(const float* x, const float* Y, const float* pw, float* out, int row, int lane) {
    const f32x4* yr = (const f32x4*)(Y + (size_t)row * DM) + lane;
    f32x4 v[4]; float s = 0.f;
#pragma unroll
    for (int j = 0; j < 4; ++j) { v[j] = yr[64 * j]; s += (v[j][0] * v[j][0] + v[j][1] * v[j][1]) + (v[j][2] * v[j][2] + v[j][3] * v[j][3]); }
    s = wave_sum(s);
    const float r = 1.0f / sqrtf(s * (1.0f / DM) + NORM_EPS);
#pragma unroll
    for (int j = 0; j < 4; ++j) {
        const f32x4 xv = ((const f32x4*)(x + (size_t)row * DM) + lane)[64 * j], w = ((const f32x4*)pw + lane)[64 * j];
        ((f32x4*)(out + (size_t)row * DM) + lane)[64 * j] = xv + v[j] * r * w;
    }
}
#include <hip/hip_bf16.h>
#include <cmath>
namespace attn_body {
using bf16=__hip_bfloat16;
using bf16x8=__attribute__((ext_vector_type(8)))short;
using s16x4=__attribute__((ext_vector_type(4)))short;
using f32x16=__attribute__((ext_vector_type(16)))float;
using u32x4=__attribute__((ext_vector_type(4)))unsigned;
constexpr int BATCH=4,NHEAD=8,SEQ=4096,D=64,DM=NHEAD*D,OPITCH=1024;
constexpr int NW=8,QBLK=32,QB=QBLK*NW,KVBLK=64,NQB=SEQ/QB;
constexpr int ATTN_PITCH=DM, ATTN_UNIT_ROWS=QB;
__device__ __forceinline__ int crow(int r,int hi){return (r&3)+8*(r>>2)+4*hi;}
#define SBAR() __builtin_amdgcn_sched_barrier(0)
__device__ __forceinline__ void cmask(f32x16&p0,f32x16&p1,int jb,int qrel,int hi){
  const float NEG=-INFINITY; int kb=64*jb+4*hi;
  #pragma unroll
  for(int r=0;r<16;++r){int kv=kb+(r&3)+8*(r>>2); if(kv>qrel)p0[r]=NEG; if(kv+32>qrel)p1[r]=NEG;}
}

constexpr int NSLOT=3, SLOTB=8192;
constexpr int LDS_K=0, LDS_V=NSLOT*SLOTB, LDS_WS=2*NSLOT*SLOTB, LDS_OST=LDS_WS+NW*64*4, LDS_MSK=LDS_OST+NW*4096, LDS_BYTES=LDS_MSK+NW*512;
constexpr float C2=0.125f*1.4426950408889634f;
__device__ __forceinline__ void glds16(const void*gsrc,unsigned lds_dst){unsigned keep;
  asm volatile("s_mov_b32 %0, m0\n\ts_mov_b32 m0, %2\n\ts_nop 0\n\tglobal_load_lds_dwordx4 %1, off\n\ts_mov_b32 m0, %0":"=&s"(keep):"v"(gsrc),"s"(lds_dst):"memory");}
__device__ __forceinline__ void glds4(const void*gsrc,unsigned lds_dst){unsigned keep;
  asm volatile("s_mov_b32 %0, m0\n\ts_mov_b32 m0, %2\n\ts_nop 0\n\tglobal_load_lds_dword %1, off\n\ts_mov_b32 m0, %0":"=&s"(keep):"v"(gsrc),"s"(lds_dst):"memory");}
__device__ __forceinline__ float max3f(float a,float b,float c){float r;asm("v_max3_f32 %0, %1, %2, %3":"=v"(r):"v"(a),"v"(b),"v"(c));return r;}
__device__ __forceinline__ float max2f(float a,float b){float r;asm("v_max_f32_e32 %0, %1, %2":"=v"(r):"v"(a),"v"(b));return r;}
__device__ __forceinline__ float fadd_s(float a,float b){float r;asm("v_add_f32_e32 %0, %1, %2":"=v"(r):"v"(a),"v"(b));return r;}
__device__ __forceinline__ float fsub_s(float a,float b){float r;asm("v_sub_f32_e32 %0, %1, %2":"=v"(r):"v"(a),"v"(b));return r;}
typedef float f32x2_t __attribute__((ext_vector_type(2))); typedef __bf16 bf16x2_t __attribute__((ext_vector_type(2)));
__device__ __forceinline__ unsigned cvtpk_s(float lo,float hi){f32x2_t v={lo,hi};bf16x2_t b=__builtin_convertvector(v,bf16x2_t);return __builtin_bit_cast(unsigned,b);}
#define WAIT_BAR(N) asm volatile("s_waitcnt vmcnt(" #N ") lgkmcnt(0)\n\ts_barrier":::"memory")

__device__ __forceinline__ void qkt(f32x16&p0,f32x16&p1,const char*Kslot,const bf16x8*qr,const f32x16&negm,int r32,int hi){
  const char*kb=Kslot+hi*1024+r32*16;
  #pragma unroll
  for(int d0=0;d0<4;++d0){
    const bf16x8 b0=*reinterpret_cast<const bf16x8*>(kb+d0*2048);
    const bf16x8 b1=*reinterpret_cast<const bf16x8*>(kb+d0*2048+512);
    if(d0==0){p0=__builtin_amdgcn_mfma_f32_32x32x16_bf16(b0,qr[0],negm,0,0,0);p1=__builtin_amdgcn_mfma_f32_32x32x16_bf16(b1,qr[0],negm,0,0,0);}
    else{p0=__builtin_amdgcn_mfma_f32_32x32x16_bf16(b0,qr[d0],p0,0,0,0);p1=__builtin_amdgcn_mfma_f32_32x32x16_bf16(b1,qr[d0],p1,0,0,0);}}
}
typedef __attribute__((address_space(3))) const char* lds_cptr;
typedef short v4i16_t __attribute__((ext_vector_type(4)));
__device__ __forceinline__ void kload8(bf16x8*kf,lds_cptr kp){
  kf[0]=*(const __attribute__((address_space(3))) bf16x8*)(kp);      kf[1]=*(const __attribute__((address_space(3))) bf16x8*)(kp+512);
  kf[2]=*(const __attribute__((address_space(3))) bf16x8*)(kp+2048); kf[3]=*(const __attribute__((address_space(3))) bf16x8*)(kp+2560);
  kf[4]=*(const __attribute__((address_space(3))) bf16x8*)(kp+4096); kf[5]=*(const __attribute__((address_space(3))) bf16x8*)(kp+4608);
  kf[6]=*(const __attribute__((address_space(3))) bf16x8*)(kp+6144); kf[7]=*(const __attribute__((address_space(3))) bf16x8*)(kp+6656);
}
__device__ __forceinline__ void kload2(bf16x8*kf,lds_cptr kp,int j){ kf[2*j]=*(const __attribute__((address_space(3))) bf16x8*)(kp+j*2048); kf[2*j+1]=*(const __attribute__((address_space(3))) bf16x8*)(kp+j*2048+512); }
__device__ __forceinline__ s16x4 vtr(lds_cptr p){ return __builtin_bit_cast(s16x4,__builtin_amdgcn_ds_read_tr16_b64_v4i16((__attribute__((address_space(3))) v4i16_t*)p)); }
__device__ __forceinline__ float rowmax(const f32x16&p0,const f32x16&p1){
  float a=max3f(p0[0],p0[1],p1[0]),b=max3f(p0[2],p0[3],p1[1]);a=max3f(a,p1[2],p1[3]);
  #pragma unroll
  for(int r=4;r<16;r+=4){a=max3f(a,p0[r],p0[r+1]);b=max3f(b,p0[r+2],p0[r+3]);a=max3f(a,p1[r],p1[r+1]);b=max3f(b,p1[r+2],p1[r+3]);}
  const float m=max2f(a,b);
  auto rr=__builtin_amdgcn_permlane32_swap(__float_as_uint(m),__float_as_uint(m),false,false);
  return max2f(__uint_as_float(rr[0]),__uint_as_float(rr[1]));
}
__device__ __forceinline__ void pv(f32x16*o,int vb,bf16x8 pa0,bf16x8 pa1,bf16x8 pa2,bf16x8 pa3){
  #pragma unroll
  for(int d0=0;d0<2;++d0){s16x4 lo[4],hi[4];
    #pragma unroll
    for(int ks=0;ks<4;++ks){
      asm volatile("ds_read_b64_tr_b16 %0,%1 offset:%c2":"=&v"(lo[ks]):"v"(vb),"i"(d0*4096+ks*1024):"memory");
      asm volatile("ds_read_b64_tr_b16 %0,%1 offset:%c2":"=&v"(hi[ks]):"v"(vb),"i"(d0*4096+ks*1024+512):"memory");}
    asm volatile("s_waitcnt lgkmcnt(0)":::"memory");SBAR();
    #define PK(k) (bf16x8){lo[k][0],lo[k][1],lo[k][2],lo[k][3],hi[k][0],hi[k][1],hi[k][2],hi[k][3]}
    o[d0]=__builtin_amdgcn_mfma_f32_32x32x16_bf16(pa0,PK(0),o[d0],0,0,0);
    o[d0]=__builtin_amdgcn_mfma_f32_32x32x16_bf16(pa1,PK(1),o[d0],0,0,0);
    o[d0]=__builtin_amdgcn_mfma_f32_32x32x16_bf16(pa2,PK(2),o[d0],0,0,0);
    o[d0]=__builtin_amdgcn_mfma_f32_32x32x16_bf16(pa3,PK(3),o[d0],0,0,0);
    #undef PK
  }
}

#ifndef ATTN_STORE16
#define ATTN_STORE16(p,v) (*(u32x4*)(p)=(v))
#endif
template<int THRL> __device__ __forceinline__ void attn_unit(int b,int h,int qb,const bf16*Q,const bf16*__restrict__ K,const bf16*__restrict__ V,const unsigned*__restrict__ MASK32,bf16*O,char*shm){
  const int tid=threadIdx.x,lane=tid&63,r32=lane&31,hi=lane>>5; const int wid=__builtin_amdgcn_readfirstlane(tid>>6);
  const long rowbase=(long)b*SEQ; const int q0=qb*QB;
  const bf16*Qw=Q+(rowbase+q0+wid*QBLK)*DM+h*D;
  const bf16*Kh=K+rowbase*DM+h*D,*Vh=V+rowbase*DM+h*D;
  const unsigned lds0=(unsigned)(uintptr_t)shm;
  float*wsf=(float*)(shm+LDS_WS)+wid*64;
  const bf16*ksrc=Kh+(long)lane*DM+wid*8;
  const bf16*vsrc=Vh+(long)(16*(wid&3)+(lane>>2))*DM+(wid>>2)*32+(lane&3)*8;
  const unsigned kdst=lds0+LDS_K+wid*1024, vdst=lds0+LDS_V+wid*1024;
  #define DMA_K(t,slot) glds16(ksrc+(long)(t)*KVBLK*DM,(unsigned)__builtin_amdgcn_readfirstlane(kdst+(slot)))
  #define DMA_V(t,slot) glds16(vsrc+(long)(t)*KVBLK*DM,(unsigned)__builtin_amdgcn_readfirstlane(vdst+(slot)))
  const unsigned*msrc=MASK32+(size_t)(rowbase+q0+wid*QBLK+(lane>>1))*128+(lane&1);
  const unsigned mdst=lds0+LDS_MSK+wid*512;
  #define DMA_M(t) glds4(msrc+2*(t),(unsigned)__builtin_amdgcn_readfirstlane(mdst+(((t)&1)<<8)))
  typedef __attribute__((address_space(3))) const unsigned long long* lds_u64p;
  #define MSK(v,W,b) __uint_as_float(__float_as_uint(v)&(unsigned)__builtin_amdgcn_sbfe((int)(W),(b),1))
  #define BP(B) (((B)&3)+8*((B)>>2))
  const int vb0=(int)(lds0+LDS_V)+((lane>>4)&1)*32+(lane&3)*8+(4*hi+((lane&15)>>2))*64;
  const char*Kbase=shm+LDS_K; bf16x8 kf[8];
  const lds_cptr shm3=(lds_cptr)shm; const lds_cptr kp0=shm3+LDS_K+hi*1024+r32*16; const lds_cptr vp0=shm3+LDS_V+((lane>>4)&1)*32+(lane&3)*8+(4*hi+((lane&15)>>2))*64;
  const lds_cptr mp0=shm3+LDS_MSK+wid*512+r32*8;
  const int NT=(q0+QB)/KVBLK;
  DMA_M(0);DMA_M(1);DMA_K(0,0);DMA_V(0,0);DMA_K(1,SLOTB);
  bf16x8 qr[4];
  #pragma unroll
  for(int d0=0;d0<4;++d0)qr[d0]=*reinterpret_cast<const bf16x8*>(&Qw[(long)r32*DM+d0*16+hi*8]);
  float mhat=0.f,l_reg=0.f;f32x16 o[2];o[0]=f32x16{};o[1]=f32x16{};f32x16 negm=f32x16{};asm volatile("":"+v"(negm));
  const int qrel=wid*QBLK+r32;
  #define CMASK(P0,P1,t) do{}while(0)
  bool resc=false;
  #define START(P0,P1) do{ const float rm=rowmax(P0,P1); resc=false; \
    { const float dl=rm; mhat=fadd_s(mhat,dl); \
      _Pragma("unroll") for(int r=0;r<16;++r){P0[r]=fsub_s(P0[r],dl);P1[r]=fsub_s(P1[r],dl);} \
      _Pragma("unroll") for(int r=0;r<16;++r)negm[r]=-mhat; asm volatile("":"+v"(negm)); } \
    _Pragma("unroll") for(int r=0;r<16;++r)P0[r]=__builtin_amdgcn_exp2f(P0[r]); }while(0)
  #define RESC() do{ if(resc){ asm volatile("s_waitcnt lgkmcnt(0)":::"memory"); \
      _Pragma("unroll") for(int d_=0;d_<2;++d_) _Pragma("unroll") for(int r=0;r<16;++r)o[d_][r]*=wsf[crow(r,hi)]; } }while(0)
  f32x16 pA0,pA1,pB0,pB1;
  int sl_prev=0,sl_cur=0,sl_next=SLOTB;
  #define ROT() do{sl_prev=sl_cur;sl_cur=sl_next;sl_next=(sl_next==(NSLOT-1)*SLOTB)?0:sl_next+SLOTB;}while(0)
  DMA_K(2,2*SLOTB);
  WAIT_BAR(3);
  qkt(pA0,pA1,Kbase,qr,negm,r32,hi);asm volatile("s_nop 15\n\ts_nop 7":"+v"(pA0),"+v"(pA1));
  START(pA0,pA1);
  _Pragma("unroll") for(int r=0;r<16;++r)pA1[r]=__builtin_amdgcn_exp2f(pA1[r]);
  { const unsigned long long mw_=*(lds_u64p)(mp0); const unsigned mwl_=(unsigned)mw_>>(4*hi), mwh_=(unsigned)(mw_>>32)>>(4*hi);
    _Pragma("unroll") for(int r=0;r<16;++r){pA0[r]=MSK(pA0[r],mwl_,BP(r));pA1[r]=MSK(pA1[r],mwh_,BP(r));} }
  WAIT_BAR(0);
  DMA_K(3,0);DMA_V(1,SLOTB);
  ROT();
  kload8(kf,kp0+sl_cur);
  WAIT_BAR(2);
  s16x4 vlo[8],vhi[8]; u32x4 pw0,pw1,pw2,pw3;
  #define PKW(P,B) cvtpk_s(P[B],P[B+1])
  #define PAF(k) __builtin_bit_cast(bf16x8,pw##k)
  #define VFR(i) (bf16x8){vlo[i][0],vlo[i][1],vlo[i][2],vlo[i][3],vhi[i][0],vhi[i][1],vhi[i][2],vhi[i][3]}
  #define PIN(x) asm volatile("":"+v"(x))
  #define MX3(a,b,c) __builtin_fmaxf(__builtin_fmaxf((a),(b)),(c))
  #define GAPA(MF,A0,A1,A2,A3,W0,W1,PW) do{ MF; sacc+=A0; sacc+=A1; sacc+=A2; sacc+=A3; PIN(sacc); W0; W1; PIN(PW); SBAR(); }while(0)
  #define EX(v) __builtin_amdgcn_exp2f(v)
  #define GAPB(MF,X,W,B) do{ MF; X[B]=MSK(EX(X[B]),W,BP(B)); X[B+1]=MSK(EX(X[B+1]),W,BP(B+1)); X[B+2]=MSK(EX(X[B+2]),W,BP(B+2)); X[B+3]=MSK(EX(X[B+3]),W,BP(B+3)); PIN(X); SBAR(); }while(0)
  #define VRD(i) do{ vlo[i]=vtr(vp_+(((i)>>2)*4096+((i)&3)*1024)); vhi[i]=vtr(vp_+(((i)>>2)*4096+((i)&3)*1024+512)); }while(0)
  #define KRD(G,j) do{ if(G){ kload2(kf,kp0+sl_next,j); SBAR(); } }while(0)
  #define STEP(C0,C1,P0,P1,t,GK,GV,GL) do{ SBAR(); \
    if(GV){DMA_M((t)+1);} \
    const unsigned long long mw_=*(lds_u64p)(mp0+(((t)&1)<<8)); const unsigned mwl_=(unsigned)mw_>>(4*hi), mwh_=(unsigned)(mw_>>32)>>(4*hi); \
    const lds_cptr vp_=vp0+sl_prev; \
    VRD(0); SBAR(); float sacc=(P0[0]+P0[1]); \
    GAPA(C0=__builtin_amdgcn_mfma_f32_32x32x16_bf16(kf[0],qr[0],negm,0,0,0), P0[2],P0[3],P0[4],P0[5],     pw0[0]=PKW(P0,0), pw0[1]=PKW(P0,2), pw0); \
    VRD(4); SBAR(); GAPA(C1=__builtin_amdgcn_mfma_f32_32x32x16_bf16(kf[1],qr[0],negm,0,0,0), P0[6],P0[7],P0[8],P0[9],     pw0[2]=PKW(P0,4), pw0[3]=PKW(P0,6), pw0); \
    VRD(1); SBAR(); GAPA(C0=__builtin_amdgcn_mfma_f32_32x32x16_bf16(kf[2],qr[1],C0,0,0,0),   P0[10],P0[11],P0[12],P0[13], pw1[0]=PKW(P0,8), pw1[1]=PKW(P0,10), pw1); \
    VRD(5); SBAR(); GAPA(C1=__builtin_amdgcn_mfma_f32_32x32x16_bf16(kf[3],qr[1],C1,0,0,0),   P0[14],P0[15],P1[0],P1[1],   pw1[2]=PKW(P0,12),pw1[3]=PKW(P0,14), pw1); \
    VRD(2); SBAR(); GAPA(C0=__builtin_amdgcn_mfma_f32_32x32x16_bf16(kf[4],qr[2],C0,0,0,0),   P1[2],P1[3],P1[4],P1[5],     pw2[0]=PKW(P1,0), pw2[1]=PKW(P1,2), pw2); \
    VRD(6); SBAR(); GAPA(C1=__builtin_amdgcn_mfma_f32_32x32x16_bf16(kf[5],qr[2],C1,0,0,0),   P1[6],P1[7],P1[8],P1[9],     pw2[2]=PKW(P1,4), pw2[3]=PKW(P1,6), pw2); \
    VRD(3); SBAR(); GAPA(C0=__builtin_amdgcn_mfma_f32_32x32x16_bf16(kf[6],qr[3],C0,0,0,0),   P1[10],P1[11],P1[12],P1[13], pw3[0]=PKW(P1,8), pw3[1]=PKW(P1,10), pw3); \
    VRD(7); SBAR(); GAPA(C1=__builtin_amdgcn_mfma_f32_32x32x16_bf16(kf[7],qr[3],C1,0,0,0),   P1[14],P1[15],0.f,0.f,       pw3[2]=PKW(P1,12),pw3[3]=PKW(P1,14), pw3); \
    l_reg+=sacc; \
    if(GK){DMA_K((t)+3,sl_cur);} if(GV){DMA_V((t)+1,sl_next);} \
    CMASK(C0,C1,t); \
    { float a=MX3(C0[0],C0[1],C1[0]),b=MX3(C0[2],C0[3],C1[1]); a=MX3(a,C1[2],C1[3]); \
      _Pragma("unroll") for(int r=4;r<16;r+=4){a=MX3(a,C0[r],C0[r+1]);b=MX3(b,C0[r+2],C0[r+3]);a=MX3(a,C1[r],C1[r+1]);b=MX3(b,C1[r+2],C1[r+3]);} \
      float rm=__builtin_fmaxf(a,b); { auto rr=__builtin_amdgcn_permlane32_swap(__float_as_uint(rm),__float_as_uint(rm),false,false); rm=__builtin_fmaxf(__uint_as_float(rr[0]),__uint_as_float(rr[1])); } \
      resc=false; \
      if(__builtin_expect(__any(rm>(float)THRL),0)){ const float dl=__builtin_fmaxf(rm,0.f); mhat+=dl; \
        _Pragma("unroll") for(int r=0;r<16;++r){C0[r]-=dl;C1[r]-=dl;} \
        _Pragma("unroll") for(int r=0;r<16;++r)negm[r]=-mhat; asm volatile("":"+v"(negm)); \
        const float f=__builtin_amdgcn_exp2f(-dl); l_reg*=f; if(hi==0)wsf[r32]=f; resc=true; } } \
    SBAR(); \
    GAPB(o[0]=__builtin_amdgcn_mfma_f32_32x32x16_bf16(PAF(0),VFR(0),o[0],0,0,0), C0,mwl_,0); \
    GAPB(o[1]=__builtin_amdgcn_mfma_f32_32x32x16_bf16(PAF(0),VFR(4),o[1],0,0,0), C0,mwl_,4); \
    KRD(GL,0); GAPB(o[0]=__builtin_amdgcn_mfma_f32_32x32x16_bf16(PAF(1),VFR(1),o[0],0,0,0), C0,mwl_,8); \
    KRD(GL,1); GAPB(o[1]=__builtin_amdgcn_mfma_f32_32x32x16_bf16(PAF(1),VFR(5),o[1],0,0,0), C0,mwl_,12); \
    KRD(GL,2); GAPB(o[0]=__builtin_amdgcn_mfma_f32_32x32x16_bf16(PAF(2),VFR(2),o[0],0,0,0), C1,mwh_,0); \
    KRD(GL,3); GAPB(o[1]=__builtin_amdgcn_mfma_f32_32x32x16_bf16(PAF(2),VFR(6),o[1],0,0,0), C1,mwh_,4); \
    GAPB(o[0]=__builtin_amdgcn_mfma_f32_32x32x16_bf16(PAF(3),VFR(3),o[0],0,0,0), C1,mwh_,8); \
    GAPB(o[1]=__builtin_amdgcn_mfma_f32_32x32x16_bf16(PAF(3),VFR(7),o[1],0,0,0), C1,mwh_,12); \
    }while(0)
  int t=1;
  #undef CMASK
  #define CMASK(P0,P1,t) do{}while(0)
  for(;t+5<NT;t+=2){
    STEP(pB0,pB1,pA0,pA1,t,true,true,true);     WAIT_BAR(2); RESC(); ROT();
    STEP(pA0,pA1,pB0,pB1,t+1,true,true,true);   WAIT_BAR(2); RESC(); ROT();
  }
  #undef CMASK
  #define CMASK(P0,P1,t) do{}while(0)
  #define ENDW(tt) do{ if((tt)+3<NT){WAIT_BAR(2);} else if((tt)+2<NT){WAIT_BAR(1);} else {WAIT_BAR(0);} }while(0)
  for(;t+1<NT;t+=2){
    STEP(pB0,pB1,pA0,pA1,t,(t+3<NT),(t+1<NT),(t+1<NT));       ENDW(t);   RESC(); ROT();
    STEP(pA0,pA1,pB0,pB1,t+1,(t+4<NT),(t+2<NT),(t+2<NT));     ENDW(t+1); RESC(); ROT();
  }
  STEP(pB0,pB1,pA0,pA1,NT-1,false,false,false); RESC();
  { float sacc=pB0[0]+pB0[1]; _Pragma("unroll") for(int r=2;r<16;++r)sacc+=pB0[r]; _Pragma("unroll") for(int r=0;r<16;++r)sacc+=pB1[r]; l_reg+=sacc;
    pw0=(u32x4){PKW(pB0,0),PKW(pB0,2),PKW(pB0,4),PKW(pB0,6)};pw1=(u32x4){PKW(pB0,8),PKW(pB0,10),PKW(pB0,12),PKW(pB0,14)};pw2=(u32x4){PKW(pB1,0),PKW(pB1,2),PKW(pB1,4),PKW(pB1,6)};pw3=(u32x4){PKW(pB1,8),PKW(pB1,10),PKW(pB1,12),PKW(pB1,14)};
    SBAR(); pv(o,vb0+sl_cur,PAF(0),PAF(1),PAF(2),PAF(3)); }
  #undef PKW
  #undef PAF
  #undef VFR
  #undef PIN
  #undef MX3
  #undef GAPA
  #undef GAPB
  #undef EX
  #undef VRD
  #undef KRD
  #undef STEP
  #undef ENDW
  {auto rr=__builtin_amdgcn_permlane32_swap(__float_as_uint(l_reg),__float_as_uint(l_reg),false,false);l_reg=__uint_as_float(rr[0])+__uint_as_float(rr[1]);}
  if(hi==0)wsf[32+r32]=l_reg;asm volatile("s_waitcnt lgkmcnt(0)":::"memory");
  float rli[16];
  #pragma unroll
  for(int r=0;r<16;++r)rli[r]=__builtin_amdgcn_rcpf(wsf[32+crow(r,hi)]);
  bf16*Ow=O+(rowbase+q0+wid*QBLK)*OPITCH+h*D;
  { bf16*stg=(bf16*)(shm+LDS_OST)+wid*2048;
    #pragma unroll
    for(int r=0;r<16;++r){const int orow=crow(r,hi);
      #pragma unroll
      for(int d0=0;d0<2;++d0)stg[orow*64+d0*32+r32]=__float2bfloat16(o[d0][r]*rli[r]);}
    asm volatile("s_waitcnt lgkmcnt(0)":::"memory");
    #pragma unroll
    for(int i=0;i<4;++i){const int row=i*8+(lane>>3),ch=lane&7; const u32x4 v=*(const u32x4*)(stg+row*64+ch*8); bf16*dst=Ow+(long)row*OPITCH+ch*8; const u32x4 g=*(const u32x4*)dst; u32x4 w;
      _Pragma("unroll") for(int e=0;e<4;++e){ const float a0=__uint_as_float(v[e]<<16),a1=__uint_as_float(v[e]&0xffff0000u),g0=__uint_as_float(g[e]<<16),g1=__uint_as_float(g[e]&0xffff0000u); w[e]=cvtpk_s(a0*g0,a1*g1); }
      *(u32x4*)dst=w;} }
  asm volatile("s_waitcnt lgkmcnt(0)\n\ts_barrier":::"memory");
  #undef DMA_K
  #undef DMA_V
  #undef DMA_M
  #undef MSK
  #undef BP
  #undef CMASK
  #undef START
  #undef RESC
  #undef ROT
}
constexpr int ATTN_LDS_BYTES=LDS_BYTES;
struct AttnTensors { const bf16* Q; const bf16* K; const bf16* V; const unsigned* MASK32; bf16* O; };
struct AttnUnit { int bh; int qb; };
struct StaticOrder {
  int vcu,G;
  __device__ __forceinline__ StaticOrder(int grid,int v):vcu(v),G(grid){}
  __device__ __forceinline__ bool next(int i,AttnUnit&u)const{
    if(G==256){ if(i>=2)return false; const int s=vcu&7; u.bh=vcu>>3; u.qb=(i==0)?15-s:s; return true; }
    const long L=(long)i*G+vcu; if(L>=BATCH*NHEAD*NQB)return false; u.qb=NQB-1-(int)(L/(BATCH*NHEAD)); u.bh=(int)(L%(BATCH*NHEAD)); return true; }
  __device__ __forceinline__ void a_ready(const AttnUnit&)const{}
  __device__ __forceinline__ void done(const AttnUnit&)const{}
};
template<class Sched,int THRL=8> __device__ __forceinline__ void attn_phase(char*lds,const AttnTensors&T,const Sched&S){
  AttnUnit u;
  for(int i=0;S.next(i,u);++i){ S.a_ready(u); attn_unit<THRL>(u.bh/NHEAD,u.bh%NHEAD,u.qb,T.Q,T.K,T.V,T.MASK32,T.O,lds); S.done(u); }
}
#undef SBAR
#undef WAIT_BAR
}
namespace sel {
typedef short bf16x8 __attribute__((ext_vector_type(8)));
typedef float f32x16 __attribute__((ext_vector_type(16)));
constexpr int QF_OFF = 0;
constexpr int H1_OFF = 32768;
__device__ __forceinline__ int hist_off(int wid) { return wid < 4 ? wid * 8192 : 98304 + (wid - 4) * 8192; }
constexpr int NUNITS = BATCH * (SEQ / 32);
__device__ __forceinline__ unsigned mono(float f) { const unsigned u = __builtin_bit_cast(unsigned, f); return (u & 0x80000000u) ? ~u : (u | 0x80000000u); }
__device__ __forceinline__ int crow16(int r, int hi) { return (r & 3) + 8 * (r >> 2) + 4 * hi; }
__device__ __forceinline__ void unit_of(int u, int& b, int& j) { j = (SEQ / 32 - 1) - (u >> 2); b = u & 3; }
__device__ __forceinline__ size_t scratch_bytes(int v) { return (size_t)4096 * (size_t)((SEQ / 32) - (v >> 2)); }

__device__ __forceinline__ void unit(int b, int j, unsigned char* ws, float* sc, LAS unsigned char* lds) {
    const int tid = threadIdx.x, lane = tid & 63, wid = __builtin_amdgcn_readfirstlane(tid >> 6), r32 = lane & 31, hi = lane >> 5;
    const int q0 = j * 32, row0 = b * SEQ + q0, nkt = j + 1;
    const bf16_t* IQH = (const bf16_t*)(ws + WS_IQH); const bf16_t* IQL = (const bf16_t*)(ws + WS_IQL);
    const bf16_t* IKH = (const bf16_t*)(ws + WS_IKH); const bf16_t* IKL = (const bf16_t*)(ws + WS_IKL);
#pragma unroll
    for (int i = 0; i < 2; ++i) {
        const int f = tid + 512 * i, h = f >> 8, s = (f >> 6) & 3, l = f & 63, r = l & 31, half = l >> 5;
        const size_t src = (size_t)(row0 + r) * 256 + h * 64 + 16 * s + 8 * half;
        const u32x4 vh = *(const u32x4*)(IQH + src), vl = *(const u32x4*)(IQL + src);
        *(LAS u32x4*)(lds + QF_OFF + ((h * 4 + s) * 2 + 0) * 1024 + l * 16) = vh;
        *(LAS u32x4*)(lds + QF_OFF + ((h * 4 + s) * 2 + 1) * 1024 + l * 16) = vl;
    }
#pragma unroll
    for (int i = 0; i < 8; ++i) *(LAS u32x4*)(lds + H1_OFF + (i * 512 + tid) * 16) = (u32x4){0u, 0u, 0u, 0u};
    const f32x4 w = *(const f32x4*)((const float*)(ws + WS_IW) + (size_t)(row0 + r32) * 4);
    __syncthreads();
#ifndef SEL_REP_SCORE
#define SEL_REP_SCORE 1
#endif
#ifndef SEL_REP_SELECT
#define SEL_REP_SELECT 1
#endif
    for (int rep_ = 0; rep_ < SEL_REP_SCORE; ++rep_)
    for (int kt = wid; kt < nkt; kt += 8) {
        const size_t krow = (size_t)(b * SEQ + kt * 32 + r32) * 64 + 8 * hi;
        bf16x8 kh[4], kl[4];
#pragma unroll
        for (int s = 0; s < 4; ++s) { kh[s] = *(const bf16x8*)(IKH + krow + 16 * s); kl[s] = *(const bf16x8*)(IKL + krow + 16 * s); }
        f32x16 score;
#pragma unroll
        for (int i = 0; i < 16; ++i) score[i] = 0.f;
        int qoff = lane * 16; asm volatile("" : "+v"(qoff));
#pragma unroll
        for (int h = 0; h < 4; ++h) {
            f32x16 acc;
#pragma unroll
            for (int i = 0; i < 16; ++i) acc[i] = 0.f;
#pragma unroll
            for (int s = 0; s < 4; ++s) {
                const bf16x8 qh = *(const LAS bf16x8*)(lds + QF_OFF + ((h * 4 + s) * 2 + 0) * 1024 + qoff);
                const bf16x8 ql = *(const LAS bf16x8*)(lds + QF_OFF + ((h * 4 + s) * 2 + 1) * 1024 + qoff);
                acc = __builtin_amdgcn_mfma_f32_32x32x16_bf16(kh[s], qh, acc, 0, 0, 0);
                acc = __builtin_amdgcn_mfma_f32_32x32x16_bf16(kh[s], ql, acc, 0, 0, 0);
                acc = __builtin_amdgcn_mfma_f32_32x32x16_bf16(kl[s], qh, acc, 0, 0, 0);
            }
            const float wh = w[h];
#pragma unroll
            for (int i = 0; i < 16; ++i) score[i] += wh * fmaxf(acc[i], 0.f);
        }
        unsigned* dst = (unsigned*)sc + ((size_t)(kt * 32 + r32) * 32 + 4 * hi);
        unsigned kk[16];
#pragma unroll
        for (int i = 0; i < 16; ++i) kk[i] = mono(score[i]);
#pragma unroll
        for (int g = 0; g < 4; ++g) *(u32x4*)(dst + 8 * g) = (u32x4){kk[4 * g], kk[4 * g + 1], kk[4 * g + 2], kk[4 * g + 3]};
        LAS unsigned* h1 = (LAS unsigned*)(lds + H1_OFF) + r32 * 512;
        if (kt != j) {
#pragma unroll
            for (int i = 0; i < 16; ++i) __hip_atomic_fetch_add(h1 + (kk[i] >> 23), ((kk[i] >> 22) & 1u) ? 0x10000u : 1u, __ATOMIC_RELAXED, __HIP_MEMORY_SCOPE_WORKGROUP);
        } else {
#pragma unroll
            for (int i = 0; i < 16; ++i) { if (crow16(i, hi) <= r32) __hip_atomic_fetch_add(h1 + (kk[i] >> 23), ((kk[i] >> 22) & 1u) ? 0x10000u : 1u, __ATOMIC_RELAXED, __HIP_MEMORY_SCOPE_WORKGROUP); }
        }
    }
    asm volatile("s_waitcnt vmcnt(0)" ::: "memory");
    __syncthreads();
    LAS unsigned* hist = (LAS unsigned*)(lds + hist_off(wid));
    unsigned pre[64];
#define SEL_LOAD_ROW(QQ, NJ) do { const unsigned* urow_ = (const unsigned*)sc + (size_t)(QQ) * 32 + hi * 1024 + r32; \
        _Pragma("unroll") for (int g_ = 0; g_ < 8; ++g_) { if (g_ * 8 < (NJ)) { _Pragma("unroll") for (int i_ = 0; i_ < 8; ++i_) pre[g_ * 8 + i_] = __builtin_nontemporal_load(urow_ + (size_t)(g_ * 8 + i_) * 2048); } } } while (0)
#define SEL_FIND(NB, TOT, CJEXPR, BIN) do { unsigned suf_ = (TOT); \
        _Pragma("unroll") for (int o_ = 1; o_ < 64; o_ <<= 1) { const unsigned v_ = __shfl_down(suf_, o_); if (lane + o_ < 64) suf_ += v_; } \
        const unsigned above_ = suf_ - (TOT); \
        const unsigned long long fm_ = __ballot(above_ < kneed && kneed <= above_ + (TOT)); \
        const int L_ = (int)__builtin_ctzll(fm_ | (1ull << 63)); \
        kneed -= (unsigned)__builtin_amdgcn_readlane((int)above_, L_); \
        const unsigned cj_ = (lane < (NB)) ? (CJEXPR) : 0u; \
        unsigned suf2_ = cj_; \
        _Pragma("unroll") for (int o_ = 1; o_ < 32; o_ <<= 1) { const unsigned v_ = __shfl_down(suf2_, o_); if (lane + o_ < 64) suf2_ += v_; } \
        const unsigned above2_ = suf2_ - cj_; \
        const unsigned long long fm2_ = __ballot(above2_ < kneed && kneed <= above2_ + cj_); \
        const int J_ = (int)__builtin_ctzll(fm2_ | (1ull << 63)); \
        kneed -= (unsigned)__builtin_amdgcn_readlane((int)above2_, J_); \
        cfin = (unsigned)__builtin_amdgcn_readlane((int)cj_, J_); \
        BIN = (unsigned)(L_ * (NB) + J_); } while (0)
#define SEL_SCAN32(BIN) do { unsigned tot_ = 0u; \
        _Pragma("unroll") for (int i_ = 0; i_ < 8; ++i_) { const u32x4 h_ = *(const LAS u32x4*)(hist + lane * 32 + 4 * i_); tot_ += (h_.x + h_.y) + (h_.z + h_.w); } \
        SEL_FIND(32, tot_, hist[L_ * 32 + lane], BIN); } while (0)
#define SEL_ZERO() do { _Pragma("unroll") for (int i_ = 0; i_ < 8; ++i_) *(LAS u32x4*)(hist + (i_ * 64 + lane) * 4) = (u32x4){0u, 0u, 0u, 0u}; } while (0)
    for (int rep_ = 0; rep_ < SEL_REP_SELECT; ++rep_) {
    SEL_LOAD_ROW(wid * 4, ((q0 + wid * 4 + 1) + 63) >> 6);
#pragma unroll 1
    for (int qi = 0; qi < 4; ++qi) {
        const int qq = wid * 4 + qi, t = q0 + qq, n = t + 1, nj = (n + 63) >> 6;
        unsigned key[64];
#pragma unroll
        for (int g = 0; g < 8; ++g) {
            if (g * 8 < nj) {
#pragma unroll
                for (int i = 0; i < 8; ++i) { const int jj = g * 8 + i; key[jj] = (lane < n - 64 * jj) ? pre[jj] : 0u; }
            } else {
#pragma unroll
                for (int i = 0; i < 8; ++i) key[g * 8 + i] = 0u;
            }
        }
        if (qi < 3) SEL_LOAD_ROW(qq + 1, (n + 1 + 63) >> 6);
        unsigned thr = 1u; bool ties = false; int need = 0;
        if (n > TOPK) {
            unsigned kneed = TOPK, cfin = 0u, b1, b2, b3;
            {
                const LAS unsigned* h1 = (const LAS unsigned*)(lds + H1_OFF) + qq * 512;
                const u32x4 ha = *(const LAS u32x4*)(h1 + lane * 8), hb = *(const LAS u32x4*)(h1 + lane * 8 + 4);
                const unsigned sw = (ha.x + ha.y) + (ha.z + ha.w) + (hb.x + hb.y) + (hb.z + hb.w);
                const unsigned tot1 = (sw & 0xffffu) + (sw >> 16);
                SEL_FIND(16, tot1, ((h1[L_ * 8 + (lane >> 1)] >> ((lane & 1) * 16)) & 0xffffu), b1);
            }
            const unsigned hb1 = b1 << 22;
            SEL_ZERO();
#pragma unroll
            for (int g = 0; g < 8; ++g) {
                if (g * 8 < nj) {
#pragma unroll
                    for (int i = 0; i < 8; ++i) { const unsigned k = key[g * 8 + i]; const bool c = (k ^ hb1) < 0x400000u;
                        if (__ballot(c)) { if (c) __hip_atomic_fetch_add(hist + ((k >> 11) & 2047u), 1u, __ATOMIC_RELAXED, __HIP_MEMORY_SCOPE_WORKGROUP); } }
                }
            }
            asm volatile("s_waitcnt lgkmcnt(0)" ::: "memory");
            SEL_SCAN32(b2);
            asm volatile("s_waitcnt lgkmcnt(0)" ::: "memory");
            const unsigned p21 = (b1 << 11) | b2, hp21 = p21 << 11;
            SEL_ZERO();
#pragma unroll
            for (int g = 0; g < 8; ++g) {
                if (g * 8 < nj) {
#pragma unroll
                    for (int i = 0; i < 8; ++i) { const unsigned k = key[g * 8 + i]; const bool c = (k ^ hp21) < 2048u;
                        if (__ballot(c)) { if (c) __hip_atomic_fetch_add(hist + (k & 2047u), 1u, __ATOMIC_RELAXED, __HIP_MEMORY_SCOPE_WORKGROUP); } }
                }
            }
            asm volatile("s_waitcnt lgkmcnt(0)" ::: "memory");
            SEL_SCAN32(b3);
            asm volatile("s_waitcnt lgkmcnt(0)" ::: "memory");
            thr = hp21 | b3; need = (int)kneed; ties = (cfin != kneed);
        }
        int mylo = 0, myhi = 0;
        if (!ties) {
#pragma unroll
            for (int g = 0; g < 8; ++g) {
                if (g * 8 < nj) {
#pragma unroll
                    for (int i = 0; i < 8; ++i) {
                        const unsigned long long bits = __ballot(key[g * 8 + i] >= thr);
                        asm volatile("s_nop 1\n\tv_writelane_b32 %0, %2, %4\n\tv_writelane_b32 %1, %3, %4" : "+v"(mylo), "+v"(myhi) : "s"((unsigned)bits), "s"((unsigned)(bits >> 32)), "n"(g * 8 + i));
                    }
                }
            }
        } else {
            int eqcnt = 0;
            const unsigned long long lt = (1ull << lane) - 1ull;
#pragma unroll
            for (int g = 0; g < 8; ++g) {
                if (g * 8 < nj) {
#pragma unroll
                    for (int i = 0; i < 8; ++i) {
                        const unsigned k = key[g * 8 + i];
                        const bool eq = (k == thr);
                        const unsigned long long meq = __ballot(eq);
                        const int rank = eqcnt + (int)__popcll(meq & lt);
                        const unsigned long long bits = __ballot(k > thr || (eq && rank < need));
                        eqcnt += (int)__popcll(meq);
                        asm volatile("s_nop 1\n\tv_writelane_b32 %0, %2, %4\n\tv_writelane_b32 %1, %3, %4" : "+v"(mylo), "+v"(myhi) : "s"((unsigned)bits), "s"((unsigned)(bits >> 32)), "n"(g * 8 + i));
                    }
                }
            }
        }
        ((unsigned long long*)(ws + WS_MASK))[(size_t)(row0 + qq) * 64 + lane] = ((unsigned long long)(unsigned)myhi << 32) | (unsigned long long)(unsigned)mylo;
    }
    }
#undef SEL_LOAD_ROW
#undef SEL_FIND
#undef SEL_SCAN32
#undef SEL_ZERO
    __syncthreads();
}

__device__ __forceinline__ void phase(unsigned char* ws, unsigned char* scbase, LAS unsigned char* lds, int G, int v) {
    const int GE = G < 256 ? G : 256;
    if (v >= GE) return;
    size_t off = 0;
    for (int i = 0; i < v; ++i) off += scratch_bytes(i);
    float* sc = (float*)(scbase + off);
    for (int r = 0;; ++r) {
        const int u = (r & 1) ? ((r + 1) * GE - 1 - v) : (r * GE + v);
        if (u >= NUNITS) break;
        int b, j; unit_of(u, b, j);
        unit(b, j, ws, sc, lds);
    }
}
}
namespace gla {
typedef short bf16x8 __attribute__((ext_vector_type(8)));
typedef float f32x16 __attribute__((ext_vector_type(16)));
constexpr int NUNITS = BATCH * 4 * (SEQ / 64);
constexpr int LP = 72;
constexpr int L_GLR = 0, L_WUP = 4096, L_GT = 8192, L_RED = 10240, L_A = 12288, L_B = L_A + 64 * LP * 2, L_V = L_B + 64 * LP * 2, L_A2 = L_V + 128 * LP * 2, L_END = L_A2 + 64 * LP * 2;
__device__ __forceinline__ int crow(int r, int hi) { return (r & 3) + 8 * (r >> 2) + 4 * hi; }

__device__ __forceinline__ void cum_gates(const float* GLR, const float* wup, const float* bias, int tok0, int h, LAS unsigned char* lds, float (&bv)[8], float& blast) {
    const int tid = threadIdx.x, d = tid & 63, tg = tid >> 6;
    LAS float* sg = (LAS float*)(lds + L_GLR); LAS float* sw = (LAS float*)(lds + L_WUP); LAS float* gt = (LAS float*)(lds + L_GT);
#pragma unroll
    for (int i = 0; i < 2; ++i) { const int e = tid + 512 * i; sg[e] = GLR[(size_t)tok0 * 16 + e]; sw[e] = wup[(e >> 6) * 256 + h * 64 + (e & 63)]; }
    __syncthreads();
    float wu[16];
#pragma unroll
    for (int r = 0; r < 16; ++r) wu[r] = sw[r * 64 + d];
    const float bi = bias[h * 64 + d];
    float run = 0.f;
#pragma unroll
    for (int i = 0; i < 8; ++i) {
        const int t = tg * 8 + i;
        float z = bi;
#pragma unroll
        for (int r = 0; r < 16; ++r) z = fmaf(sg[t * 16 + r], wu[r], z);
        const float ls = fminf(z, 0.f) - log1pf(expf(-fabsf(z)));
        run += ls * (1.0f / 16.0f);
        bv[i] = run;
    }
    gt[tg * 64 + d] = run;
    __syncthreads();
    float pre = 0.f, tot = 0.f;
#pragma unroll
    for (int g = 0; g < 8; ++g) { const float v = gt[g * 64 + d]; tot += v; if (g < tg) pre += v; }
#pragma unroll
    for (int i = 0; i < 8; ++i) bv[i] += pre;
    blast = tot;
}
__device__ __forceinline__ void stage_vT(const bf16_t* GV, int tok0, int h, LAS unsigned char* lds) {
    const int tid = threadIdx.x, e = tid & 127, tq = tid >> 7;
    unsigned pk[8];
#pragma unroll
    for (int i = 0; i < 8; ++i) {
        const unsigned lo = GV[(size_t)(tok0 + tq * 16 + 2 * i) * 512 + h * 128 + e], hi = GV[(size_t)(tok0 + tq * 16 + 2 * i + 1) * 512 + h * 128 + e];
        pk[i] = lo | (hi << 16);
    }
    LAS u32x4* dst = (LAS u32x4*)(lds + L_V + (e * LP + tq * 16) * 2);
    dst[0] = (u32x4){pk[0], pk[1], pk[2], pk[3]}; dst[1] = (u32x4){pk[4], pk[5], pk[6], pk[7]};
}

__device__ __forceinline__ void g1_unit(int u, const MkPtrs& P, LAS unsigned char* lds) {
    const int tid = threadIdx.x, lane = tid & 63, wid = __builtin_amdgcn_readfirstlane(tid >> 6), r32 = lane & 31, hi = lane >> 5;
    const int bh = u >> 6, c = u & 63, b = bh >> 2, h = bh & 3, tok0 = b * SEQ + c * 64, d = tid & 63, tg = tid >> 6;
    float bv[8], blast;
    cum_gates(P.GLR, P.wup, P.bias, tok0, h, lds, bv, blast);
    {
        float kl[8];
#pragma unroll
        for (int i = 0; i < 8; ++i) kl[i] = bf2f(P.GK[(size_t)(tok0 + tg * 8 + i) * 256 + h * 64 + d]) * expf(blast - bv[i]);
        *(LAS u32x4*)(lds + L_A + (d * LP + tg * 8) * 2) = (u32x4){pk2(kl[0], kl[1]), pk2(kl[2], kl[3]), pk2(kl[4], kl[5]), pk2(kl[6], kl[7])};
    }
    stage_vT(P.GV, tok0, h, lds);
    if (tid < 64) P.DV[(size_t)u * 64 + tid] = expf(blast);
    __syncthreads();
    {
        const int wd = wid & 1, we = wid >> 1;
        f32x16 acc;
#pragma unroll
        for (int i = 0; i < 16; ++i) acc[i] = 0.f;
#pragma unroll
        for (int s = 0; s < 4; ++s) {
            const bf16x8 af = *(const LAS bf16x8*)(lds + L_A + ((wd * 32 + r32) * LP + 16 * s + 8 * hi) * 2);
            const bf16x8 bf = *(const LAS bf16x8*)(lds + L_V + ((we * 32 + r32) * LP + 16 * s + 8 * hi) * 2);
            acc = __builtin_amdgcn_mfma_f32_32x32x16_bf16(af, bf, acc, 0, 0, 0);
        }
        bf16_t* dst = P.UT + ((size_t)u * 128 + we * 32 + r32) * 64 + wd * 32 + 4 * hi;
#pragma unroll
        for (int g = 0; g < 4; ++g) *(u32x2*)(dst + 8 * g) = (u32x2){pk2(acc[4 * g], acc[4 * g + 1]), pk2(acc[4 * g + 2], acc[4 * g + 3])};
    }
    __syncthreads();
}
__device__ __forceinline__ void g2_item(int item, const MkPtrs& P, bf16_t* STout) {
    const int tid = threadIdx.x, bh = item >> 4, idx = (item & 15) * 512 + tid, d = idx & 63;
    bf16_t* p = P.UT + (size_t)bh * 64 * 8192 + idx; const float* dvp = P.DV + (size_t)bh * 64 * 64 + d;
    bf16_t* po = STout + (size_t)bh * 64 * 8192 + idx;
    float S = 0.f;
#pragma unroll 1
    for (int c0 = 0; c0 < 64; c0 += 16) {
        float uu[16], dd[16];
#pragma unroll
        for (int i = 0; i < 16; ++i) { uu[i] = bf2f(p[(size_t)(c0 + i) * 8192]); dd[i] = dvp[(c0 + i) * 64]; }
        asm volatile("" ::: "memory");
#pragma unroll
        for (int i = 0; i < 16; ++i) { po[(size_t)(c0 + i) * 8192] = f2bf(S); S = fmaf(dd[i], S, uu[i]); }
    }
}
__device__ __forceinline__ void g3_unit(int u, const MkPtrs& P, bf16_t* MIXo, LAS unsigned char* lds) {
    const int tid = threadIdx.x, lane = tid & 63, wid = __builtin_amdgcn_readfirstlane(tid >> 6), r32 = lane & 31, hi = lane >> 5;
    const int bh = u >> 6, c = u & 63, b = bh >> 2, h = bh & 3, tok0 = b * SEQ + c * 64, d = tid & 63, tg = tid >> 6;
    float bv[8], blast;
    cum_gates(P.GLR, P.wup, P.bias, tok0, h, lds, bv, blast);
    {
        LAS bf16_t* qa = (LAS bf16_t*)(lds + L_A); LAS bf16_t* kb = (LAS bf16_t*)(lds + L_B);
#pragma unroll
        for (int i = 0; i < 8; ++i) {
            const int t = tg * 8 + i; const size_t g = (size_t)(tok0 + t) * 256 + h * 64 + d;
            qa[t * LP + d] = f2bf(bf2f(P.GQ[g]) * 0.125f * expf(bv[i]));
            kb[t * LP + d] = f2bf(bf2f(P.GK[g]) * expf(-bv[i]));
        }
    }
    stage_vT(P.GV, tok0, h, lds);
    __syncthreads();
    if (wid < 4) {
        const int ss = wid & 1, tt = wid >> 1;
        f32x16 acc;
#pragma unroll
        for (int i = 0; i < 16; ++i) acc[i] = 0.f;
        if (ss <= tt) {
#pragma unroll
            for (int s = 0; s < 4; ++s) {
                const bf16x8 af = *(const LAS bf16x8*)(lds + L_B + ((ss * 32 + r32) * LP + 16 * s + 8 * hi) * 2);
                const bf16x8 bf = *(const LAS bf16x8*)(lds + L_A + ((tt * 32 + r32) * LP + 16 * s + 8 * hi) * 2);
                acc = __builtin_amdgcn_mfma_f32_32x32x16_bf16(af, bf, acc, 0, 0, 0);
            }
        }
        const int t = tt * 32 + r32;
#pragma unroll
        for (int g = 0; g < 4; ++g) {
            float x[4];
#pragma unroll
            for (int e = 0; e < 4; ++e) { const int s = ss * 32 + 8 * g + 4 * hi + e; x[e] = (s <= t) ? acc[4 * g + e] : 0.f; }
            *(LAS u32x2*)(lds + L_A2 + (t * LP + ss * 32 + 8 * g + 4 * hi) * 2) = (u32x2){pk2(x[0], x[1]), pk2(x[2], x[3])};
        }
    }
    __syncthreads();
    const int ee = wid >> 1, tt = wid & 1;
    f32x16 o;
#pragma unroll
    for (int i = 0; i < 16; ++i) o[i] = 0.f;
    {
        const bf16_t* st = P.UT + ((size_t)u * 128 + ee * 32 + r32) * 64 + 8 * hi;
#pragma unroll
        for (int s = 0; s < 4; ++s) {
            const bf16x8 af = *(const bf16x8*)(st + 16 * s);
            const bf16x8 bf = *(const LAS bf16x8*)(lds + L_A + ((tt * 32 + r32) * LP + 16 * s + 8 * hi) * 2);
            o = __builtin_amdgcn_mfma_f32_32x32x16_bf16(af, bf, o, 0, 0, 0);
        }
#pragma unroll
        for (int s = 0; s < 4; ++s) {
            const bf16x8 af = *(const LAS bf16x8*)(lds + L_V + ((ee * 32 + r32) * LP + 16 * s + 8 * hi) * 2);
            const bf16x8 bf = *(const LAS bf16x8*)(lds + L_A2 + ((tt * 32 + r32) * LP + 16 * s + 8 * hi) * 2);
            o = __builtin_amdgcn_mfma_f32_32x32x16_bf16(af, bf, o, 0, 0, 0);
        }
    }
    float ssq = 0.f;
#pragma unroll
    for (int i = 0; i < 16; ++i) ssq = fmaf(o[i], o[i], ssq);
    ssq += __shfl_xor(ssq, 32);
    LAS float* red = (LAS float*)(lds + L_RED);
    const int t = tt * 32 + r32;
    if (hi == 0) red[ee * 64 + t] = ssq;
    __syncthreads();
    const float tot = (red[t] + red[64 + t]) + (red[128 + t] + red[192 + t]);
    const float rs = 1.0f / sqrtf(tot * (1.0f / 128.0f) + NORM_EPS);
    bf16_t* mrow = MIXo + (size_t)(tok0 + t) * 1024 + 512 + h * 128 + ee * 32 + 4 * hi;
    const float* gw = P.gnw + ee * 32 + 4 * hi;
#pragma unroll
    for (int g = 0; g < 4; ++g) {
        const u32x2 gg = *(const u32x2*)(mrow + 8 * g);
        const f32x4 w4 = *(const f32x4*)(gw + 8 * g);
        const float y0 = o[4 * g] * rs * w4[0] * __builtin_bit_cast(float, gg.x << 16), y1 = o[4 * g + 1] * rs * w4[1] * __builtin_bit_cast(float, gg.x & 0xffff0000u);
        const float y2 = o[4 * g + 2] * rs * w4[2] * __builtin_bit_cast(float, gg.y << 16), y3 = o[4 * g + 3] * rs * w4[3] * __builtin_bit_cast(float, gg.y & 0xffff0000u);
        *(u32x2*)(mrow + 8 * g) = (u32x2){pk2(y0, y1), pk2(y2, y3)};
    }
    __syncthreads();
}
}
constexpr int MK_LDS = 147456;
constexpr int N_PHASES = 9;
struct MkArgs { const float* x; const int* pos; const float* w_in; const float* wup; const float* bgate; const float* gnw; const float* w_out; const float* prew; const float* postw;
                float* out; unsigned char* ws; int ph_lo, ph_hi; };
__global__ void __launch_bounds__(512, 2) mk_fwd(MkArgs a) {
    extern __shared__ __attribute__((aligned(16))) unsigned char lds_raw[];
    LAS unsigned char* lds = (LAS unsigned char*)lds_raw;
    cg::grid_group grid = cg::this_grid();
    const int tid = threadIdx.x, lane = tid & 63, wave = __builtin_amdgcn_readfirstlane(tid >> 6);
    const int G = gridDim.x, bx = blockIdx.x;
    const int vcu = (G % 8 == 0) ? (bx % 8) * (G / 8) + bx / 8 : bx;
    unsigned char* ws = a.ws;
    const MkPtrs PT{(const float*)(ws + WS_GLR), a.wup, a.bgate, a.gnw, (const bf16_t*)(ws + WS_GQ), (const bf16_t*)(ws + WS_GK), (const bf16_t*)(ws + WS_GV),
                    (bf16_t*)(ws + WS_UT), (float*)(ws + WS_DV), (bf16_t*)(ws + WS_MIX)};
#define IN(k) (a.ph_lo <= (k) && (k) < a.ph_hi)
    volatile LAS unsigned* bst = (volatile LAS unsigned*)(lds + MK_LDS - 16);
    if (tid < 4) bst[tid] = 0u;
    __syncthreads();
    XcdBarrier xbar = xcd_barrier_post((unsigned*)(ws + WS_CTL) + CW_BAR, bst);
    if (a.ph_hi > 1000) grid.sync();
#ifndef MK_REPS
#define MK_REPS {1, 1, 1, 1, 1, 1, 1, 1, 1}
#endif
#ifndef MK_XSYNC
#define MK_XSYNC 0
#endif
    constexpr int REPS[N_PHASES] = MK_REPS;
    MkPtrs PTD = PT; PTD.UT = (bf16_t*)(ws + WS_DUMMY); PTD.MIX = (bf16_t*)(ws + WS_DUMMY);
#define SEAM(k) do { if (IN(k) && IN((k) + 1)) { xcd_barrier(xbar); for (int xs_ = 0; xs_ < MK_XSYNC; ++xs_) xcd_barrier(xbar); } } while (0)
    if (IN(0)) for (int rep = 0; rep < REPS[0]; ++rep) {
        LAS float* scr = (LAS float*)(lds + wave * 16384);
        const int gw = vcu * 8 + wave, NGW = G * 8;
        constexpr int I_W1 = 16 * (NF / 32), I_W2 = 16 * (DM / 32);
        for (int it = gw; it < I_W1 + I_W2; it += NGW) {
            if (it < I_W1) p0_transpose_item<true>(a.w_in, NPROJ, a.prew, (bf16_t*)(ws + WS_W1T), (bf16_t*)(ws + WS_W1L), scr, it, NF / 32, lane);
            else p0_transpose_item<false>(a.w_out, DM, nullptr, (bf16_t*)(ws + WS_W2T), nullptr, scr, it - I_W1, DM / 32, lane);
        }
        for (int row = gw; row < M; row += NGW) p0_row(a.x, a.pos, ws, row, lane);
    }
    SEAM(0);
    if (IN(1)) for (int rep = 0; rep < REPS[1]; ++rep) {
        ProbProj P{(const bf16_t*)(ws + WS_XH), (const bf16_t*)(ws + WS_XL), (const bf16_t*)(ws + WS_W1T), (const bf16_t*)(ws + WS_W1L)};
        SchedProj S{G, vcu};
        EpiProj E{ws};
        pg8::gemm_phase<EpiProj, SchedProj, ProbProj, true>(lds, P, S, E);
    }
    SEAM(1);
    if (IN(2)) for (int rep = 0; rep < REPS[2]; ++rep) { for (int u = vcu; u < gla::NUNITS; u += G) gla::g1_unit(u, PT, lds); }
    SEAM(2);
    if (IN(3)) for (int rep = 0; rep < REPS[3]; ++rep) { for (int it = vcu; it < 256; it += G) gla::g2_item(it, PT, rep ? PTD.UT : PT.UT); }
    SEAM(3);
    if (IN(4)) for (int rep = 0; rep < REPS[4]; ++rep) { for (int u = vcu; u < gla::NUNITS; u += G) gla::g3_unit(u, PT, rep ? PTD.MIX : PT.MIX, lds); }
    SEAM(4);
    if (IN(5)) for (int rep = 0; rep < REPS[5]; ++rep) sel::phase(ws, ws + WS_SC, lds, G, vcu);
    SEAM(5);
    if (IN(6)) for (int rep = 0; rep < REPS[6]; ++rep) {
        const attn_body::AttnTensors AT{(const attn_body::bf16*)(ws + WS_Q), (const attn_body::bf16*)(ws + WS_K), (const attn_body::bf16*)(ws + WS_V), (const unsigned*)(ws + WS_MASK), (attn_body::bf16*)(ws + (rep ? WS_DUMMY : WS_MIX))};
        const attn_body::StaticOrder S(G, vcu);
        attn_body::attn_phase<attn_body::StaticOrder>((char*)lds_raw, AT, S);
    }
    SEAM(6);
    if (IN(7)) for (int rep = 0; rep < REPS[7]; ++rep) {
        ProbOut P{(const bf16_t*)(ws + WS_MIX), (const bf16_t*)(ws + WS_W2T)};
        SchedOut S{G, vcu};
        EpiY E{(float*)(ws + WS_TMP)};
        pg8::gemm_phase<EpiY, SchedOut, ProbOut, false>(lds, P, S, E);
    }
    SEAM(7);
    if (IN(8)) for (int rep = 0; rep < REPS[8]; ++rep) {
        const int gw = vcu * 8 + wave, NGW = G * 8;
        for (int row = gw; row < M; row += NGW) p6_row(a.x, (const float*)(ws + WS_TMP), a.postw, a.out, row, lane);
    }
#undef IN
#undef SEAM
}

#ifndef MK_CUTS
#define MK_CUTS {0, 9}
#endif
extern "C" void kernel_launch(void* const* d_in, const int* in_sizes, int n_in, void* d_out, int out_size, void* d_ws, size_t ws_size, hipStream_t stream) {
    const float* x = (const float*)d_in[0]; const int* pos = (const int*)d_in[1]; const float* w_in = (const float*)d_in[2];
    const float* wup = (const float*)d_in[3]; const float* bgate = (const float*)d_in[4]; const float* gnw = (const float*)d_in[5];
    const float* w_out = (const float*)d_in[6]; const float* prew = (const float*)d_in[7]; const float* postw = (const float*)d_in[8];
    unsigned char* ws = (unsigned char*)d_ws; float* out = (float*)d_out;
    static int grid_blocks = 0;
    if (!grid_blocks) {
        int dev = 0, cus = 0, per_cu = 0;
        (void)hipGetDevice(&dev);
        (void)hipDeviceGetAttribute(&cus, hipDeviceAttributeMultiprocessorCount, dev);
        (void)hipFuncSetAttribute((const void*)mk_fwd, hipFuncAttributeMaxDynamicSharedMemorySize, MK_LDS);
        (void)hipOccupancyMaxActiveBlocksPerMultiprocessor(&per_cu, (const void*)mk_fwd, 512, MK_LDS);
        if (per_cu < 1) per_cu = 1;
        grid_blocks = cus * per_cu;
    }
    auto launch = [&](int lo, int hi) {
        MkArgs a{}; a.x = x; a.pos = pos; a.w_in = w_in; a.wup = wup; a.bgate = bgate; a.gnw = gnw; a.w_out = w_out; a.prew = prew; a.postw = postw;
        a.out = out; a.ws = ws; a.ph_lo = lo; a.ph_hi = hi;
        void* args[] = {&a};
        hipError_t e = hipLaunchCooperativeKernel((const void*)mk_fwd, dim3(grid_blocks), dim3(512), args, MK_LDS, stream);
        if (e != hipSuccess) fprintf(stderr, "cooperative launch [%d,%d) failed: %s (grid %d)\n", lo, hi, hipGetErrorString(e), grid_blocks);
    };
    (void)hipMemsetAsync(ws + WS_CTL, 0, CTL_ZERO_BYTES, stream);
    const int cuts[] = MK_CUTS;
    for (int i = 0; i + 1 < (int)(sizeof(cuts) / sizeof(cuts[0])); ++i) launch(cuts[i], cuts[i + 1]);
}
```
